# Optimizing an MI355X kernel written in HIP

```python
import jax, jax.numpy as jnp
from jax import lax
import numpy as np

D_MODEL = 1024
BATCH = 8
SEQ = 4096
DEPTH = 4

GRID_W = 64
CTX_LEN = 256
HEAD_DIM = 64
ROPE_THETA = 10000.0
NORM_EPS = 1e-6
NEG_INF = -1e30

GLA_HEADS = 4
GLA_DK = 32
GLA_DV = 64
GLA_RANK = 16
GLA_NORMALIZER = 16.0
GLA_CHUNK = 64
GLA_W = GLA_HEADS * GLA_DV

SWA_HEADS = 8
SWA_KV_HEADS = 2
SWA_GROUP = SWA_HEADS // SWA_KV_HEADS
SWA_WINDOW = 128
SWA_BLOCK = 128
SWA_W = SWA_HEADS * HEAD_DIM

RWKV_HEADS = 4
RWKV_N = 64
RWKV_W = RWKV_HEADS * RWKV_N
RWKV_W_RANK = 64
RWKV_A_RANK = 64
RWKV_G_RANK = 128
RWKV_GN_EPS = 64e-5

MIX_W = GLA_W + SWA_W + RWKV_W
D_FF = -(-8 * D_MODEL // (3 * 256)) * 256

GLA_SIZES = (GLA_HEADS * GLA_DK, GLA_HEADS * GLA_DK, GLA_W, GLA_W, GLA_RANK, GLA_RANK)
SWA_SIZES = (SWA_W, SWA_KV_HEADS * HEAD_DIM, SWA_KV_HEADS * HEAD_DIM)
RWKV_SIZES = (RWKV_W, RWKV_W, RWKV_W, RWKV_W_RANK, RWKV_W_RANK, RWKV_A_RANK, RWKV_A_RANK, RWKV_G_RANK)
GLA_COLS = sum(GLA_SIZES)
SWA_COLS = sum(SWA_SIZES)
RWKV_COLS = sum(RWKV_SIZES)
IN_COLS = GLA_COLS + SWA_COLS + RWKV_COLS

kernel_name = 'hybrid_gla_swa_rwkv7_dit_block'


def _split(p, sizes):
    return jnp.split(p, np.cumsum(sizes)[:-1].tolist(), axis=-1)


def rmsnorm(x, g):
    xf = x.astype(jnp.float32)
    y = xf * lax.rsqrt(jnp.mean(xf * xf, axis=-1, keepdims=True) + NORM_EPS)
    return (y * g.astype(jnp.float32)).astype(x.dtype)


def modulate(h, shift, scale):
    return h * (1.0 + scale) + shift


def axial_rope(n_tokens):
    rows = n_tokens // GRID_W
    row = jnp.repeat(jnp.arange(rows, dtype=jnp.float32), GRID_W)
    col = jnp.tile(jnp.arange(GRID_W, dtype=jnp.float32), rows)
    n_freq = HEAD_DIM // 4
    inv = ROPE_THETA ** (-jnp.arange(n_freq, dtype=jnp.float32) / n_freq)
    ang = jnp.concatenate([row[:, None] * inv, col[:, None] * inv], axis=-1)
    return jnp.cos(ang), jnp.sin(ang)


def apply_rope(x, cos, sin):
    shape = (cos.shape[0],) + (1,) * (x.ndim - 3) + (cos.shape[-1],)
    cos, sin = cos.reshape(shape), sin.reshape(shape)
    x1, x2 = jnp.split(x, 2, axis=-1)
    return jnp.concatenate([x1 * cos - x2 * sin, x1 * sin + x2 * cos], axis=-1)


def run_direction(scan_fn, ctx_in, lat_in, state0, reverse):
    if reverse:
        ctx_in = tuple(jnp.flip(t, axis=1) for t in ctx_in)
        lat_in = tuple(jnp.flip(t, axis=1) for t in lat_in)
    o_c, s_c = scan_fn(*ctx_in, state0)
    o_x, _ = scan_fn(*lat_in, s_c)
    if reverse:
        o_c, o_x = jnp.flip(o_c, axis=1), jnp.flip(o_x, axis=1)
    return o_c, o_x


def gla_chunked(q, k, v, glog, state0):
    B, T, H, _ = q.shape
    n = T // GLA_CHUNK
    rs = lambda a: a.reshape(B, n, GLA_CHUNK, H, a.shape[-1]).transpose(1, 0, 3, 2, 4)
    q, k, v, glog = rs(q), rs(k), rs(v), rs(glog)
    b = jnp.cumsum(glog, axis=-2)
    b_last = b[..., -1:, :]
    q_dec = q * jnp.exp(b)
    k_dec = k * jnp.exp(-b)
    k_to_end = k * jnp.exp(b_last - b)
    causal_in_chunk = jnp.tril(jnp.ones((GLA_CHUNK, GLA_CHUNK), jnp.float32))
    att = jnp.einsum('nbhid,nbhjd->nbhij', q_dec, k_dec) * causal_in_chunk
    o_intra = jnp.einsum('nbhij,nbhjv->nbhiv', att, v)

    def step(S, inp):
        qd, kte, vv, bl = inp
        o = jnp.einsum('bhid,bhdv->bhiv', qd, S)
        S = S * jnp.exp(bl)[:, :, 0, :, None] + jnp.einsum('bhjd,bhjv->bhdv', kte, vv)
        return S, o

    S_final, o_inter = lax.scan(step, state0, (q_dec, k_to_end, v, b_last))
    o = (o_intra + o_inter).transpose(1, 0, 3, 2, 4).reshape(B, T, H, v.shape[-1])
    return o, S_final


def gla_group(pc, px, decay_w, decay_b, norm_g, with_ctx_out):
    def prep(p):
        B, T, _ = p.shape
        q, k, v, g, lf, lb = _split(p, GLA_SIZES)
        heads = lambda t, d: t.reshape(B, T, GLA_HEADS, d)
        glog = lambda lr, i: heads(jax.nn.log_sigmoid(lr @ decay_w[i] + decay_b[i]) / GLA_NORMALIZER, GLA_DK)
        return (heads(q, GLA_DK) * GLA_DK ** -0.5, heads(k, GLA_DK), heads(v, GLA_DV), g,
                glog(lf, 0), glog(lb, 1))

    qc, kc, vc, gc, fc, bc = prep(pc)
    qx, kx, vx, gx, fx, bx = prep(px)
    zero = jnp.zeros((pc.shape[0], GLA_HEADS, GLA_DK, GLA_DV), jnp.float32)
    oc_f, ox_f = run_direction(gla_chunked, (qc, kc, vc, fc), (qx, kx, vx, fx), zero, False)
    oc_b, ox_b = run_direction(gla_chunked, (qc, kc, vc, bc), (qx, kx, vx, bx), zero, True)

    def out(o, g):
        B, T = g.shape[:2]
        return rmsnorm(o, norm_g).reshape(B, T, GLA_W) * jax.nn.silu(g)

    oc = out(oc_f + oc_b, gc) if with_ctx_out else None
    return oc, out(ox_f + ox_b, gx)


def swa_group(pc, px, sink, cos, sin, with_ctx_out):
    def prep(p):
        B, T, _ = p.shape
        q, k, v = _split(p, SWA_SIZES)
        return (q.reshape(B, T, SWA_KV_HEADS, SWA_GROUP, HEAD_DIM) * HEAD_DIM ** -0.5,
                k.reshape(B, T, SWA_KV_HEADS, HEAD_DIM), v.reshape(B, T, SWA_KV_HEADS, HEAD_DIM))

    qc, kc, vc = prep(pc)
    qx, kx, vx = prep(px)
    qx, kx = apply_rope(qx, cos, sin), apply_rope(kx, cos, sin)
    B, T = px.shape[:2]
    Tc = pc.shape[1]
    nb = T // SWA_BLOCK
    sink_logit = sink.astype(jnp.float32).reshape(SWA_KV_HEADS, SWA_GROUP)

    def bands(t):
        tp = jnp.pad(t, ((0, 0), (SWA_BLOCK, SWA_BLOCK), (0, 0), (0, 0)))
        tp = tp.reshape(B, nb + 2, SWA_BLOCK, SWA_KV_HEADS, HEAD_DIM)
        return jnp.concatenate([tp[:, :-2], tp[:, 1:-1], tp[:, 2:]], axis=2)

    kb, vb = bands(kx), bands(vx)
    rel = jnp.arange(SWA_BLOCK)[:, None] - jnp.arange(3 * SWA_BLOCK)[None, :] + SWA_BLOCK
    kpos = jnp.arange(nb)[:, None] * SWA_BLOCK - SWA_BLOCK + jnp.arange(3 * SWA_BLOCK)[None, :]
    mask = (jnp.abs(rel) <= SWA_WINDOW)[None] & ((kpos >= 0) & (kpos < T))[:, None, :]
    qb = qx.reshape(B, nb, SWA_BLOCK, SWA_KV_HEADS, SWA_GROUP, HEAD_DIM)

    def sink_col(s):
        return jnp.broadcast_to(sink_logit[None, :, :, None, None], s.shape[:-1] + (1,))

    def block(args):
        q, k, v, m = args
        s_ctx = jnp.einsum('bqkgd,bckd->bkgqc', q, kc)
        s_loc = jnp.where(m, jnp.einsum('bqkgd,bjkd->bkgqj', q, k), NEG_INF)
        p = jax.nn.softmax(jnp.concatenate([s_ctx, s_loc, sink_col(s_ctx)], axis=-1), axis=-1)
        return (jnp.einsum('bkgqc,bckd->bqkgd', p[..., :Tc], vc)
                + jnp.einsum('bkgqj,bjkd->bqkgd', p[..., Tc:Tc + 3 * SWA_BLOCK], v))

    ob = lax.map(block, (jnp.moveaxis(qb, 1, 0), jnp.moveaxis(kb, 1, 0), jnp.moveaxis(vb, 1, 0), mask))
    ox = jnp.moveaxis(ob, 0, 1).reshape(B, T, SWA_W)
    oc = None
    if with_ctx_out:
        s = jnp.einsum('bqkgd,bckd->bkgqc', qc, kc)
        p = jax.nn.softmax(jnp.concatenate([s, sink_col(s)], axis=-1), axis=-1)
        oc = jnp.einsum('bkgqc,bckd->bqkgd', p[..., :Tc], vc).reshape(B, Tc, SWA_W)
    return oc, ox


def centred_shift(p, w):
    pp = jnp.pad(p, ((0, 0), (1, 1), (0, 0)))
    return w[0] * pp[:, :-2] + w[1] * pp[:, 1:-1] + w[2] * pp[:, 2:]


def rwkv7_scan(r, w, k, v, kk, a, state0):
    xs = tuple(jnp.moveaxis(t, 1, 0) for t in (r, w, k, v, kk, a))

    def step(S, inp):
        rt, wt, kt, vt, kkt, at = inp
        sa = jnp.einsum('bhvk,bhk->bhv', S, kkt)
        S = (S * wt[:, :, None, :] - sa[..., None] * (kkt * at)[:, :, None, :]
             + vt[..., None] * kt[:, :, None, :])
        return S, jnp.einsum('bhvk,bhk->bhv', S, rt)

    S_final, o = lax.scan(step, state0, xs)
    return jnp.moveaxis(o, 0, 1), S_final


def rwkv_group(pc, px, shift_w, w0, w2, a0, a2, g2, k_k, k_a, r_k, ln_g, ln_b, with_ctx_out):
    def prep(p):
        B, T, _ = p.shape
        r, k, v, lwf, lwb, laf, lab, lg = _split(centred_shift(p, shift_w), RWKV_SIZES)
        heads = lambda t: t.reshape(B, T, RWKV_HEADS, RWKV_N)
        kk = heads(k * k_k)
        kk = kk * lax.rsqrt(jnp.sum(kk * kk, axis=-1, keepdims=True) + 1e-12)

        def direction(lw, la, i):
            z = w0[i] + jnp.tanh(lw) @ w2[i]
            decay = jnp.exp(-jnp.exp(-jax.nn.softplus(-z) - 0.5))
            a = jax.nn.sigmoid(a0[i] + la @ a2[i])
            return heads(decay), heads(k * (1.0 + (a - 1.0) * k_a)), heads(a)

        return (heads(r), heads(k), heads(v), kk, jax.nn.sigmoid(lg) @ g2,
                direction(lwf, laf, 0), direction(lwb, lab, 1))

    rc, kc, vc, kkc, gc, fc, bc = prep(pc)
    rx, kx, vx, kkx, gx, fx, bx = prep(px)
    zero = jnp.zeros((pc.shape[0], RWKV_HEADS, RWKV_N, RWKV_N), jnp.float32)

    def args(r, v, kk, d):
        decay, kd, a = d
        return (r, decay, kd, v, kk, a)

    oc_f, ox_f = run_direction(rwkv7_scan, args(rc, vc, kkc, fc), args(rx, vx, kkx, fx), zero, False)
    oc_b, ox_b = run_direction(rwkv7_scan, args(rc, vc, kkc, bc), args(rx, vx, kkx, bx), zero, True)
    gn_g = ln_g.reshape(RWKV_HEADS, RWKV_N)
    gn_b = ln_b.reshape(RWKV_HEADS, RWKV_N)

    def out(o, r, k, v, g):
        mu = jnp.mean(o, axis=-1, keepdims=True)
        var = jnp.mean(jnp.square(o - mu), axis=-1, keepdims=True)
        o = (o - mu) * lax.rsqrt(var + RWKV_GN_EPS) * gn_g + gn_b
        o = o + jnp.sum(r * k * r_k, axis=-1, keepdims=True) * v
        B, T = o.shape[:2]
        return o.reshape(B, T, RWKV_W) * g

    oc = out(oc_f + oc_b, rc, kc, vc, gc) if with_ctx_out else None
    return oc, out(ox_f + ox_b, rx, kx, vx, gx)


def swiglu(h, w_gate, w_up, w_down):
    return (jax.nn.silu(h @ w_gate) * (h @ w_up)) @ w_down


def setup_inputs(seed: int = 0) -> dict:
    key = jax.random.key(seed)
    ks = iter(jax.random.split(key, 40))
    nrm = lambda shape, scale: scale * jax.random.normal(next(ks), shape, jnp.float32)
    L, D = DEPTH, D_MODEL
    shift_base = jnp.array([0.25, 0.5, 0.25], jnp.float32)[None, :, None]
    return {
        'x': nrm((BATCH, SEQ, D), 1.0),
        'c': nrm((BATCH, D), 1.0),
        'ctx': nrm((BATCH, CTX_LEN, D), 1.0),
        'c_ctx': nrm((D,), 1.0),
        'ada_w': nrm((L, D, 6 * D), 0.5 * D ** -0.5),
        'ada_b': nrm((L, 6 * D), 0.02),
        'norm_mix_g': 1.0 + nrm((L, D), 0.05),
        'norm_ffn_g': 1.0 + nrm((L, D), 0.05),
        'w_in': nrm((L, D, IN_COLS), D ** -0.5),
        'w_out': nrm((L, MIX_W, D), MIX_W ** -0.5),
        'gla_decay_w': nrm((L, 2, GLA_RANK, GLA_HEADS * GLA_DK), GLA_RANK ** -0.5),
        'gla_decay_b': nrm((L, 2, GLA_HEADS * GLA_DK), 0.1),
        'gla_norm_g': 1.0 + nrm((L, GLA_DV), 0.05),
        'swa_sink': nrm((L, SWA_HEADS), 0.5),
        'rwkv_shift_w': shift_base + nrm((L, 3, RWKV_COLS), 0.05),
        'rwkv_w0': -1.0 + nrm((L, 2, RWKV_W), 0.5),
        'rwkv_w2': nrm((L, 2, RWKV_W_RANK, RWKV_W), RWKV_W_RANK ** -0.5),
        'rwkv_a0': nrm((L, 2, RWKV_W), 0.1),
        'rwkv_a2': nrm((L, 2, RWKV_A_RANK, RWKV_W), RWKV_A_RANK ** -0.5),
        'rwkv_g2': nrm((L, RWKV_G_RANK, RWKV_W), RWKV_G_RANK ** -0.5),
        'rwkv_k_k': 0.85 + nrm((L, RWKV_W), 0.05),
        'rwkv_k_a': 1.0 + nrm((L, RWKV_W), 0.05),
        'rwkv_r_k': nrm((L, RWKV_HEADS, RWKV_N), 0.1),
        'rwkv_ln_g': 1.0 + nrm((L, RWKV_W), 0.05),
        'rwkv_ln_b': nrm((L, RWKV_W), 0.02),
        'ffn_w_gate': nrm((L, D, D_FF), D ** -0.5),
        'ffn_w_up': nrm((L, D, D_FF), D ** -0.5),
        'ffn_w_down': nrm((L, D_FF, D), D_FF ** -0.5),
        'final_norm_g': 1.0 + nrm((D,), 0.05),
    }


def reference(x, c, ctx, c_ctx, ada_w, ada_b, norm_mix_g, norm_ffn_g, w_in, w_out,
              gla_decay_w, gla_decay_b, gla_norm_g, swa_sink,
              rwkv_shift_w, rwkv_w0, rwkv_w2, rwkv_a0, rwkv_a2, rwkv_g2, rwkv_k_k, rwkv_k_a,
              rwkv_r_k, rwkv_ln_g, rwkv_ln_b, ffn_w_gate, ffn_w_up, ffn_w_down, final_norm_g):
    T = x.shape[1]
    cos, sin = axial_rope(T)
    xc, xx = ctx, x
    for l in range(DEPTH):
        with_ctx_out = l < DEPTH - 1
        mod_x = (jax.nn.silu(c) @ ada_w[l] + ada_b[l])[:, None, :]
        mod_c = (jax.nn.silu(c_ctx) @ ada_w[l] + ada_b[l])[None, None, :]
        sh1x, sc1x, g1x, sh2x, sc2x, g2x = jnp.split(mod_x, 6, axis=-1)
        sh1c, sc1c, g1c, sh2c, sc2c, g2c = jnp.split(mod_c, 6, axis=-1)

        hx = modulate(rmsnorm(xx, norm_mix_g[l]), sh1x, sc1x)
        hc = modulate(rmsnorm(xc, norm_mix_g[l]), sh1c, sc1c)
        px = (hx @ w_in[l]).astype(jnp.float32)
        pc = (hc @ w_in[l]).astype(jnp.float32)
        px_a, px_b, px_c = _split(px, (GLA_COLS, SWA_COLS, RWKV_COLS))
        pc_a, pc_b, pc_c = _split(pc, (GLA_COLS, SWA_COLS, RWKV_COLS))
        oa_c, oa_x = gla_group(pc_a, px_a, gla_decay_w[l], gla_decay_b[l], gla_norm_g[l], with_ctx_out)
        ob_c, ob_x = swa_group(pc_b, px_b, swa_sink[l], cos, sin, with_ctx_out)
        oc_c, oc_x = rwkv_group(pc_c, px_c, rwkv_shift_w[l], rwkv_w0[l], rwkv_w2[l], rwkv_a0[l],
                                rwkv_a2[l], rwkv_g2[l], rwkv_k_k[l], rwkv_k_a[l], rwkv_r_k[l],
                                rwkv_ln_g[l], rwkv_ln_b[l], with_ctx_out)
        mix_x = jnp.concatenate([oa_x, ob_x, oc_x], axis=-1).astype(x.dtype) @ w_out[l]
        xx = xx + g1x * mix_x
        hx = modulate(rmsnorm(xx, norm_ffn_g[l]), sh2x, sc2x)
        xx = xx + g2x * swiglu(hx, ffn_w_gate[l], ffn_w_up[l], ffn_w_down[l])

        if with_ctx_out:
            mix_c = jnp.concatenate([oa_c, ob_c, oc_c], axis=-1).astype(x.dtype) @ w_out[l]
            xc = xc + g1c * mix_c
            hc = modulate(rmsnorm(xc, norm_ffn_g[l]), sh2c, sc2c)
            xc = xc + g2c * swiglu(hc, ffn_w_gate[l], ffn_w_up[l], ffn_w_down[l])
    return rmsnorm(xx, final_norm_g)
```

```cpp
#include <hip/hip_runtime.h>
#include <hip/hip_cooperative_groups.h>
#include <cstdio>
#include <cstdint>
namespace cg = cooperative_groups;
namespace pg8 {
#define PG8_LAS __attribute__((address_space(3)))
typedef unsigned short bf16_t;
typedef short bf16x8 __attribute__((ext_vector_type(8)));
typedef float f32x4 __attribute__((ext_vector_type(4)));
typedef unsigned u32x4 __attribute__((ext_vector_type(4)));
constexpr int BM = 256, BK = 64, HALF = 128, HTB = HALF * BK * 2  , STAGE_BYTES = 8 * HTB, NXCD = 8, WGM = 8;

__host__ __device__ __forceinline__ int lds_byte(int r, int c) { const int st = (r >> 4) * 2 + (c >> 5), rr = r & 15, cc = c & 31, ob = rr * 64 + cc * 2; return st * 1024 + (ob ^ (((ob >> 9) & 1) << 5)); }
__host__ __device__ __forceinline__ void stage_rc(int b, int& R, int& C) { const int st = b / 1024, sb = b % 1024, swz = sb ^ (((sb >> 9) & 1) << 5); R = (st >> 1) * 16 + swz / 64; C = (st & 1) * 32 + (swz % 64) / 2; }
__host__ __device__ __forceinline__ int perm32(int rho) { const int n = rho >> 4, i = rho & 15; return 8 * (i >> 2) + 4 * n + (i & 3); }

struct Unit { int pm, pn; };
struct Gemm { const bf16_t* A; const bf16_t* Bt; int M, N, K; };

struct StaticOrder {
    int nM, nN, nwg, G, c;
    __host__ __device__ void init(int M, int N, int G_, int c_) { nM = M / BM; nN = N / BM; nwg = nM * nN; G = G_; c = c_; }
    __host__ __device__ bool next(int i, Unit& u) const {
        const long L = (long)i * G + c; if (L >= nwg) return false;
        int wgid = (int)L; { const int q = nwg / NXCD, r = nwg % NXCD, xcd = wgid % NXCD, off = wgid / NXCD; wgid = (xcd < r ? xcd * (q + 1) : r * (q + 1) + (xcd - r) * q) + off; }
        const int nig = WGM * nN, gid = wgid / nig, fm = gid * WGM, gsz = (nM - fm) < WGM ? (nM - fm) : WGM;
        u.pm = fm + ((wgid % nig) % gsz); u.pn = (wgid % nig) / gsz; return true;
    }
    __device__ __forceinline__ void a_ready(const Unit&) const {}
    __device__ __forceinline__ void done(const Unit&) const {}
};

__device__ __forceinline__ unsigned cvt_pk_bf16(float lo, float hi) { unsigned r; asm volatile("v_cvt_pk_bf16_f32 %0, %1, %2" : "=v"(r) : "v"(lo), "v"(hi)); return r; }
typedef float f32x2 __attribute__((ext_vector_type(2)));
constexpr int EP_ML = 32768;
struct EpiIn {
    static constexpr bool PERM = true, AFTER_DRAIN = false;
    bf16_t* O0; bf16_t* O1;
    __device__ __forceinline__ void operator()(const f32x4 (&acc)[2][2][4][2], const Unit& u, int wr, int wc, int fr, int fq) const {
        const int row0 = u.pm * BM + wr * 64 + fr;
#pragma unroll
        for (int bj = 0; bj < 2; ++bj) {
            const int c0 = u.pn * BM + bj * HALF + wc * 32 + 8 * fq;
            bf16_t* base; size_t ld; int cc; bool ok = true;
            if (c0 < 1568) { base = O0; ld = 1568; cc = c0; } else if (c0 < 2720) { base = O1; ld = 1152; cc = c0 - 1568; } else { base = O0; ld = 0; cc = 0; ok = false; }
            if (ok) {
#pragma unroll
            for (int ai = 0; ai < 2; ++ai)
#pragma unroll
                for (int m = 0; m < 4; ++m) {
                    const f32x4 v0 = acc[ai][bj][m][0], v1 = acc[ai][bj][m][1];
                    u32x4 w; w.x = cvt_pk_bf16(v0[0], v0[1]); w.y = cvt_pk_bf16(v0[2], v0[3]); w.z = cvt_pk_bf16(v1[0], v1[1]); w.w = cvt_pk_bf16(v1[2], v1[3]);
                    *(u32x4*)(base + (size_t)(row0 + ai * HALF + m * 16) * ld + cc) = w;
                }
            }
        }
    }
};
struct EpiRes {
    static constexpr bool PERM = true, AFTER_DRAIN = false;
    const float* srcL; float* dstL; const float* srcC; float* dstC; const float* gate;
    __device__ __forceinline__ void operator()(const f32x4 (&acc)[2][2][4][2], const Unit& u, int wr, int wc, int fr, int fq) const {
        const int rowt = u.pm * BM;
        const bool lat = rowt < EP_ML;
        const float* src = lat ? srcL : srcC; float* dst = lat ? dstL : dstC;
        const float* g = gate + (lat ? (rowt >> 12) : 8) * 6144; const int rb = lat ? rowt : rowt - EP_ML;
        const int col0 = u.pn * BM + wc * 32 + 8 * fq;
#pragma unroll
        for (int bj = 0; bj < 2; ++bj) {
            const f32x4 g0 = *(const f32x4*)(g + col0 + bj * HALF), g1 = *(const f32x4*)(g + col0 + bj * HALF + 4);
#pragma unroll
            for (int ai = 0; ai < 2; ++ai)
#pragma unroll
                for (int m = 0; m < 4; ++m) { const size_t off = (size_t)(rb + ai * HALF + wr * 64 + m * 16 + fr) * 1024 + col0 + bj * HALF;
                    const f32x4 s0 = *(const f32x4*)(src + off), s1 = *(const f32x4*)(src + off + 4);
                    *(f32x4*)(dst + off) = s0 + g0 * acc[ai][bj][m][0]; *(f32x4*)(dst + off + 4) = s1 + g1 * acc[ai][bj][m][1]; }
        }
    }
};
struct EpiSwiglu {
    static constexpr bool PERM = true, AFTER_DRAIN = false;
    bf16_t* O0;
    __device__ __forceinline__ void operator()(const f32x4 (&acc)[2][2][4][2], const Unit& u, int wr, int wc, int fr, int fq) const {
        const int row0 = u.pm * BM + wr * 64 + fr, col = u.pn * HALF + wc * 32 + 8 * fq;
#pragma unroll
        for (int ai = 0; ai < 2; ++ai)
#pragma unroll
            for (int m = 0; m < 4; ++m) {
                float h[8];
#pragma unroll
                for (int n = 0; n < 2; ++n)
#pragma unroll
                    for (int e = 0; e < 4; ++e) { const float gt = acc[ai][0][m][n][e], up = acc[ai][1][m][n][e]; h[n * 4 + e] = gt * up * __builtin_amdgcn_rcpf(1.0f + __expf(-gt)); }
                u32x4 w; w.x = cvt_pk_bf16(h[0], h[1]); w.y = cvt_pk_bf16(h[2], h[3]); w.z = cvt_pk_bf16(h[4], h[5]); w.w = cvt_pk_bf16(h[6], h[7]);
                *(u32x4*)(O0 + (size_t)(row0 + ai * HALF + m * 16) * 2816 + col) = w;
            }
    }
};
template <class Epi, class Sched, bool ALIGN_EPI = false, bool SP2 = false>
__device__ __forceinline__ void gemm_phase(PG8_LAS unsigned char* lds, const Gemm g, const Sched& S, const Epi& E, int tid_in) {
    const int tid = tid_in, wid = __builtin_amdgcn_readfirstlane(tid >> 6), lane = tid & 63, wr = wid >> 2, wc = wid & 3, fr = lane & 15, fq = lane >> 4;
    const int K = g.K, nt = K / BK;
    unsigned voffA[2], voffB[2];
#pragma unroll
    for (int i = 0; i < 2; ++i) { int R, C; stage_rc(tid * 16 + i * 8192, R, C); const int Rb = Epi::PERM ? ((R & ~31) + perm32(R & 31)) : R;
        voffA[i] = (unsigned)(R * K + C) * 2u; voffB[i] = (unsigned)(Rb * K + C) * 2u; }
    const size_t kstep = (size_t)(BK * 2);
    const size_t hstep = (size_t)HALF * K * 2;
    const size_t tstep = 2 * hstep;
    const unsigned ldsw = (unsigned)wid * 1024u;
    const int aoff = lds_byte(wr * 64 + fr, fq * 8), boff = lds_byte(wc * 32 + fr, fq * 8);
#define PG8_SA(b, h) (((b) * 2 + (h)) * HTB)
#define PG8_SB(b, h) ((4 + (b) * 2 + (h)) * HTB)
#define PG8_STAGE(bufoff, gbase, voff) do { _Pragma("unroll") for (int _i = 0; _i < 2; ++_i) \
        __builtin_amdgcn_global_load_lds((const unsigned*)((const char*)(gbase) + (voff)[_i]), (PG8_LAS unsigned*)(lds + (bufoff) + ldsw + _i * 8192), 16, 0, 0); } while (0)
#define PG8_LDA(dst, b, h) do { _Pragma("unroll") for (int m = 0; m < 4; ++m) _Pragma("unroll") for (int k = 0; k < 2; ++k) dst[m][k] = *(const PG8_LAS bf16x8*)(lds + PG8_SA(b, h) + aoff + m * 2048 + k * 1024); } while (0)
#define PG8_LDB(dst, b, h) do { _Pragma("unroll") for (int n = 0; n < 2; ++n) _Pragma("unroll") for (int k = 0; k < 2; ++k) dst[n][k] = *(const PG8_LAS bf16x8*)(lds + PG8_SB(b, h) + boff + n * 2048 + k * 1024); } while (0)
#define PG8_MMA(ai, bj, At, Bt) do { __builtin_amdgcn_s_setprio(1); _Pragma("unroll") for (int m = 0; m < 4; ++m) _Pragma("unroll") for (int n = 0; n < 2; ++n) _Pragma("unroll") for (int k = 0; k < 2; ++k) \
        acc[ai][bj][m][n] = __builtin_amdgcn_mfma_f32_16x16x32_bf16(Bt[n][k], At[m][k], acc[ai][bj][m][n], 0, 0, 0); __builtin_amdgcn_s_setprio(0); } while (0)
#define PG8_WAIT_V(n) asm volatile("s_waitcnt vmcnt(" #n ")" ::: "memory")
#define PG8_WAIT_L(n) asm volatile("s_waitcnt lgkmcnt(" #n ")" ::: "memory")
#define PG8_BAR __builtin_amdgcn_s_barrier()
#define PG8_SCHED __builtin_amdgcn_sched_barrier(0)
    Unit cur, nxt; int ui = 0;
    if (!S.next(0, cur)) return;
    f32x4 acc[2][2][4][2];
#pragma unroll
    for (int a = 0; a < 2; ++a)
#pragma unroll
        for (int b = 0; b < 2; ++b)
#pragma unroll
            for (int m = 0; m < 4; ++m)
#pragma unroll
                for (int n = 0; n < 2; ++n) acc[a][b][m][n] = (f32x4){0.f, 0.f, 0.f, 0.f};
    bf16x8 At[4][2], B0[2][2], B1[2][2];
    const char* cA = (const char*)g.A + (size_t)cur.pm * tstep; const char* cB = (const char*)g.Bt + (size_t)cur.pn * tstep;
    S.a_ready(cur);
    if constexpr (SP2) {
        PG8_STAGE(PG8_SB(0, 0), cB, voffB); PG8_STAGE(PG8_SB(0, 1), cB + hstep, voffB); PG8_STAGE(PG8_SA(0, 0), cA, voffA); PG8_STAGE(PG8_SA(0, 1), cA + hstep, voffA);
        if (wr == 1) PG8_BAR;
        PG8_WAIT_V(2); PG8_BAR;
        PG8_STAGE(PG8_SB(1, 0), cB + kstep, voffB); PG8_STAGE(PG8_SA(1, 0), cA + kstep, voffA); PG8_STAGE(PG8_SB(1, 1), cB + hstep + kstep, voffB);
        PG8_WAIT_V(6); PG8_BAR;
    } else {
        PG8_STAGE(PG8_SB(0, 0), cB, voffB); PG8_STAGE(PG8_SA(0, 0), cA, voffA); PG8_STAGE(PG8_SB(0, 1), cB + hstep, voffB); PG8_STAGE(PG8_SA(0, 1), cA + hstep, voffA);
        if (wr == 1) PG8_BAR;
        PG8_WAIT_V(4); PG8_BAR;
        PG8_STAGE(PG8_SB(1, 0), cB + kstep, voffB); PG8_STAGE(PG8_SA(1, 0), cA + kstep, voffA); PG8_STAGE(PG8_SB(1, 1), cB + hstep + kstep, voffB);
        PG8_WAIT_V(6); PG8_BAR;
    }
    for (;;) {
        const bool has_next = S.next(ui + 1, nxt);
        const char* nA = has_next ? (const char*)g.A + (size_t)nxt.pm * tstep : cA; const char* nB = has_next ? (const char*)g.Bt + (size_t)nxt.pn * tstep : cB;
        for (int t = 0; t < nt; t += 2) {
            const bool last = (t == nt - 2);
            const char* a1 = cA + (size_t)(t + 1) * kstep;
            const char* a2 = last ? nA : cA + (size_t)(t + 2) * kstep; const char* b2 = last ? nB : cB + (size_t)(t + 2) * kstep;
            const char* a3 = a2 + kstep; const char* b3 = b2 + kstep;
            if (last && has_next) S.a_ready(nxt);
            if constexpr (SP2) {
            PG8_LDB(B0, 0, 0); PG8_LDB(B1, 0, 1); PG8_SCHED; PG8_LDA(At, 0, 0); PG8_STAGE(PG8_SA(1, 1), a1 + hstep, voffA);
            PG8_WAIT_V(8); PG8_WAIT_L(0); PG8_BAR; PG8_MMA(0, 0, At, B0); PG8_MMA(0, 1, At, B1); PG8_BAR; PG8_SCHED;
            PG8_LDA(At, 0, 1); PG8_STAGE(PG8_SB(0, 0), b2, voffB); PG8_STAGE(PG8_SB(0, 1), b2 + hstep, voffB); PG8_STAGE(PG8_SA(0, 0), a2, voffA);
            PG8_WAIT_V(8); PG8_WAIT_L(0); PG8_BAR; PG8_MMA(1, 0, At, B0); PG8_MMA(1, 1, At, B1); PG8_BAR; PG8_SCHED;
            PG8_LDB(B0, 1, 0); PG8_LDB(B1, 1, 1); PG8_SCHED; PG8_LDA(At, 1, 0); PG8_STAGE(PG8_SA(0, 1), a2 + hstep, voffA);
            PG8_WAIT_V(8); PG8_WAIT_L(0); PG8_BAR; PG8_MMA(0, 0, At, B0); PG8_MMA(0, 1, At, B1); PG8_BAR; PG8_SCHED;
            PG8_LDA(At, 1, 1); PG8_STAGE(PG8_SB(1, 0), b3, voffB); PG8_STAGE(PG8_SB(1, 1), b3 + hstep, voffB); PG8_STAGE(PG8_SA(1, 0), a3, voffA);
            PG8_WAIT_V(8); PG8_WAIT_L(0); PG8_BAR; PG8_MMA(1, 0, At, B0); PG8_MMA(1, 1, At, B1); PG8_BAR; PG8_SCHED;
            } else {
            PG8_LDB(B0, 0, 0); PG8_SCHED; PG8_LDA(At, 0, 0); PG8_STAGE(PG8_SA(1, 1), a1 + hstep, voffA);
            PG8_WAIT_L(8); PG8_BAR; PG8_WAIT_L(0); PG8_MMA(0, 0, At, B0); PG8_BAR; PG8_SCHED;
            PG8_LDB(B1, 0, 1); PG8_STAGE(PG8_SB(0, 0), b2, voffB);
            PG8_BAR; PG8_WAIT_L(0); PG8_MMA(0, 1, At, B1); PG8_BAR;
            PG8_LDA(At, 0, 1); PG8_STAGE(PG8_SA(0, 0), a2, voffA);
            PG8_BAR; PG8_WAIT_L(0); PG8_MMA(1, 0, At, B0); PG8_BAR; PG8_SCHED;
            PG8_STAGE(PG8_SB(0, 1), b2 + hstep, voffB);
            PG8_WAIT_V(6); PG8_BAR; PG8_MMA(1, 1, At, B1); PG8_BAR;
            PG8_LDB(B0, 1, 0); PG8_SCHED; PG8_LDA(At, 1, 0); PG8_STAGE(PG8_SA(0, 1), a2 + hstep, voffA);
            PG8_WAIT_L(8); PG8_BAR; PG8_WAIT_L(0); PG8_MMA(0, 0, At, B0); PG8_BAR; PG8_SCHED;
            PG8_LDB(B1, 1, 1); PG8_STAGE(PG8_SB(1, 0), b3, voffB);
            PG8_BAR; PG8_WAIT_L(0); PG8_MMA(0, 1, At, B1); PG8_BAR;
            PG8_LDA(At, 1, 1); PG8_STAGE(PG8_SA(1, 0), a3, voffA);
            PG8_BAR; PG8_WAIT_L(0); PG8_MMA(1, 0, At, B0); PG8_BAR; PG8_SCHED;
            PG8_STAGE(PG8_SB(1, 1), b3 + hstep, voffB);
            PG8_WAIT_V(6); PG8_BAR; PG8_MMA(1, 1, At, B1); PG8_BAR;
            }
        }
        if constexpr (ALIGN_EPI) { if (wr == 0) PG8_BAR; }
        if constexpr (!Epi::AFTER_DRAIN) { E(acc, cur, wr, wc, fr, fq); S.done(cur); }
        if (!has_next) break;
#pragma unroll
        for (int a = 0; a < 2; ++a)
#pragma unroll
            for (int b = 0; b < 2; ++b)
#pragma unroll
                for (int m = 0; m < 4; ++m)
#pragma unroll
                    for (int n = 0; n < 2; ++n) acc[a][b][m][n] = (f32x4){0.f, 0.f, 0.f, 0.f};
        cur = nxt; cA = nA; cB = nB; ++ui;
        if constexpr (ALIGN_EPI) { if (wr == 1) PG8_BAR; }
    }
    PG8_WAIT_V(0);
    if constexpr (!ALIGN_EPI) { if (wr == 0) PG8_BAR; }
    PG8_BAR;
    if constexpr (Epi::AFTER_DRAIN) { E.fused(acc, cur, wr, wc, fr, fq, lds, wid, lane); S.done(cur); }
#undef PG8_SA
#undef PG8_SB
#undef PG8_STAGE
#undef PG8_LDA
#undef PG8_LDB
#undef PG8_MMA
#undef PG8_WAIT_V
#undef PG8_WAIT_L
#undef PG8_BAR
#undef PG8_SCHED
}
}
#define LAS __attribute__((address_space(3)))
typedef unsigned short bf16_t;
typedef _Float16 hf;
typedef _Float16 h8 __attribute__((ext_vector_type(8)));
typedef _Float16 h4 __attribute__((ext_vector_type(4)));
typedef unsigned u32x4 __attribute__((ext_vector_type(4)));
typedef unsigned u32x2 __attribute__((ext_vector_type(2)));
typedef float f32x4 __attribute__((ext_vector_type(4)));
typedef short bf16x8 __attribute__((ext_vector_type(8)));

constexpr int DM = 1024, NB = 8, SEQ = 4096, CTXL = 256, NLAYER = 4;
constexpr int ML = NB * SEQ, MC = NB * CTXL, MT = ML + MC;
constexpr int INC = 2720, INP = 2816, P1C = 1568, RAWC = 1152, FF = 2816;
constexpr int PRC = 2304, PGC = 512;
constexpr int NTHREADS = 512, NWAVES = 8;
constexpr int LDS_BYTES = 147456;
constexpr size_t MiB = 1u << 20;
constexpr size_t WS_CTL = 0, WS_MOD = 1 * MiB, WS_ROPE = 2 * MiB, WS_BONUS = 3 * MiB, WS_WT = 4 * MiB, WS_XC = 28 * MiB, WS_XN = 36 * MiB,
                 WS_P1 = 104 * MiB, WS_RAW = 209 * MiB, WS_PREP = 286 * MiB, WS_PG = 439 * MiB, WS_GG = 473 * MiB, WS_END = 490 * MiB;
constexpr size_t WS_H = 104 * MiB;
constexpr size_t WS_OR = 209 * MiB, WS_OG = 243 * MiB;
constexpr size_t WT_IN = 0, WT_OUT = (size_t)INP * DM * 2, WT_GU = WT_OUT + (size_t)DM * DM * 2, WT_DN = WT_GU + (size_t)2 * FF * DM * 2;
static_assert(WT_DN + (size_t)DM * FF * 2 == 24 * MiB, "wt");
static_assert(WS_P1 + (size_t)MT * P1C * 2 <= WS_RAW && WS_RAW + (size_t)MT * RAWC * 2 <= WS_PREP && WS_PREP + (size_t)MT * PRC * 2 <= WS_PG && WS_PG + (size_t)MT * PGC * 2 <= WS_GG && WS_GG + (size_t)MT * 256 * 2 <= WS_END, "ws map");
static_assert(WS_OG + (size_t)2 * MT * 256 * 2 <= WS_PREP && WS_H + (size_t)MT * FF * 2 <= WS_PG && WS_XN + (size_t)MT * DM * 2 <= WS_P1, "ws overlay");

struct Params { const float* in[29]; float* out; unsigned char* ws; };
typedef const __attribute__((address_space(4))) Params* kparams_t;

__device__ __forceinline__ float bf2f(unsigned b) { return __uint_as_float(b << 16); }
__device__ __forceinline__ unsigned f2bf(float f) { unsigned u = __float_as_uint(f); return (u + 0x7fffu + ((u >> 16) & 1u)) >> 16; }
__device__ __forceinline__ unsigned pk2(float lo, float hi) { return f2bf(lo) | (f2bf(hi) << 16); }
__device__ __forceinline__ float bflo(unsigned w) { return __uint_as_float(w << 16); }
__device__ __forceinline__ float bfhi(unsigned w) { return __uint_as_float(w & 0xffff0000u); }
__device__ __forceinline__ float wave_sum(float v) {
#pragma unroll
    for (int o = 1; o < 64; o <<= 1) v += __shfl_xor(v, o);
    return v;
}
__device__ __forceinline__ float sigmoidf_(float x) { return __builtin_amdgcn_rcpf(1.0f + __expf(-x)); }
__device__ __forceinline__ float softplusf_(float x) { return fmaxf(x, 0.f) + __logf(1.0f + __expf(-fabsf(x))); }
template <int CTRL> __device__ __forceinline__ float dpp_add(float x) {
    return x + __int_as_float(__builtin_amdgcn_update_dpp(0, __float_as_int(x), CTRL, 0xF, 0xF, true));
}
__device__ __forceinline__ float reduce4(float x) { x = dpp_add<0xB1>(x); x = dpp_add<0x4E>(x); return x; }
__device__ __forceinline__ float reduce8(float x) { x = dpp_add<0xB1>(x); x = dpp_add<0x4E>(x); x = dpp_add<0x141>(x); return x; }

__device__ __forceinline__ void phase_mod(unsigned char* lds, kparams_t p, int tid, int bid, int G) {
    float* sc = (float*)lds;
    float* part = (float*)(lds + 36864);
    const float* c = p->in[1]; const float* cctx = p->in[3]; const float* ada_w = p->in[4]; const float* ada_b = p->in[5];
    float* MOD = (float*)(p->ws + WS_MOD);
    for (int i = tid; i < 9 * 1024; i += NTHREADS) { const float x = i < 8192 ? c[i] : cctx[i - 8192]; sc[i] = x * sigmoidf_(x); }
    __syncthreads();
    const int cl = tid & 31, kg = tid >> 5;
    for (int item = bid; item < NLAYER * 192; item += G) {
        const int l = item / 192, cgp = item % 192, col = cgp * 32 + cl;
        float acc[9];
#pragma unroll
        for (int s = 0; s < 9; ++s) acc[s] = 0.f;
        const float* w = ada_w + ((size_t)l * 1024 + kg * 64) * 6144 + col;
#pragma unroll 4
        for (int kk = 0; kk < 64; ++kk) { const float wv = w[(size_t)kk * 6144];
#pragma unroll
            for (int s = 0; s < 9; ++s) acc[s] = fmaf(sc[s * 1024 + kg * 64 + kk], wv, acc[s]); }
#pragma unroll
        for (int s = 0; s < 9; ++s) part[(kg * 9 + s) * 32 + cl] = acc[s];
        __syncthreads();
        if (tid < 288) { const int s = tid >> 5; float a = ada_b[l * 6144 + col];
#pragma unroll
            for (int k2 = 0; k2 < 16; ++k2) a += part[(k2 * 9 + s) * 32 + cl];
            MOD[((size_t)l * 9 + s) * 6144 + col] = a; }
        __syncthreads();
    }
    float* RC = (float*)(p->ws + WS_ROPE); float* RS = RC + 4096 * 32;
    for (int idx = bid * NTHREADS + tid; idx < 4096 * 32; idx += G * NTHREADS) {
        const int t = idx >> 5, j = idx & 31; const float pos = (float)(j < 16 ? (t >> 6) : (t & 63));
        const float inv = exp2f(-(float)(j & 15) * (13.287712379549449f / 16.0f));
        const float ang = pos * inv; const float rev = ang * 0.15915494309189535f; const float fr = rev - floorf(rev);
        const float a2 = fr * 6.283185307179586f;
        RC[idx] = __cosf(a2); RS[idx] = __sinf(a2);
    }
}

__device__ __forceinline__ void transpose_item(const float* W, int K, int N, bf16_t* WT, int k0, int n0, int drow0, LAS float* scr, int lane) {
#pragma unroll 8
    for (int i = 0; i < 32; ++i) { const int kk = 2 * i + (lane >> 5); scr[kk * 33 + (lane & 31)] = W[(size_t)(k0 + kk) * N + n0 + (lane & 31)]; }
    asm volatile("s_waitcnt lgkmcnt(0)" ::: "memory");
    const int c = lane & 7;
#pragma unroll
    for (int j = 0; j < 4; ++j) { const int n = (lane >> 3) + 8 * j; const LAS float* s = scr + (8 * c) * 33 + n;
        u32x4 o; o.x = pk2(s[0 * 33], s[1 * 33]); o.y = pk2(s[2 * 33], s[3 * 33]); o.z = pk2(s[4 * 33], s[5 * 33]); o.w = pk2(s[6 * 33], s[7 * 33]);
        *(u32x4*)(WT + (size_t)(drow0 + n) * K + k0 + 8 * c) = o; }
    asm volatile("s_waitcnt lgkmcnt(0)" ::: "memory");
}
__device__ __forceinline__ void convert_weights(unsigned char* lds, kparams_t p, int l, int gw, int ngw, int wave, int lane) {
    LAS float* scr = (LAS float*)((LAS unsigned char*)lds + wave * 16384);
    unsigned char* wt = p->ws + WS_WT;
    constexpr int I_IN = 16 * 85, I_OUT = 16 * 32, I_G = 16 * 88, I_D = 44 * 32;
    constexpr int NIT = I_IN + I_OUT + 2 * I_G + I_D;
    for (int it = gw; it < NIT; it += ngw) {
        int r = it;
        if (r < I_IN) { const int kb = r / 85, nb = r % 85; transpose_item(p->in[8] + (size_t)l * DM * INC, DM, INC, (bf16_t*)(wt + WT_IN), kb * 64, nb * 32, nb * 32, scr, lane); continue; } r -= I_IN;
        if (r < I_OUT) { const int kb = r / 32, nb = r % 32; transpose_item(p->in[9] + (size_t)l * DM * DM, DM, DM, (bf16_t*)(wt + WT_OUT), kb * 64, nb * 32, nb * 32, scr, lane); continue; } r -= I_OUT;
        if (r < I_G) { const int kb = r / 88, nb = r % 88, n0 = nb * 32; transpose_item(p->in[25] + (size_t)l * DM * FF, DM, FF, (bf16_t*)(wt + WT_GU), kb * 64, n0, (n0 >> 7) * 256 + (n0 & 127), scr, lane); continue; } r -= I_G;
        if (r < I_G) { const int kb = r / 88, nb = r % 88, n0 = nb * 32; transpose_item(p->in[26] + (size_t)l * DM * FF, DM, FF, (bf16_t*)(wt + WT_GU), kb * 64, n0, (n0 >> 7) * 256 + 128 + (n0 & 127), scr, lane); continue; } r -= I_G;
        { const int kb = r / 32, nb = r % 32; transpose_item(p->in[27] + (size_t)l * FF * DM, FF, DM, (bf16_t*)(wt + WT_DN), kb * 64, nb * 32, nb * 32, scr, lane); }
    }
}

__device__ __forceinline__ void norm_mod_rows(const float* srcL, const float* srcC, const float* gamma, const float* modl, int shoff, int scoff, bf16_t* XN, int nrows, int gw, int ngw, int lane) {
    for (int m = gw; m < nrows; m += ngw) {
        const float* xr = m < ML ? srcL + (size_t)m * DM : srcC + (size_t)(m - ML) * DM; const int s = m < ML ? (m >> 12) : 8;
        const float* md = modl + (size_t)s * 6144;
        f32x4 v[4]; float ss = 0.f;
#pragma unroll
        for (int j = 0; j < 4; ++j) { v[j] = ((const f32x4*)xr)[lane + 64 * j]; ss += (v[j].x * v[j].x + v[j].y * v[j].y) + (v[j].z * v[j].z + v[j].w * v[j].w); }
        const float rstd = rsqrtf(wave_sum(ss) * (1.0f / DM) + 1e-6f);
#pragma unroll
        for (int j = 0; j < 4; ++j) { const int c4 = lane + 64 * j; const f32x4 g = ((const f32x4*)gamma)[c4], sc = ((const f32x4*)(md + scoff))[c4], sh = ((const f32x4*)(md + shoff))[c4];
            const f32x4 y = (v[j] * rstd * g) * (sc + 1.0f) + sh; u32x2 o; o.x = pk2(y.x, y.y); o.y = pk2(y.z, y.w);
            ((u32x2*)(XN + (size_t)m * DM))[c4] = o; }
    }
}
__device__ __forceinline__ void final_norm_rows(float* x, const float* gamma, int gw, int ngw, int lane) {
    for (int m = gw; m < ML; m += ngw) {
        float* xr = x + (size_t)m * DM; f32x4 v[4]; float ss = 0.f;
#pragma unroll
        for (int j = 0; j < 4; ++j) { v[j] = ((const f32x4*)xr)[lane + 64 * j]; ss += (v[j].x * v[j].x + v[j].y * v[j].y) + (v[j].z * v[j].z + v[j].w * v[j].w); }
        const float rstd = rsqrtf(wave_sum(ss) * (1.0f / DM) + 1e-6f);
#pragma unroll
        for (int j = 0; j < 4; ++j) { const int c4 = lane + 64 * j; ((f32x4*)xr)[c4] = v[j] * rstd * ((const f32x4*)gamma)[c4]; }
    }
}
__device__ __forceinline__ void phase_prep(unsigned char* ldsg, kparams_t p, int l, int tid, int bid, int G) {
    LAS unsigned char* lds = (LAS unsigned char*)ldsg;
    LAS float* SH = (LAS float*)lds;
    LAS float* TL = (LAS float*)(lds + 73728);
    LAS float* KK = (LAS float*)(lds + 98304);
    LAS float* GL = (LAS float*)(lds + 114688);
    const int lane = tid & 63, wave = tid >> 6;
    bf16_t* P1 = (bf16_t*)(p->ws + WS_P1); const bf16_t* RAW = (const bf16_t*)(p->ws + WS_RAW);
    hf* PREP = (hf*)(p->ws + WS_PREP); hf* PG = (hf*)(p->ws + WS_PG); hf* GG = (hf*)(p->ws + WS_GG); float* BONUS = (float*)(p->ws + WS_BONUS);
    const float* RC = (const float*)(p->ws + WS_ROPE); const float* RS = RC + 4096 * 32;
    const float* shw = p->in[14] + (size_t)l * 3 * RAWC;
    const float* w0 = p->in[15] + (size_t)l * 512; const float* w2 = p->in[16] + (size_t)l * 2 * 64 * 256;
    const float* a0 = p->in[17] + (size_t)l * 512; const float* a2 = p->in[18] + (size_t)l * 2 * 64 * 256;
    const float* g2 = p->in[19] + (size_t)l * 128 * 256;
    const float* k_k = p->in[20] + l * 256; const float* k_a = p->in[21] + l * 256; const float* r_k = p->in[22] + l * 256;
    const float* dw = p->in[10] + (size_t)l * 2 * 16 * 128; const float* db = p->in[11] + l * 256;
    for (int tile = bid; tile < MT / 16; tile += G) {
        const int row0 = tile * 16; const bool lat = row0 < ML;
        const int t0 = lat ? (row0 & 4095) : ((row0 - ML) & 255); const int T = lat ? 4096 : 256;
        for (int task = tid; task < 16 * 144; task += NTHREADS) {
            const int tok = task / 144, c = (task % 144) * 8, t = t0 + tok; const size_t row = row0 + tok;
            const u32x4 z4 = {0u, 0u, 0u, 0u};
            const u32x4 cur = *(const u32x4*)(RAW + row * RAWC + c);
            const u32x4 prv = t > 0 ? *(const u32x4*)(RAW + (row - 1) * RAWC + c) : z4;
            const u32x4 nxt = t + 1 < T ? *(const u32x4*)(RAW + (row + 1) * RAWC + c) : z4;
#pragma unroll
            for (int e = 0; e < 4; ++e) {
                const float x0 = shw[c + 2 * e] * bflo(prv[e]) + shw[RAWC + c + 2 * e] * bflo(cur[e]) + shw[2 * RAWC + c + 2 * e] * bflo(nxt[e]);
                const float x1 = shw[c + 2 * e + 1] * bfhi(prv[e]) + shw[RAWC + c + 2 * e + 1] * bfhi(cur[e]) + shw[2 * RAWC + c + 2 * e + 1] * bfhi(nxt[e]);
                SH[tok * RAWC + c + 2 * e] = x0; SH[tok * RAWC + c + 2 * e + 1] = x1;
            }
        }
        { const int tok = tid >> 5, j = tid & 31; GL[j * 16 + tok] = bf2f(P1[(size_t)(row0 + tok) * P1C + 768 + j]); }
        __syncthreads();
        for (int idx = tid; idx < 16 * 384; idx += NTHREADS) {
            const int j = idx % 384, tok = idx / 384; const float x = SH[tok * RAWC + 768 + j];
            float y;
            if (j < 128) { const float e2 = __expf(2.0f * x); y = 1.0f - 2.0f * __builtin_amdgcn_rcpf(e2 + 1.0f); }
            else if (j < 256) y = x;
            else y = sigmoidf_(x);
            TL[j * 16 + tok] = y;
        }
#pragma unroll 1
        for (int i = 0; i < 8; ++i) {
            const int pair = wave * 8 + i, tok = pair >> 2, h = pair & 3, c = h * 64 + lane; const size_t row = row0 + tok;
            const float r = SH[tok * RAWC + c], k = SH[tok * RAWC + 256 + c], v = SH[tok * RAWC + 512 + c];
            const float val = k * k_k[c]; const float ss = wave_sum(val * val); const float kk = val * rsqrtf(ss + 1e-12f);
            KK[tok * 256 + c] = kk;
            const float bon = wave_sum(r * k * r_k[c]);
            if (lane == 0) BONUS[row * 4 + h] = bon;
            PREP[row * PRC + c] = (hf)r; PREP[row * PRC + 256 + c] = (hf)kk; PREP[row * PRC + 512 + c] = (hf)v;
        }
        __syncthreads();
        {
            const int c = tid & 255, th = tid >> 8;
#pragma unroll 1
            for (int i = 0; i < 2; ++i) {
                float acc[8];
#pragma unroll
                for (int q = 0; q < 8; ++q) acc[q] = 0.f;
                const float* W = w2 + (size_t)i * 64 * 256 + c;
#pragma unroll 4
                for (int j = 0; j < 64; ++j) { const float wv = W[j * 256]; const f32x4 ta = *(const LAS f32x4*)(TL + (i * 64 + j) * 16 + th * 8), tb = *(const LAS f32x4*)(TL + (i * 64 + j) * 16 + th * 8 + 4);
                    acc[0] = fmaf(ta.x, wv, acc[0]); acc[1] = fmaf(ta.y, wv, acc[1]); acc[2] = fmaf(ta.z, wv, acc[2]); acc[3] = fmaf(ta.w, wv, acc[3]);
                    acc[4] = fmaf(tb.x, wv, acc[4]); acc[5] = fmaf(tb.y, wv, acc[5]); acc[6] = fmaf(tb.z, wv, acc[6]); acc[7] = fmaf(tb.w, wv, acc[7]); }
                const float w0c = w0[i * 256 + c];
#pragma unroll
                for (int q = 0; q < 8; ++q) { const size_t row = row0 + th * 8 + q; const float z = w0c + acc[q];
                    const float dec = __expf(-__expf(-softplusf_(-z) - 0.5f)); PREP[row * PRC + 768 + i * 768 + c] = (hf)dec; }
#pragma unroll
                for (int q = 0; q < 8; ++q) acc[q] = 0.f;
                W = a2 + (size_t)i * 64 * 256 + c;
#pragma unroll 4
                for (int j = 0; j < 64; ++j) { const float wv = W[j * 256]; const f32x4 ta = *(const LAS f32x4*)(TL + (128 + i * 64 + j) * 16 + th * 8), tb = *(const LAS f32x4*)(TL + (128 + i * 64 + j) * 16 + th * 8 + 4);
                    acc[0] = fmaf(ta.x, wv, acc[0]); acc[1] = fmaf(ta.y, wv, acc[1]); acc[2] = fmaf(ta.z, wv, acc[2]); acc[3] = fmaf(ta.w, wv, acc[3]);
                    acc[4] = fmaf(tb.x, wv, acc[4]); acc[5] = fmaf(tb.y, wv, acc[5]); acc[6] = fmaf(tb.z, wv, acc[6]); acc[7] = fmaf(tb.w, wv, acc[7]); }
                const float a0c = a0[i * 256 + c], kac = k_a[c];
#pragma unroll
                for (int q = 0; q < 8; ++q) { const int tok = th * 8 + q; const size_t row = row0 + tok; const float a = sigmoidf_(a0c + acc[q]);
                    const float k = SH[tok * RAWC + 256 + c], kk = KK[tok * 256 + c];
                    PREP[row * PRC + 768 + i * 768 + 256 + c] = (hf)(kk * a); PREP[row * PRC + 768 + i * 768 + 512 + c] = (hf)(k * (1.0f + (a - 1.0f) * kac)); }
            }
            float acc[8];
#pragma unroll
            for (int q = 0; q < 8; ++q) acc[q] = 0.f;
            const float* W = g2 + c;
#pragma unroll 4
            for (int j = 0; j < 128; ++j) { const float wv = W[j * 256]; const f32x4 ta = *(const LAS f32x4*)(TL + (256 + j) * 16 + th * 8), tb = *(const LAS f32x4*)(TL + (256 + j) * 16 + th * 8 + 4);
                acc[0] = fmaf(ta.x, wv, acc[0]); acc[1] = fmaf(ta.y, wv, acc[1]); acc[2] = fmaf(ta.z, wv, acc[2]); acc[3] = fmaf(ta.w, wv, acc[3]);
                acc[4] = fmaf(tb.x, wv, acc[4]); acc[5] = fmaf(tb.y, wv, acc[5]); acc[6] = fmaf(tb.z, wv, acc[6]); acc[7] = fmaf(tb.w, wv, acc[7]); }
#pragma unroll
            for (int q = 0; q < 8; ++q) GG[(size_t)(row0 + th * 8 + q) * 256 + c] = (hf)acc[q];
        }
        {
            const int c = tid & 127, i = (tid >> 7) & 1, th = tid >> 8;
            float acc[8]; const float bb = db[i * 128 + c];
#pragma unroll
            for (int q = 0; q < 8; ++q) acc[q] = bb;
            const float* W = dw + (size_t)i * 16 * 128 + c;
#pragma unroll
            for (int j = 0; j < 16; ++j) { const float wv = W[j * 128]; const f32x4 ta = *(const LAS f32x4*)(GL + (i * 16 + j) * 16 + th * 8), tb = *(const LAS f32x4*)(GL + (i * 16 + j) * 16 + th * 8 + 4);
                acc[0] = fmaf(ta.x, wv, acc[0]); acc[1] = fmaf(ta.y, wv, acc[1]); acc[2] = fmaf(ta.z, wv, acc[2]); acc[3] = fmaf(ta.w, wv, acc[3]);
                acc[4] = fmaf(tb.x, wv, acc[4]); acc[5] = fmaf(tb.y, wv, acc[5]); acc[6] = fmaf(tb.z, wv, acc[6]); acc[7] = fmaf(tb.w, wv, acc[7]); }
#pragma unroll
            for (int q = 0; q < 8; ++q) { const float glog = -softplusf_(-acc[q]) * (1.0f / 16.0f); PG[(size_t)(row0 + th * 8 + q) * PGC + 256 + i * 128 + c] = (hf)__expf(glog); }
            for (int idx = tid; idx < 16 * 256; idx += NTHREADS) { const int tok = idx >> 8, cc = idx & 255; float x = bf2f(P1[(size_t)(row0 + tok) * P1C + cc]);
                if (cc < 128) x *= 0.17677669529663687f; PG[(size_t)(row0 + tok) * PGC + cc] = (hf)x; }
        }
        if (lat) {
            for (int task = tid; task < 640; task += NTHREADS) {
                const int tok = task / 40, r = task % 40, hh = r >> 2, gi = r & 3; const int t = t0 + tok;
                bf16_t* ptr = P1 + (size_t)(row0 + tok) * P1C + 800 + hh * 64 + gi * 8;
                const u32x4 x1 = *(const u32x4*)ptr, x2 = *(const u32x4*)(ptr + 32);
                const float* cs = RC + t * 32 + gi * 8; const float* sn = RS + t * 32 + gi * 8;
                u32x4 o1, o2;
#pragma unroll
                for (int e = 0; e < 4; ++e) {
                    const float a0_ = bflo(x1[e]), a1_ = bfhi(x1[e]), b0_ = bflo(x2[e]), b1_ = bfhi(x2[e]);
                    const float c0_ = cs[2 * e], c1_ = cs[2 * e + 1], s0_ = sn[2 * e], s1_ = sn[2 * e + 1];
                    o1[e] = pk2(a0_ * c0_ - b0_ * s0_, a1_ * c1_ - b1_ * s1_); o2[e] = pk2(a0_ * s0_ + b0_ * c0_, a1_ * s1_ + b1_ * c1_);
                }
                *(u32x4*)ptr = o1; *(u32x4*)(ptr + 32) = o2;
            }
        }
        __syncthreads();
    }
}
__device__ __forceinline__ int chain_row(int b, int dir, int s) {
    if (s < 256) return ML + b * 256 + (dir ? 255 - s : s);
    const int t = s - 256; return b * 4096 + (dir ? 4095 - t : t);
}
constexpr int NCHUNK = (SEQ + CTXL) / 32;
__device__ __forceinline__ void rwkv_scan_item(unsigned char* ldsg, kparams_t p, int item, int tid) {
    LAS unsigned char* lds = (LAS unsigned char*)ldsg;
    constexpr int STEPB = 704, BUFB = 32 * STEPB, NPIECE = 32 * 44;
    LAS unsigned char* obuf = lds + 2 * BUFB;
    const int chain = item >> 1, half_ = item & 1, b = chain >> 3, h = (chain >> 1) & 3, dir = chain & 1;
    const int lane = tid & 63, wave = tid >> 6, kq = lane & 7, rloc = (wave & 3) * 8 + (lane >> 3);
    const hf* PREP = (const hf*)(p->ws + WS_PREP); hf* OR = (hf*)(p->ws + WS_OR) + (size_t)dir * MT * 256;
    int srcoff[6]; srcoff[0] = h * 64; srcoff[1] = 256 + h * 64; srcoff[2] = 768 + dir * 768 + h * 64; srcoff[3] = srcoff[2] + 256; srcoff[4] = srcoff[2] + 512; srcoff[5] = 512 + h * 64 + half_ * 32;
    float S[8];
#pragma unroll
    for (int i = 0; i < 8; ++i) S[i] = 0.f;
    u32x4 pre[3];
#define RW_ISSUE(cc) do { _Pragma("unroll") for (int i_ = 0; i_ < 3; ++i_) { const int pp = tid + i_ * NTHREADS; if (pp < NPIECE) { const int st = pp / 44, q = pp % 44; \
        const int row = chain_row(b, dir, (cc) * 32 + st); const int arr = q >> 3; const int so = arr == 0 ? srcoff[0] : arr == 1 ? srcoff[1] : arr == 2 ? srcoff[2] : arr == 3 ? srcoff[3] : arr == 4 ? srcoff[4] : srcoff[5]; \
        pre[i_] = *(const u32x4*)(PREP + (size_t)row * PRC + so + (q & 7) * 8); } } } while (0)
#define RW_COMMIT(cc) do { _Pragma("unroll") for (int i_ = 0; i_ < 3; ++i_) { const int pp = tid + i_ * NTHREADS; if (pp < NPIECE) { const int st = pp / 44, q = pp % 44; \
        *(LAS u32x4*)(lds + ((cc) & 1) * BUFB + st * STEPB + q * 16) = pre[i_]; } } } while (0)
    RW_ISSUE(0); RW_COMMIT(0);
    __syncthreads();
    for (int c = 0; c < NCHUNK; ++c) {
        if (c + 1 < NCHUNK) RW_ISSUE(c + 1);
        if (wave < 4) {
            const LAS unsigned char* buf = lds + (c & 1) * BUFB;
#pragma unroll 4
            for (int st = 0; st < 32; ++st) {
                const LAS unsigned char* sb = buf + st * STEPB;
                const h8 r8 = *(const LAS h8*)(sb + kq * 16), kk8 = *(const LAS h8*)(sb + 128 + kq * 16), w8 = *(const LAS h8*)(sb + 256 + kq * 16),
                         b8 = *(const LAS h8*)(sb + 384 + kq * 16), kd8 = *(const LAS h8*)(sb + 512 + kq * 16);
                const float vv = (float)*(const LAS hf*)(sb + 640 + rloc * 2);
                float sa0 = 0.f, sa1 = 0.f;
#pragma unroll
                for (int i = 0; i < 8; i += 2) { sa0 = fmaf(S[i], (float)kk8[i], sa0); sa1 = fmaf(S[i + 1], (float)kk8[i + 1], sa1); }
                const float nsa = -reduce8(sa0 + sa1);
                float o0 = 0.f, o1 = 0.f;
#pragma unroll
                for (int i = 0; i < 8; i += 2) {
                    float u0 = vv * (float)kd8[i], u1 = vv * (float)kd8[i + 1];
                    u0 = fmaf(nsa, (float)b8[i], u0); u1 = fmaf(nsa, (float)b8[i + 1], u1);
                    S[i] = fmaf(S[i], (float)w8[i], u0); S[i + 1] = fmaf(S[i + 1], (float)w8[i + 1], u1);
                    o0 = fmaf(S[i], (float)r8[i], o0); o1 = fmaf(S[i + 1], (float)r8[i + 1], o1);
                }
                const float o = reduce8(o0 + o1);
                if (kq == 0) *(LAS hf*)(obuf + (st * 32 + rloc) * 2) = (hf)o;
            }
        }
        __syncthreads();
        if (c + 1 < NCHUNK) RW_COMMIT(c + 1);
        if (tid < 128) { const int st = tid >> 2, pc = tid & 3; const int row = chain_row(b, dir, c * 32 + st);
            *(u32x4*)(OR + (size_t)row * 256 + h * 64 + half_ * 32 + pc * 8) = *(const LAS u32x4*)(obuf + st * 64 + pc * 16); }
        __syncthreads();
    }
#undef RW_ISSUE
#undef RW_COMMIT
}
__device__ __forceinline__ void gla_scan_item(unsigned char* ldsg, kparams_t p, int chain, int tid) {
    LAS unsigned char* lds = (LAS unsigned char*)ldsg;
    constexpr int STEPB = 320, BUFB = 32 * STEPB, NPIECE = 32 * 20;
    LAS unsigned char* obuf = lds + 2 * BUFB;
    const int b = chain >> 3, h = (chain >> 1) & 3, dir = chain & 1;
    const int lane = tid & 63, wave = tid >> 6, dq = lane & 3, col = (wave & 3) * 16 + (lane >> 2);
    const hf* PG = (const hf*)(p->ws + WS_PG); const bf16_t* P1 = (const bf16_t*)(p->ws + WS_P1); hf* OG = (hf*)(p->ws + WS_OG) + (size_t)dir * MT * 256;
    float S[8];
#pragma unroll
    for (int i = 0; i < 8; ++i) S[i] = 0.f;
    u32x4 pre[2];
#define GL_ISSUE(cc) do { _Pragma("unroll") for (int i_ = 0; i_ < 2; ++i_) { const int pp = tid + i_ * NTHREADS; if (pp < NPIECE) { const int st = pp / 20, q = pp % 20; \
        const int row = chain_row(b, dir, (cc) * 32 + st); \
        if (q < 12) { const int arr = q >> 2; const int so = arr == 0 ? h * 32 : arr == 1 ? 128 + h * 32 : 256 + dir * 128 + h * 32; pre[i_] = *(const u32x4*)(PG + (size_t)row * PGC + so + (q & 3) * 8); } \
        else pre[i_] = *(const u32x4*)(P1 + (size_t)row * P1C + 256 + h * 64 + (q - 12) * 8); } } } while (0)
#define GL_COMMIT(cc) do { _Pragma("unroll") for (int i_ = 0; i_ < 2; ++i_) { const int pp = tid + i_ * NTHREADS; if (pp < NPIECE) { const int st = pp / 20, q = pp % 20; \
        *(LAS u32x4*)(lds + ((cc) & 1) * BUFB + st * STEPB + q * 16) = pre[i_]; } } } while (0)
    GL_ISSUE(0); GL_COMMIT(0);
    __syncthreads();
    for (int c = 0; c < NCHUNK; ++c) {
        if (c + 1 < NCHUNK) GL_ISSUE(c + 1);
        if (wave < 4) {
            const LAS unsigned char* buf = lds + (c & 1) * BUFB;
#pragma unroll 4
            for (int st = 0; st < 32; ++st) {
                const LAS unsigned char* sb = buf + st * STEPB;
                const h8 q8 = *(const LAS h8*)(sb + dq * 16), k8 = *(const LAS h8*)(sb + 64 + dq * 16), e8 = *(const LAS h8*)(sb + 128 + dq * 16);
                const float vv = bf2f((unsigned)*(const LAS unsigned short*)(sb + 192 + col * 2));
                float o0 = 0.f, o1 = 0.f;
#pragma unroll
                for (int i = 0; i < 8; i += 2) {
                    S[i] = fmaf(S[i], (float)e8[i], (float)k8[i] * vv); S[i + 1] = fmaf(S[i + 1], (float)e8[i + 1], (float)k8[i + 1] * vv);
                    o0 = fmaf((float)q8[i], S[i], o0); o1 = fmaf((float)q8[i + 1], S[i + 1], o1);
                }
                const float o = reduce4(o0 + o1);
                if (dq == 0) *(LAS hf*)(obuf + (st * 64 + col) * 2) = (hf)o;
            }
        }
        __syncthreads();
        if (c + 1 < NCHUNK) GL_COMMIT(c + 1);
        if (tid < 256) { const int st = tid >> 3, pc = tid & 7; const int row = chain_row(b, dir, c * 32 + st);
            *(u32x4*)(OG + (size_t)row * 256 + h * 64 + pc * 8) = *(const LAS u32x4*)(obuf + st * 128 + pc * 16); }
        __syncthreads();
    }
#undef GL_ISSUE
#undef GL_COMMIT
}
__device__ __forceinline__ void swa_item(unsigned char* ldsg, kparams_t p, int l, int item, int tid) {
    LAS unsigned char* lds = (LAS unsigned char*)ldsg;
    LAS unsigned char* Ks = lds;
    LAS unsigned char* Vt = lds + 9216;
    const int lane = tid & 63, wave = tid >> 6, fr = lane & 15, quad = lane >> 4;
    const bf16_t* P1 = (const bf16_t*)(p->ws + WS_P1); bf16_t* MIX = (bf16_t*)(p->ws + WS_XN);
    const bool lat = item < 512;
    int b, n, kvh;
    if (lat) { b = item >> 6; n = (item >> 1) & 31; kvh = item & 1; } else { const int r = item - 512; b = r >> 2; n = (r >> 1) & 1; kvh = r & 1; }
    const int qrow = (lat ? b * 4096 : ML + b * 256) + n * 128 + wave * 16 + fr;
    const int qpos = n * 128 + wave * 16 + fr;
#pragma unroll 1
    for (int hp = 0; hp < 2; ++hp) {
    const int hbase = kvh * 4 + hp * 2;
    bf16x8 qf[2][2];
#pragma unroll
    for (int g = 0; g < 2; ++g)
#pragma unroll
        for (int ks = 0; ks < 2; ++ks) qf[g][ks] = *(const bf16x8*)(P1 + (size_t)qrow * P1C + 800 + (hbase + g) * 64 + ks * 32 + quad * 8);
    f32x4 oacc[2][4]; float mrun[2], lrun[2];
#pragma unroll
    for (int g = 0; g < 2; ++g) { mrun[g] = -1e30f; lrun[g] = 0.f;
#pragma unroll
        for (int dt = 0; dt < 4; ++dt) oacc[g][dt] = (f32x4){0.f, 0.f, 0.f, 0.f}; }
    const int ntile = lat ? 10 : 4;
    for (int tile = 0; tile < ntile; ++tile) {
        int krow0, kpos0; bool local = false;
        if (tile < 4) { krow0 = ML + b * 256 + tile * 64; kpos0 = 0; }
        else { kpos0 = (n - 1) * 128 + (tile - 4) * 64; if (kpos0 < 0 || kpos0 >= SEQ) continue; krow0 = b * 4096 + kpos0; local = true; }
        __syncthreads();
        { const int key = tid >> 3, ch = tid & 7; const bf16_t* src = P1 + (size_t)(krow0 + key) * P1C + 1312 + kvh * 64 + ch * 8;
          const u32x4 kv = *(const u32x4*)src; const u32x4 vv = *(const u32x4*)(src + 128);
          *(LAS u32x4*)(Ks + key * 144 + ch * 16) = kv;
#pragma unroll
          for (int e = 0; e < 4; ++e) { *(LAS unsigned short*)(Vt + (ch * 8 + 2 * e) * 144 + key * 2) = (unsigned short)(vv[e] & 0xffffu); *(LAS unsigned short*)(Vt + (ch * 8 + 2 * e + 1) * 144 + key * 2) = (unsigned short)(vv[e] >> 16); } }
        __syncthreads();
#pragma unroll
        for (int g = 0; g < 2; ++g) {
            asm volatile("" ::: "memory");
            bf16x8 kf[4][2], vf[4][2];
#pragma unroll
        for (int st = 0; st < 4; ++st)
#pragma unroll
            for (int ks = 0; ks < 2; ++ks) kf[st][ks] = *(const LAS bf16x8*)(Ks + (st * 16 + fr) * 144 + ks * 64 + quad * 16);
#pragma unroll
        for (int dt = 0; dt < 4; ++dt)
#pragma unroll
            for (int kp = 0; kp < 2; ++kp) { const u32x2 lo = *(const LAS u32x2*)(Vt + (dt * 16 + fr) * 144 + ((2 * kp) * 16 + quad * 4) * 2), hi = *(const LAS u32x2*)(Vt + (dt * 16 + fr) * 144 + ((2 * kp + 1) * 16 + quad * 4) * 2);
                const u32x4 t = {lo.x, lo.y, hi.x, hi.y}; vf[dt][kp] = __builtin_bit_cast(bf16x8, t); }
            f32x4 s[4];
#pragma unroll
            for (int st = 0; st < 4; ++st) { f32x4 a = (f32x4){0.f, 0.f, 0.f, 0.f};
                a = __builtin_amdgcn_mfma_f32_16x16x32_bf16(kf[st][0], qf[g][0], a, 0, 0, 0); a = __builtin_amdgcn_mfma_f32_16x16x32_bf16(kf[st][1], qf[g][1], a, 0, 0, 0); s[st] = a * 0.125f; }
            if (local) {
#pragma unroll
                for (int st = 0; st < 4; ++st)
#pragma unroll
                    for (int j = 0; j < 4; ++j) { const int d = qpos - (kpos0 + st * 16 + quad * 4 + j); if (d > 128 || d < -128) s[st][j] = -1e30f; }
            }
            float mx = fmaxf(fmaxf(fmaxf(s[0][0], s[0][1]), fmaxf(s[0][2], s[0][3])), fmaxf(fmaxf(s[1][0], s[1][1]), fmaxf(s[1][2], s[1][3])));
            mx = fmaxf(mx, fmaxf(fmaxf(fmaxf(s[2][0], s[2][1]), fmaxf(s[2][2], s[2][3])), fmaxf(fmaxf(s[3][0], s[3][1]), fmaxf(s[3][2], s[3][3]))));
            mx = fmaxf(mx, __shfl_xor(mx, 16)); mx = fmaxf(mx, __shfl_xor(mx, 32));
            const float mn = fmaxf(mrun[g], mx), alpha = __expf(mrun[g] - mn); mrun[g] = mn;
            float ps = 0.f;
#pragma unroll
            for (int st = 0; st < 4; ++st)
#pragma unroll
                for (int j = 0; j < 4; ++j) { s[st][j] = __expf(s[st][j] - mn); ps += s[st][j]; }
            lrun[g] = lrun[g] * alpha + ps;
            bf16x8 pb[2];
#pragma unroll
            for (int kp = 0; kp < 2; ++kp) { const u32x4 t = {pk2(s[2 * kp][0], s[2 * kp][1]), pk2(s[2 * kp][2], s[2 * kp][3]), pk2(s[2 * kp + 1][0], s[2 * kp + 1][1]), pk2(s[2 * kp + 1][2], s[2 * kp + 1][3])}; pb[kp] = __builtin_bit_cast(bf16x8, t); }
#pragma unroll
            for (int dt = 0; dt < 4; ++dt) { f32x4 o = oacc[g][dt] * alpha;
                o = __builtin_amdgcn_mfma_f32_16x16x32_bf16(vf[dt][0], pb[0], o, 0, 0, 0); o = __builtin_amdgcn_mfma_f32_16x16x32_bf16(vf[dt][1], pb[1], o, 0, 0, 0); oacc[g][dt] = o; }
        }
    }
    const float* sink = p->in[13] + l * 8;
#pragma unroll
    for (int g = 0; g < 2; ++g) {
        float lsum = lrun[g]; lsum += __shfl_xor(lsum, 16); lsum += __shfl_xor(lsum, 32);
        lsum += __expf(sink[hbase + g] - mrun[g]);
        const float inv = 1.0f / lsum;
#pragma unroll
        for (int dt = 0; dt < 4; ++dt) { const f32x4 o = oacc[g][dt] * inv; u32x2 w; w.x = pk2(o[0], o[1]); w.y = pk2(o[2], o[3]);
            *(u32x2*)(MIX + (size_t)qrow * DM + 256 + (hbase + g) * 64 + dt * 16 + quad * 4) = w; }
    }
    }
}

__device__ __forceinline__ float group16_sum(float v) { v += __shfl_xor(v, 1); v += __shfl_xor(v, 2); v += __shfl_xor(v, 4); v += __shfl_xor(v, 8); return v; }
__device__ __forceinline__ void phase_finalize(kparams_t p, int l, int nrows, int gw, int ngw, int lane) {
    const hf* OR = (const hf*)(p->ws + WS_OR); const hf* OG = (const hf*)(p->ws + WS_OG); const hf* PREP = (const hf*)(p->ws + WS_PREP); const hf* GG = (const hf*)(p->ws + WS_GG);
    const float* BONUS = (const float*)(p->ws + WS_BONUS); const bf16_t* P1 = (const bf16_t*)(p->ws + WS_P1); bf16_t* MIX = (bf16_t*)(p->ws + WS_XN);
    const float* ln_g = p->in[23] + l * 256; const float* ln_b = p->in[24] + l * 256; const float* gng = p->in[12] + l * 64;
    const int c = lane * 4, h = lane >> 4;
    const f32x4 lg4 = *(const f32x4*)(ln_g + c), lb4 = *(const f32x4*)(ln_b + c), gn4 = *(const f32x4*)(gng + (c & 63));
    for (int row = gw; row < nrows; row += ngw) {
        {
            const h4 a = *(const h4*)(OR + (size_t)row * 256 + c), bq = *(const h4*)(OR + (size_t)MT * 256 + (size_t)row * 256 + c);
            float o[4]; float s = 0.f;
#pragma unroll
            for (int e = 0; e < 4; ++e) { o[e] = (float)a[e] + (float)bq[e]; s += o[e]; }
            const float mu = group16_sum(s) * (1.0f / 64.0f); float q = 0.f;
#pragma unroll
            for (int e = 0; e < 4; ++e) { o[e] -= mu; q += o[e] * o[e]; }
            const float rs = rsqrtf(group16_sum(q) * (1.0f / 64.0f) + 64e-5f);
            const float bon = BONUS[(size_t)row * 4 + h];
            const h4 v4 = *(const h4*)(PREP + (size_t)row * PRC + 512 + c), g4 = *(const h4*)(GG + (size_t)row * 256 + c);
            float y[4];
#pragma unroll
            for (int e = 0; e < 4; ++e) y[e] = (o[e] * rs * lg4[e] + lb4[e] + bon * (float)v4[e]) * (float)g4[e];
            u32x2 w; w.x = pk2(y[0], y[1]); w.y = pk2(y[2], y[3]);
            *(u32x2*)(MIX + (size_t)row * DM + 768 + c) = w;
        }
        {
            const h4 a = *(const h4*)(OG + (size_t)row * 256 + c), bq = *(const h4*)(OG + (size_t)MT * 256 + (size_t)row * 256 + c);
            float o[4]; float q = 0.f;
#pragma unroll
            for (int e = 0; e < 4; ++e) { o[e] = (float)a[e] + (float)bq[e]; q += o[e] * o[e]; }
            const float rs = rsqrtf(group16_sum(q) * (1.0f / 64.0f) + 1e-6f);
            const u32x2 gt = *(const u32x2*)(P1 + (size_t)row * P1C + 512 + c);
            const float gv[4] = {bflo(gt.x), bfhi(gt.x), bflo(gt.y), bfhi(gt.y)};
            float y[4];
#pragma unroll
            for (int e = 0; e < 4; ++e) y[e] = o[e] * rs * gn4[e] * gv[e] * sigmoidf_(gv[e]);
            u32x2 w; w.x = pk2(y[0], y[1]); w.y = pk2(y[2], y[3]);
            *(u32x2*)(MIX + (size_t)row * DM + c) = w;
        }
    }
}
__global__ void __launch_bounds__(NTHREADS, 2) hybrid_fwd(Params p_arg) {
    extern __shared__ __attribute__((aligned(16))) unsigned char lds[];
#ifndef MAXSTEP
#define MAXSTEP 1000
#endif
    constexpr int NSTEP = 1 + 9 * NLAYER + 1;
#pragma unroll 1
    for (int step = 0; step < NSTEP; ++step) {
        kparams_t kp = (kparams_t)__builtin_amdgcn_kernarg_segment_ptr();
        asm volatile("" : "+s"(kp));
        kparams_t p = kp;
        int tid = threadIdx.x, bid = blockIdx.x, G = gridDim.x;
        asm volatile("" : "+v"(tid)); asm volatile("" : "+s"(bid)); asm volatile("" : "+s"(G));
        const int lane = tid & 63, wave = __builtin_amdgcn_readfirstlane(tid >> 6);
        const int gw = bid * NWAVES + wave, ngw = G * NWAVES;
        unsigned char* ws = p->ws;
        bf16_t* XN = (bf16_t*)(ws + WS_XN); float* XC = (float*)(ws + WS_XC); float* XL = p->out;
        if (step == 0) { phase_mod(lds, p, tid, bid, G); }
        else if (step == NSTEP - 1) { final_norm_rows(XL, p->in[28], gw, ngw, lane); break; }
        else {
            const int l = (step - 1) / 9, ph = (step - 1) % 9;
            const bool lastl = (l == NLAYER - 1);
            const int mrows = lastl ? ML : MT;
            const float* modl = (const float*)(ws + WS_MOD) + (size_t)l * 9 * 6144;
            const float* resL = l == 0 ? p->in[0] : XL; const float* resC = l == 0 ? p->in[2] : XC;
            if (ph == 0) {
                convert_weights(lds, p, l, gw, ngw, wave, lane);
                norm_mod_rows(resL, resC, p->in[6] + l * DM, modl, 0, 1024, XN, MT, gw, ngw, lane);
            } else if (ph == 1) {
                pg8::Gemm g{XN, (const bf16_t*)(ws + WS_WT + WT_IN), MT, INP, DM}; pg8::StaticOrder S; S.init(MT, INP, G, bid);
                pg8::EpiIn E{(bf16_t*)(ws + WS_P1), (bf16_t*)(ws + WS_RAW)};
                pg8::gemm_phase<pg8::EpiIn, pg8::StaticOrder, true, true>((PG8_LAS unsigned char*)lds, g, S, E, tid);
            } else if (ph == 5) {
                pg8::Gemm g{XN, (const bf16_t*)(ws + WS_WT + WT_OUT), mrows, DM, DM}; pg8::StaticOrder S; S.init(mrows, DM, G, bid);
                pg8::EpiRes E{resL, XL, resC, XC, modl + 2048};
                pg8::gemm_phase<pg8::EpiRes, pg8::StaticOrder, true, true>((PG8_LAS unsigned char*)lds, g, S, E, tid);
            } else if (ph == 7) {
                pg8::Gemm g{XN, (const bf16_t*)(ws + WS_WT + WT_GU), mrows, 2 * FF, DM}; pg8::StaticOrder S; S.init(mrows, 2 * FF, G, bid);
                pg8::EpiSwiglu E{(bf16_t*)(ws + WS_H)};
                pg8::gemm_phase<pg8::EpiSwiglu, pg8::StaticOrder, true, true>((PG8_LAS unsigned char*)lds, g, S, E, tid);
            } else if (ph == 8) {
                pg8::Gemm g{(const bf16_t*)(ws + WS_H), (const bf16_t*)(ws + WS_WT + WT_DN), mrows, DM, FF}; pg8::StaticOrder S; S.init(mrows, DM, G, bid);
                pg8::EpiRes E{XL, XL, XC, XC, modl + 5120};
                pg8::gemm_phase<pg8::EpiRes, pg8::StaticOrder, true, true>((PG8_LAS unsigned char*)lds, g, S, E, tid);
            } else if (ph == 2) {
                phase_prep(lds, p, l, tid, bid, G);
            } else if (ph == 3) {
                for (int it = bid; it < 192; it += G) { if (it < 128) rwkv_scan_item(lds, p, it, tid); else gla_scan_item(lds, p, it - 128, tid); __syncthreads(); }
                const int nswa = lastl ? 512 : 544;
                unsigned* ctl = (unsigned*)(ws + WS_CTL);
                LAS int* qslot = (LAS int*)((LAS unsigned char*)lds + 20480);
                for (;;) {
                    __syncthreads();
                    if (tid == 0) *qslot = (int)atomicAdd(ctl + 64 * l, 1u);
                    __syncthreads();
                    const int it = *qslot;
                    if (it >= nswa) break;
                    swa_item(lds, p, l, it, tid);
                }
            } else if (ph == 4) {
                phase_finalize(p, l, mrows, gw, ngw, lane);
            } else {
                norm_mod_rows(XL, XC, p->in[7] + l * DM, modl, 3072, 4096, XN, mrows, gw, ngw, lane);
            }
        }
        cg::this_grid().sync();
        if (step + 1 >= MAXSTEP) break;
    }
}

extern "C" void kernel_launch(void* const* d_in, const int* in_sizes, int n_in, void* d_out, int out_size, void* d_ws, size_t ws_size, hipStream_t stream) {
    static int grid_blocks = 0;
    if (grid_blocks == 0) {
        if (n_in != 29 || out_size != ML * DM || ws_size < WS_END) { fprintf(stderr, "kernel_launch: unexpected shapes (n_in %d out %d ws %zu)\n", n_in, out_size, ws_size); grid_blocks = -1; return; }
        int dev = 0, cus = 0, per_cu = 0;
        (void)hipGetDevice(&dev);
        (void)hipDeviceGetAttribute(&cus, hipDeviceAttributeMultiprocessorCount, dev);
        (void)hipFuncSetAttribute((const void*)hybrid_fwd, hipFuncAttributeMaxDynamicSharedMemorySize, LDS_BYTES);
        (void)hipOccupancyMaxActiveBlocksPerMultiprocessor(&per_cu, (const void*)hybrid_fwd, NTHREADS, LDS_BYTES);
        if (per_cu < 1) per_cu = 1;
        grid_blocks = cus * per_cu;
        (void)hipGetLastError();
    }
    if (grid_blocks < 0) return;
    (void)hipMemsetAsync((char*)d_ws + WS_CTL, 0, 4096, stream);
    Params p{};
    for (int i = 0; i < 29; ++i) p.in[i] = (const float*)d_in[i];
    p.out = (float*)d_out; p.ws = (unsigned char*)d_ws;
    void* args[] = {&p};
    hipError_t e = hipLaunchCooperativeKernel((const void*)hybrid_fwd, dim3(grid_blocks), dim3(NTHREADS), args, LDS_BYTES, stream);
    if (e != hipSuccess) fprintf(stderr, "cooperative launch failed: %s (grid %d)\n", hipGetErrorString(e), grid_blocks);
}
```

```cpp
#include <hip/hip_runtime.h>
#include <hip/hip_cooperative_groups.h>
#include <cstdio>
#include <cstdint>
namespace cg = cooperative_groups;
namespace pg8 {
#define PG8_LAS __attribute__((address_space(3)))
typedef unsigned short bf16_t;
typedef short bf16x8 __attribute__((ext_vector_type(8)));
typedef float f32x4 __attribute__((ext_vector_type(4)));
typedef unsigned u32x4 __attribute__((ext_vector_type(4)));
constexpr int BM = 256, BK = 64, HALF = 128, HTB = HALF * BK * 2  , STAGE_BYTES = 8 * HTB, NXCD = 8, WGM = 8;

__host__ __device__ __forceinline__ int lds_byte(int r, int c) { const int st = (r >> 4) * 2 + (c >> 5), rr = r & 15, cc = c & 31, ob = rr * 64 + cc * 2; return st * 1024 + (ob ^ (((ob >> 9) & 1) << 5)); }
__host__ __device__ __forceinline__ void stage_rc(int b, int& R, int& C) { const int st = b / 1024, sb = b % 1024, swz = sb ^ (((sb >> 9) & 1) << 5); R = (st >> 1) * 16 + swz / 64; C = (st & 1) * 32 + (swz % 64) / 2; }
__host__ __device__ __forceinline__ int perm32(int rho) { const int n = rho >> 4, i = rho & 15; return 8 * (i >> 2) + 4 * n + (i & 3); }

struct Unit { int pm, pn; };
struct Gemm { const bf16_t* A; const bf16_t* Bt; int M, N, K; };

struct StaticOrder {
    int nM, nN, nwg, G, c;
    __host__ __device__ void init(int M, int N, int G_, int c_) { nM = M / BM; nN = N / BM; nwg = nM * nN; G = G_; c = c_; }
    __host__ __device__ bool next(int i, Unit& u) const {
        const long L = (long)i * G + c; if (L >= nwg) return false;
        int wgid = (int)L; { const int q = nwg / NXCD, r = nwg % NXCD, xcd = wgid % NXCD, off = wgid / NXCD; wgid = (xcd < r ? xcd * (q + 1) : r * (q + 1) + (xcd - r) * q) + off; }
        const int nig = WGM * nN, gid = wgid / nig, fm = gid * WGM, gsz = (nM - fm) < WGM ? (nM - fm) : WGM;
        u.pm = fm + ((wgid % nig) % gsz); u.pn = (wgid % nig) / gsz; return true;
    }
    __device__ __forceinline__ void a_ready(const Unit&) const {}
    __device__ __forceinline__ void done(const Unit&) const {}
};

__device__ __forceinline__ unsigned cvt_pk_bf16(float lo, float hi) { unsigned r; asm volatile("v_cvt_pk_bf16_f32 %0, %1, %2" : "=v"(r) : "v"(lo), "v"(hi)); return r; }
typedef float f32x2 __attribute__((ext_vector_type(2)));
constexpr int EP_ML = 32768;
struct EpiIn {
    static constexpr bool PERM = true, AFTER_DRAIN = false;
    bf16_t* O0; bf16_t* O1;
    __device__ __forceinline__ void operator()(const f32x4 (&acc)[2][2][4][2], const Unit& u, int wr, int wc, int fr, int fq) const {
        const int row0 = u.pm * BM + wr * 64 + fr;
#pragma unroll
        for (int bj = 0; bj < 2; ++bj) {
            const int c0 = u.pn * BM + bj * HALF + wc * 32 + 8 * fq;
            bf16_t* base; size_t ld; int cc; bool ok = true;
            if (c0 < 1568) { base = O0; ld = 1568; cc = c0; } else if (c0 < 2720) { base = O1; ld = 1152; cc = c0 - 1568; } else { base = O0; ld = 0; cc = 0; ok = false; }
            if (ok) {
#pragma unroll
            for (int ai = 0; ai < 2; ++ai)
#pragma unroll
                for (int m = 0; m < 4; ++m) {
                    const f32x4 v0 = acc[ai][bj][m][0], v1 = acc[ai][bj][m][1];
                    u32x4 w; w.x = cvt_pk_bf16(v0[0], v0[1]); w.y = cvt_pk_bf16(v0[2], v0[3]); w.z = cvt_pk_bf16(v1[0], v1[1]); w.w = cvt_pk_bf16(v1[2], v1[3]);
                    *(u32x4*)(base + (size_t)(row0 + ai * HALF + m * 16) * ld + cc) = w;
                }
            }
        }
    }
};
struct EpiRes {
    static constexpr bool PERM = true, AFTER_DRAIN = false;
    const float* srcL; float* dstL; const float* srcC; float* dstC; const float* gate;
    __device__ __forceinline__ void operator()(const f32x4 (&acc)[2][2][4][2], const Unit& u, int wr, int wc, int fr, int fq) const {
        const int rowt = u.pm * BM;
        const bool lat = rowt < EP_ML;
        const float* src = lat ? srcL : srcC; float* dst = lat ? dstL : dstC;
        const float* g = gate + (lat ? (rowt >> 12) : 8) * 6144; const int rb = lat ? rowt : rowt - EP_ML;
        const int col0 = u.pn * BM + wc * 32 + 8 * fq;
#pragma unroll
        for (int bj = 0; bj < 2; ++bj) {
            const f32x4 g0 = *(const f32x4*)(g + col0 + bj * HALF), g1 = *(const f32x4*)(g + col0 + bj * HALF + 4);
#pragma unroll
            for (int ai = 0; ai < 2; ++ai)
#pragma unroll
                for (int m = 0; m < 4; ++m) { const size_t off = (size_t)(rb + ai * HALF + wr * 64 + m * 16 + fr) * 1024 + col0 + bj * HALF;
                    const f32x4 s0 = *(const f32x4*)(src + off), s1 = *(const f32x4*)(src + off + 4);
                    *(f32x4*)(dst + off) = s0 + g0 * acc[ai][bj][m][0]; *(f32x4*)(dst + off + 4) = s1 + g1 * acc[ai][bj][m][1]; }
        }
    }
};
struct EpiSwiglu {
    static constexpr bool PERM = true, AFTER_DRAIN = false;
    bf16_t* O0;
    __device__ __forceinline__ void operator()(const f32x4 (&acc)[2][2][4][2], const Unit& u, int wr, int wc, int fr, int fq) const {
        const int row0 = u.pm * BM + wr * 64 + fr, col = u.pn * HALF + wc * 32 + 8 * fq;
#pragma unroll
        for (int ai = 0; ai < 2; ++ai)
#pragma unroll
            for (int m = 0; m < 4; ++m) {
                float h[8];
#pragma unroll
                for (int n = 0; n < 2; ++n)
#pragma unroll
                    for (int e = 0; e < 4; ++e) { const float gt = acc[ai][0][m][n][e], up = acc[ai][1][m][n][e]; h[n * 4 + e] = gt * up * __builtin_amdgcn_rcpf(1.0f + __expf(-gt)); }
                u32x4 w; w.x = cvt_pk_bf16(h[0], h[1]); w.y = cvt_pk_bf16(h[2], h[3]); w.z = cvt_pk_bf16(h[4], h[5]); w.w = cvt_pk_bf16(h[6], h[7]);
                *(u32x4*)(O0 + (size_t)(row0 + ai * HALF + m * 16) * 2816 + col) = w;
            }
    }
};
template <class Epi, class Sched, bool ALIGN_EPI = false, bool SP2 = false>
__device__ __forceinline__ void gemm_phase(PG8_LAS unsigned char* lds, const Gemm g, const Sched& S, const Epi& E, int tid_in) {
    const int tid = tid_in, wid = __builtin_amdgcn_readfirstlane(tid >> 6), lane = tid & 63, wr = wid >> 2, wc = wid & 3, fr = lane & 15, fq = lane >> 4;
    const int K = g.K, nt = K / BK;
    unsigned voffA[2], voffB[2];
#pragma unroll
    for (int i = 0; i < 2; ++i) { int R, C; stage_rc(tid * 16 + i * 8192, R, C); const int Rb = Epi::PERM ? ((R & ~31) + perm32(R & 31)) : R;
        voffA[i] = (unsigned)(R * K + C) * 2u; voffB[i] = (unsigned)(Rb * K + C) * 2u; }
    const size_t kstep = (size_t)(BK * 2);
    const size_t hstep = (size_t)HALF * K * 2;
    const size_t tstep = 2 * hstep;
    const unsigned ldsw = (unsigned)wid * 1024u;
    const int aoff = lds_byte(wr * 64 + fr, fq * 8), boff = lds_byte(wc * 32 + fr, fq * 8);
#define PG8_SA(b, h) (((b) * 2 + (h)) * HTB)
#define PG8_SB(b, h) ((4 + (b) * 2 + (h)) * HTB)
#define PG8_STAGE(bufoff, gbase, voff) do { _Pragma("unroll") for (int _i = 0; _i < 2; ++_i) \
        __builtin_amdgcn_global_load_lds((const unsigned*)((const char*)(gbase) + (voff)[_i]), (PG8_LAS unsigned*)(lds + (bufoff) + ldsw + _i * 8192), 16, 0, 0); } while (0)
#define PG8_LDA(dst, b, h) do { _Pragma("unroll") for (int m = 0; m < 4; ++m) _Pragma("unroll") for (int k = 0; k < 2; ++k) dst[m][k] = *(const PG8_LAS bf16x8*)(lds + PG8_SA(b, h) + aoff + m * 2048 + k * 1024); } while (0)
#define PG8_LDB(dst, b, h) do { _Pragma("unroll") for (int n = 0; n < 2; ++n) _Pragma("unroll") for (int k = 0; k < 2; ++k) dst[n][k] = *(const PG8_LAS bf16x8*)(lds + PG8_SB(b, h) + boff + n * 2048 + k * 1024); } while (0)
#define PG8_MMA(ai, bj, At, Bt) do { __builtin_amdgcn_s_setprio(1); _Pragma("unroll") for (int m = 0; m < 4; ++m) _Pragma("unroll") for (int n = 0; n < 2; ++n) _Pragma("unroll") for (int k = 0; k < 2; ++k) \
        acc[ai][bj][m][n] = __builtin_amdgcn_mfma_f32_16x16x32_bf16(Bt[n][k], At[m][k], acc[ai][bj][m][n], 0, 0, 0); __builtin_amdgcn_s_setprio(0); } while (0)
#define PG8_WAIT_V(n) asm volatile("s_waitcnt vmcnt(" #n ")" ::: "memory")
#define PG8_WAIT_L(n) asm volatile("s_waitcnt lgkmcnt(" #n ")" ::: "memory")
#define PG8_BAR __builtin_amdgcn_s_barrier()
#define PG8_SCHED __builtin_amdgcn_sched_barrier(0)
    Unit cur, nxt; int ui = 0;
    if (!S.next(0, cur)) return;
    f32x4 acc[2][2][4][2];
#pragma unroll
    for (int a = 0; a < 2; ++a)
#pragma unroll
        for (int b = 0; b < 2; ++b)
#pragma unroll
            for (int m = 0; m < 4; ++m)
#pragma unroll
                for (int n = 0; n < 2; ++n) acc[a][b][m][n] = (f32x4){0.f, 0.f, 0.f, 0.f};
    bf16x8 At[4][2], B0[2][2], B1[2][2];
    const char* cA = (const char*)g.A + (size_t)cur.pm * tstep; const char* cB = (const char*)g.Bt + (size_t)cur.pn * tstep;
    S.a_ready(cur);
    if constexpr (SP2) {
        PG8_STAGE(PG8_SB(0, 0), cB, voffB); PG8_STAGE(PG8_SB(0, 1), cB + hstep, voffB); PG8_STAGE(PG8_SA(0, 0), cA, voffA); PG8_STAGE(PG8_SA(0, 1), cA + hstep, voffA);
        if (wr == 1) PG8_BAR;
        PG8_WAIT_V(2); PG8_BAR;
        PG8_STAGE(PG8_SB(1, 0), cB + kstep, voffB); PG8_STAGE(PG8_SA(1, 0), cA + kstep, voffA); PG8_STAGE(PG8_SB(1, 1), cB + hstep + kstep, voffB);
        PG8_WAIT_V(6); PG8_BAR;
    } else {
        PG8_STAGE(PG8_SB(0, 0), cB, voffB); PG8_STAGE(PG8_SA(0, 0), cA, voffA); PG8_STAGE(PG8_SB(0, 1), cB + hstep, voffB); PG8_STAGE(PG8_SA(0, 1), cA + hstep, voffA);
        if (wr == 1) PG8_BAR;
        PG8_WAIT_V(4); PG8_BAR;
        PG8_STAGE(PG8_SB(1, 0), cB + kstep, voffB); PG8_STAGE(PG8_SA(1, 0), cA + kstep, voffA); PG8_STAGE(PG8_SB(1, 1), cB + hstep + kstep, voffB);
        PG8_WAIT_V(6); PG8_BAR;
    }
    for (;;) {
        const bool has_next = S.next(ui + 1, nxt);
        const char* nA = has_next ? (const char*)g.A + (size_t)nxt.pm * tstep : cA; const char* nB = has_next ? (const char*)g.Bt + (size_t)nxt.pn * tstep : cB;
        for (int t = 0; t < nt; t += 2) {
            const bool last = (t == nt - 2);
            const char* a1 = cA + (size_t)(t + 1) * kstep;
            const char* a2 = last ? nA : cA + (size_t)(t + 2) * kstep; const char* b2 = last ? nB : cB + (size_t)(t + 2) * kstep;
            const char* a3 = a2 + kstep; const char* b3 = b2 + kstep;
            if (last && has_next) S.a_ready(nxt);
            if constexpr (SP2) {
            PG8_LDB(B0, 0, 0); PG8_LDB(B1, 0, 1); PG8_SCHED; PG8_LDA(At, 0, 0); PG8_STAGE(PG8_SA(1, 1), a1 + hstep, voffA);
            PG8_WAIT_V(8); PG8_WAIT_L(0); PG8_BAR; PG8_MMA(0, 0, At, B0); PG8_MMA(0, 1, At, B1); PG8_BAR; PG8_SCHED;
            PG8_LDA(At, 0, 1); PG8_STAGE(PG8_SB(0, 0), b2, voffB); PG8_STAGE(PG8_SB(0, 1), b2 + hstep, voffB); PG8_STAGE(PG8_SA(0, 0), a2, voffA);
            PG8_WAIT_V(8); PG8_WAIT_L(0); PG8_BAR; PG8_MMA(1, 0, At, B0); PG8_MMA(1, 1, At, B1); PG8_BAR; PG8_SCHED;
            PG8_LDB(B0, 1, 0); PG8_LDB(B1, 1, 1); PG8_SCHED; PG8_LDA(At, 1, 0); PG8_STAGE(PG8_SA(0, 1), a2 + hstep, voffA);
            PG8_WAIT_V(8); PG8_WAIT_L(0); PG8_BAR; PG8_MMA(0, 0, At, B0); PG8_MMA(0, 1, At, B1); PG8_BAR; PG8_SCHED;
            PG8_LDA(At, 1, 1); PG8_STAGE(PG8_SB(1, 0), b3, voffB); PG8_STAGE(PG8_SB(1, 1), b3 + hstep, voffB); PG8_STAGE(PG8_SA(1, 0), a3, voffA);
            PG8_WAIT_V(8); PG8_WAIT_L(0); PG8_BAR; PG8_MMA(1, 0, At, B0); PG8_MMA(1, 1, At, B1); PG8_BAR; PG8_SCHED;
            } else {
            PG8_LDB(B0, 0, 0); PG8_SCHED; PG8_LDA(At, 0, 0); PG8_STAGE(PG8_SA(1, 1), a1 + hstep, voffA);
            PG8_WAIT_L(8); PG8_BAR; PG8_WAIT_L(0); PG8_MMA(0, 0, At, B0); PG8_BAR; PG8_SCHED;
            PG8_LDB(B1, 0, 1); PG8_STAGE(PG8_SB(0, 0), b2, voffB);
            PG8_BAR; PG8_WAIT_L(0); PG8_MMA(0, 1, At, B1); PG8_BAR;
            PG8_LDA(At, 0, 1); PG8_STAGE(PG8_SA(0, 0), a2, voffA);
            PG8_BAR; PG8_WAIT_L(0); PG8_MMA(1, 0, At, B0); PG8_BAR; PG8_SCHED;
            PG8_STAGE(PG8_SB(0, 1), b2 + hstep, voffB);
            PG8_WAIT_V(6); PG8_BAR; PG8_MMA(1, 1, At, B1); PG8_BAR;
            PG8_LDB(B0, 1, 0); PG8_SCHED; PG8_LDA(At, 1, 0); PG8_STAGE(PG8_SA(0, 1), a2 + hstep, voffA);
            PG8_WAIT_L(8); PG8_BAR; PG8_WAIT_L(0); PG8_MMA(0, 0, At, B0); PG8_BAR; PG8_SCHED;
            PG8_LDB(B1, 1, 1); PG8_STAGE(PG8_SB(1, 0), b3, voffB);
            PG8_BAR; PG8_WAIT_L(0); PG8_MMA(0, 1, At, B1); PG8_BAR;
            PG8_LDA(At, 1, 1); PG8_STAGE(PG8_SA(1, 0), a3, voffA);
            PG8_BAR; PG8_WAIT_L(0); PG8_MMA(1, 0, At, B0); PG8_BAR; PG8_SCHED;
            PG8_STAGE(PG8_SB(1, 1), b3 + hstep, voffB);
            PG8_WAIT_V(6); PG8_BAR; PG8_MMA(1, 1, At, B1); PG8_BAR;
            }
        }
        if constexpr (ALIGN_EPI) { if (wr == 0) PG8_BAR; }
        if constexpr (!Epi::AFTER_DRAIN) { E(acc, cur, wr, wc, fr, fq); S.done(cur); }
        if (!has_next) break;
#pragma unroll
        for (int a = 0; a < 2; ++a)
#pragma unroll
            for (int b = 0; b < 2; ++b)
#pragma unroll
                for (int m = 0; m < 4; ++m)
#pragma unroll
                    for (int n = 0; n < 2; ++n) acc[a][b][m][n] = (f32x4){0.f, 0.f, 0.f, 0.f};
        cur = nxt; cA = nA; cB = nB; ++ui;
        if constexpr (ALIGN_EPI) { if (wr == 1) PG8_BAR; }
    }
    PG8_WAIT_V(0);
    if constexpr (!ALIGN_EPI) { if (wr == 0) PG8_BAR; }
    PG8_BAR;
    if constexpr (Epi::AFTER_DRAIN) { E.fused(acc, cur, wr, wc, fr, fq, lds, wid, lane); S.done(cur); }
#undef PG8_SA
#undef PG8_SB
#undef PG8_STAGE
#undef PG8_LDA
#undef PG8_LDB
#undef PG8_MMA
#undef PG8_WAIT_V
#undef PG8_WAIT_L
#undef PG8_BAR
#undef PG8_SCHED
}
}
#define LAS __attribute__((address_space(3)))
typedef unsigned short bf16_t;
typedef _Float16 hf;
typedef _Float16 h8 __attribute__((ext_vector_type(8)));
typedef _Float16 h4 __attribute__((ext_vector_type(4)));
typedef unsigned u32x4 __attribute__((ext_vector_type(4)));
typedef unsigned u32x2 __attribute__((ext_vector_type(2)));
typedef float f32x4 __attribute__((ext_vector_type(4)));
typedef short bf16x8 __attribute__((ext_vector_type(8)));

constexpr int DM = 1024, NB = 8, SEQ = 4096, CTXL = 256, NLAYER = 4;
constexpr int ML = NB * SEQ, MC = NB * CTXL, MT = ML + MC;
constexpr int INC = 2720, INP = 2816, P1C = 1568, RAWC = 1152, FF = 2816;
constexpr int PRC = 2304, PGC = 512;
constexpr int NTHREADS = 512, NWAVES = 8;
constexpr int LDS_BYTES = 147456;
constexpr size_t MiB = 1u << 20;
constexpr size_t WS_CTL = 0, WS_MOD = 1 * MiB, WS_ROPE = 2 * MiB, WS_BONUS = 3 * MiB, WS_WT = 4 * MiB, WS_XC = 28 * MiB, WS_XN = 36 * MiB,
                 WS_P1 = 104 * MiB, WS_RAW = 209 * MiB, WS_PREP = 286 * MiB, WS_PG = 439 * MiB, WS_GG = 473 * MiB, WS_END = 490 * MiB;
constexpr size_t WS_H = 104 * MiB;
constexpr size_t WS_OR = 209 * MiB, WS_OG = 243 * MiB;
constexpr size_t WT_IN = 0, WT_OUT = (size_t)INP * DM * 2, WT_GU = WT_OUT + (size_t)DM * DM * 2, WT_DN = WT_GU + (size_t)2 * FF * DM * 2;
static_assert(WT_DN + (size_t)DM * FF * 2 == 24 * MiB, "wt");
static_assert(WS_P1 + (size_t)MT * P1C * 2 <= WS_RAW && WS_RAW + (size_t)MT * RAWC * 2 <= WS_PREP && WS_PREP + (size_t)MT * PRC * 2 <= WS_PG && WS_PG + (size_t)MT * PGC * 2 <= WS_GG && WS_GG + (size_t)MT * 256 * 2 <= WS_END, "ws map");
static_assert(WS_OG + (size_t)2 * MT * 256 * 2 <= WS_PREP && WS_H + (size_t)MT * FF * 2 <= WS_PG && WS_XN + (size_t)MT * DM * 2 <= WS_P1, "ws overlay");

struct Params { const float* in[29]; float* out; unsigned char* ws; };
typedef const __attribute__((address_space(4))) Params* kparams_t;

__device__ __forceinline__ float bf2f(unsigned b) { return __uint_as_float(b << 16); }
__device__ __forceinline__ unsigned f2bf(float f) { unsigned u = __float_as_uint(f); return (u + 0x7fffu + ((u >> 16) & 1u)) >> 16; }
__device__ __forceinline__ unsigned pk2(float lo, float hi) { return f2bf(lo) | (f2bf(hi) << 16); }
typedef float f32x2_t __attribute__((ext_vector_type(2))); typedef __bf16 bf16x2_t __attribute__((ext_vector_type(2)));
__device__ __forceinline__ unsigned cvtpk(float lo, float hi) { const f32x2_t v = {lo, hi}; const bf16x2_t b = __builtin_convertvector(v, bf16x2_t); return __builtin_bit_cast(unsigned, b); }
__device__ __forceinline__ float bflo(unsigned w) { return __uint_as_float(w << 16); }
__device__ __forceinline__ float bfhi(unsigned w) { return __uint_as_float(w & 0xffff0000u); }
__device__ __forceinline__ float wave_sum(float v) {
#pragma unroll
    for (int o = 1; o < 64; o <<= 1) v += __shfl_xor(v, o);
    return v;
}
__device__ __forceinline__ float sigmoidf_(float x) { return __builtin_amdgcn_rcpf(1.0f + __expf(-x)); }
__device__ __forceinline__ float softplusf_(float x) { return fmaxf(x, 0.f) + __logf(1.0f + __expf(-fabsf(x))); }
template <int CTRL> __device__ __forceinline__ float dpp_add(float x) {
    return x + __int_as_float(__builtin_amdgcn_update_dpp(0, __float_as_int(x), CTRL, 0xF, 0xF, true));
}
__device__ __forceinline__ float reduce4(float x) { x = dpp_add<0xB1>(x); x = dpp_add<0x4E>(x); return x; }
__device__ __forceinline__ float reduce16(float x) { x = dpp_add<0xB1>(x); x = dpp_add<0x4E>(x); x = dpp_add<0x141>(x); x = dpp_add<0x140>(x); return x; }
__device__ __forceinline__ float reduce8(float x) { x = dpp_add<0xB1>(x); x = dpp_add<0x4E>(x); x = dpp_add<0x141>(x); return x; }

__device__ __forceinline__ void phase_mod(unsigned char* lds, kparams_t p, int tid, int bid, int G) {
    float* sc = (float*)lds;
    float* part = (float*)(lds + 36864);
    const float* c = p->in[1]; const float* cctx = p->in[3]; const float* ada_w = p->in[4]; const float* ada_b = p->in[5];
    float* MOD = (float*)(p->ws + WS_MOD);
    for (int i = tid; i < 9 * 1024; i += NTHREADS) { const float x = i < 8192 ? c[i] : cctx[i - 8192]; sc[i] = x * sigmoidf_(x); }
    __syncthreads();
    const int cl = tid & 31, kg = tid >> 5;
    for (int item = bid; item < NLAYER * 192; item += G) {
        const int l = item / 192, cgp = item % 192, col = cgp * 32 + cl;
        float acc[9];
#pragma unroll
        for (int s = 0; s < 9; ++s) acc[s] = 0.f;
        const float* w = ada_w + ((size_t)l * 1024 + kg * 64) * 6144 + col;
#pragma unroll 16
        for (int kk = 0; kk < 64; ++kk) { const float wv = w[(size_t)kk * 6144];
#pragma unroll
            for (int s = 0; s < 9; ++s) acc[s] = fmaf(sc[s * 1024 + kg * 64 + kk], wv, acc[s]); }
#pragma unroll
        for (int s = 0; s < 9; ++s) part[(kg * 9 + s) * 32 + cl] = acc[s];
        __syncthreads();
        if (tid < 288) { const int s = tid >> 5; float a = ada_b[l * 6144 + col];
#pragma unroll
            for (int k2 = 0; k2 < 16; ++k2) a += part[(k2 * 9 + s) * 32 + cl];
            MOD[((size_t)l * 9 + s) * 6144 + col] = a; }
        __syncthreads();
    }
    float* RC = (float*)(p->ws + WS_ROPE); float* RS = RC + 4096 * 32;
    for (int idx = bid * NTHREADS + tid; idx < 4096 * 32; idx += G * NTHREADS) {
        const int t = idx >> 5, j = idx & 31; const float pos = (float)(j < 16 ? (t >> 6) : (t & 63));
        const float inv = exp2f(-(float)(j & 15) * (13.287712379549449f / 16.0f));
        const float ang = pos * inv; const float rev = ang * 0.15915494309189535f; const float fr = rev - floorf(rev);
        const float a2 = fr * 6.283185307179586f;
        RC[idx] = __cosf(a2); RS[idx] = __sinf(a2);
    }
}

__device__ __forceinline__ void transpose_item(const float* W, int K, int N, bf16_t* WT, int k0, int n0, int drow0, LAS float* scr, int lane) {
#pragma unroll 16
    for (int i = 0; i < 32; ++i) { const int kk = 2 * i + (lane >> 5); scr[kk * 33 + (lane & 31)] = W[(size_t)(k0 + kk) * N + n0 + (lane & 31)]; }
    asm volatile("s_waitcnt lgkmcnt(0)" ::: "memory");
    const int c = lane & 7;
#pragma unroll
    for (int j = 0; j < 4; ++j) { const int n = (lane >> 3) + 8 * j; const LAS float* s = scr + (8 * c) * 33 + n;
        u32x4 o; o.x = pk2(s[0 * 33], s[1 * 33]); o.y = pk2(s[2 * 33], s[3 * 33]); o.z = pk2(s[4 * 33], s[5 * 33]); o.w = pk2(s[6 * 33], s[7 * 33]);
        *(u32x4*)(WT + (size_t)(drow0 + n) * K + k0 + 8 * c) = o; }
    asm volatile("s_waitcnt lgkmcnt(0)" ::: "memory");
}
__device__ __forceinline__ void convert_weights(unsigned char* lds, kparams_t p, int l, int gw, int ngw, int wave, int lane) {
    LAS float* scr = (LAS float*)((LAS unsigned char*)lds + wave * 16384);
    unsigned char* wt = p->ws + WS_WT;
    constexpr int I_IN = 16 * 85, I_OUT = 16 * 32, I_G = 16 * 88, I_D = 44 * 32;
    constexpr int NIT = I_IN + I_OUT + 2 * I_G + I_D;
    for (int it = gw; it < NIT; it += ngw) {
        int r = it;
        if (r < I_IN) { const int kb = r / 85, nb = r % 85; transpose_item(p->in[8] + (size_t)l * DM * INC, DM, INC, (bf16_t*)(wt + WT_IN), kb * 64, nb * 32, nb * 32, scr, lane); continue; } r -= I_IN;
        if (r < I_OUT) { const int kb = r / 32, nb = r % 32; transpose_item(p->in[9] + (size_t)l * DM * DM, DM, DM, (bf16_t*)(wt + WT_OUT), kb * 64, nb * 32, nb * 32, scr, lane); continue; } r -= I_OUT;
        if (r < I_G) { const int kb = r / 88, nb = r % 88, n0 = nb * 32; transpose_item(p->in[25] + (size_t)l * DM * FF, DM, FF, (bf16_t*)(wt + WT_GU), kb * 64, n0, (n0 >> 7) * 256 + (n0 & 127), scr, lane); continue; } r -= I_G;
        if (r < I_G) { const int kb = r / 88, nb = r % 88, n0 = nb * 32; transpose_item(p->in[26] + (size_t)l * DM * FF, DM, FF, (bf16_t*)(wt + WT_GU), kb * 64, n0, (n0 >> 7) * 256 + 128 + (n0 & 127), scr, lane); continue; } r -= I_G;
        { const int kb = r / 32, nb = r % 32; transpose_item(p->in[27] + (size_t)l * FF * DM, FF, DM, (bf16_t*)(wt + WT_DN), kb * 64, nb * 32, nb * 32, scr, lane); }
    }
}

__device__ __forceinline__ void norm_mod_rows(const float* srcL, const float* srcC, const float* gamma, const float* modl, int shoff, int scoff, bf16_t* XN, int nrows, int gw, int ngw, int lane) {
    int m = gw; f32x4 v[4];
    if (m < nrows) { const float* xr = m < ML ? srcL + (size_t)m * DM : srcC + (size_t)(m - ML) * DM;
#pragma unroll
        for (int j = 0; j < 4; ++j) v[j] = ((const f32x4*)xr)[lane + 64 * j]; }
    while (m < nrows) {
        const int mn = m + ngw; f32x4 vn[4];
        if (mn < nrows) { const float* xr = mn < ML ? srcL + (size_t)mn * DM : srcC + (size_t)(mn - ML) * DM;
#pragma unroll
            for (int j = 0; j < 4; ++j) vn[j] = ((const f32x4*)xr)[lane + 64 * j]; }
        const int s = m < ML ? (m >> 12) : 8; const float* md = modl + (size_t)s * 6144;
        float ss = 0.f;
#pragma unroll
        for (int j = 0; j < 4; ++j) ss += (v[j].x * v[j].x + v[j].y * v[j].y) + (v[j].z * v[j].z + v[j].w * v[j].w);
        const float rstd = rsqrtf(wave_sum(ss) * (1.0f / DM) + 1e-6f);
#pragma unroll
        for (int j = 0; j < 4; ++j) { const int c4 = lane + 64 * j; const f32x4 g = ((const f32x4*)gamma)[c4], sc = ((const f32x4*)(md + scoff))[c4], sh = ((const f32x4*)(md + shoff))[c4];
            const f32x4 y = (v[j] * rstd * g) * (sc + 1.0f) + sh; u32x2 o; o.x = cvtpk(y.x, y.y); o.y = cvtpk(y.z, y.w);
            ((u32x2*)(XN + (size_t)m * DM))[c4] = o; }
#pragma unroll
        for (int j = 0; j < 4; ++j) v[j] = vn[j];
        m = mn;
    }
}
__device__ __forceinline__ void final_norm_rows(float* x, const float* gamma, int gw, int ngw, int lane) {
    for (int m = gw; m < ML; m += ngw) {
        float* xr = x + (size_t)m * DM; f32x4 v[4]; float ss = 0.f;
#pragma unroll
        for (int j = 0; j < 4; ++j) { v[j] = ((const f32x4*)xr)[lane + 64 * j]; ss += (v[j].x * v[j].x + v[j].y * v[j].y) + (v[j].z * v[j].z + v[j].w * v[j].w); }
        const float rstd = rsqrtf(wave_sum(ss) * (1.0f / DM) + 1e-6f);
#pragma unroll
        for (int j = 0; j < 4; ++j) { const int c4 = lane + 64 * j; ((f32x4*)xr)[c4] = v[j] * rstd * ((const f32x4*)gamma)[c4]; }
    }
}
#define XB_TMO      128
#define XB_XCNT(j)  (256  + 64 * (j))
#define XB_XSUB(j)  (1280 + 64 * (j))
#define XB_XGEN(j)  (2304 + 64 * (j))
#define XB_TOP      3328
#define XB_TOPGEN   3392
#define XCD_BAR_WORDS 3456
#define XB_SPIN_CAP (1u << 18)

__device__ __forceinline__ unsigned xb_ld(unsigned* p)              { return __hip_atomic_load(p, __ATOMIC_RELAXED, __HIP_MEMORY_SCOPE_AGENT); }
__device__ __forceinline__ unsigned xb_add(unsigned* p, unsigned v) { return __hip_atomic_fetch_add(p, v, __ATOMIC_RELAXED, __HIP_MEMORY_SCOPE_AGENT); }
__device__ __forceinline__ unsigned xb_xcc_id() { return (unsigned)__builtin_amdgcn_s_getreg((3 << 11) | 20) & 0xFu; }
#define XB_SPIN(cond, bar) do { unsigned _sp = 0; while (cond) { __builtin_amdgcn_s_sleep(1); \
    if ((++_sp & 255u) == 0u) { if (xb_ld(&(bar)[XB_TMO])) break; if (_sp > XB_SPIN_CAP) { atomicAdd(&(bar)[XB_TMO], 1u); break; } } } } while (0)

struct XcdBarrier {
    unsigned* bar; unsigned x;
    volatile LAS unsigned* st;
};

__device__ __forceinline__ XcdBarrier xcd_barrier_post(unsigned* bar, volatile LAS unsigned* st) {
    XcdBarrier b; b.bar = bar; b.x = xb_xcc_id(); b.st = st;
    if (threadIdx.x == 0) (void)xb_add(&bar[XB_XCNT(b.x)], 1u);
    return b;
}
__device__ __forceinline__ void xcd_barrier_complete(unsigned* bar, unsigned x, unsigned& nloc, unsigned& nx) {
    const unsigned G = gridDim.x * gridDim.y * gridDim.z;
    unsigned sum, cnt, mine, sp = 0u;
    for (;;) {
        sum = 0u; cnt = 0u; mine = 0u;
#pragma unroll
        for (unsigned j = 0; j < 16; ++j) { const unsigned c = xb_ld(&bar[XB_XCNT(j)]); sum += c; cnt += (c > 0u) ? 1u : 0u; mine = (j == x) ? c : mine; }
        if (sum == G) break;
        __builtin_amdgcn_s_sleep(1);
        if ((++sp & 255u) == 0u) { if (xb_ld(&bar[XB_TMO])) break; if (sp > XB_SPIN_CAP) { atomicAdd(&bar[XB_TMO], 1u); break; } }
    }
    nloc = mine > 0u ? mine : 1u; nx = cnt > 0u ? cnt : 1u;
}

__device__ __forceinline__ void xcd_barrier(const XcdBarrier& b) {
    asm volatile("s_waitcnt vmcnt(0)" ::: "memory");
    __syncthreads();
    if (threadIdx.x == 0) {
        unsigned* bar = b.bar;
        __builtin_amdgcn_s_waitcnt(0);
        unsigned nloc = b.st[0], nx = b.st[1];
        if (nloc == 0u) { xcd_barrier_complete(bar, b.x, nloc, nx); b.st[0] = nloc; b.st[1] = nx; }
        const unsigned old = xb_add(&bar[XB_XSUB(b.x)], 1u);
        const unsigned gen = old / nloc;
        if (old + 1u == (gen + 1u) * nloc) {
            __builtin_amdgcn_fence(__ATOMIC_RELEASE, "agent");
            asm volatile("s_waitcnt vmcnt(0)" ::: "memory");
            const unsigned og = xb_add(&bar[XB_TOP], 1u);
            const unsigned tg = og / nx;
            if (og + 1u == (tg + 1u) * nx) xb_add(&bar[XB_TOPGEN], 1u);
            else XB_SPIN(xb_ld(&bar[XB_TOPGEN]) == tg, bar);
            __builtin_amdgcn_fence(__ATOMIC_ACQUIRE, "agent");
            xb_add(&bar[XB_XGEN(b.x)], 1u);
            asm volatile("s_waitcnt vmcnt(0)" ::: "memory");
        } else {
            XB_SPIN(xb_ld(&bar[XB_XGEN(b.x)]) == gen, bar);
            __builtin_amdgcn_fence(__ATOMIC_ACQUIRE, "agent");
            asm volatile("s_waitcnt vmcnt(0)" ::: "memory");
        }
    }
    __syncthreads();
}
__device__ __forceinline__ bf16x8 load_wfrag(const float* W, int k0, int c) {
    u32x4 t; t.x = pk2(W[(k0 + 0) * 256 + c], W[(k0 + 1) * 256 + c]); t.y = pk2(W[(k0 + 2) * 256 + c], W[(k0 + 3) * 256 + c]);
    t.z = pk2(W[(k0 + 4) * 256 + c], W[(k0 + 5) * 256 + c]); t.w = pk2(W[(k0 + 6) * 256 + c], W[(k0 + 7) * 256 + c]);
    return __builtin_bit_cast(bf16x8, t);
}
__device__ __forceinline__ u32x2 pack_h4(float a, float b, float c, float d) {
    const h4 v = {(hf)a, (hf)b, (hf)c, (hf)d}; return __builtin_bit_cast(u32x2, v);
}
__device__ __forceinline__ void phase_prep(unsigned char* ldsg, kparams_t p, int l, int tid, int bid, int G, bool do_rope) {
    LAS unsigned char* lds = (LAS unsigned char*)ldsg;
    LAS float* SH = (LAS float*)lds;
    LAS unsigned char* ACT = lds + 73728;
    LAS float* KK = (LAS float*)(lds + 86272);
    LAS float* GL = (LAS float*)(lds + 102656);
    const int lane = tid & 63, wave = tid >> 6, fr = lane & 15, quad = lane >> 4;
    bf16_t* P1 = (bf16_t*)(p->ws + WS_P1); const bf16_t* RAW = (const bf16_t*)(p->ws + WS_RAW);
    hf* PREP = (hf*)(p->ws + WS_PREP); hf* PG = (hf*)(p->ws + WS_PG); hf* GG = (hf*)(p->ws + WS_GG); float* BONUS = (float*)(p->ws + WS_BONUS);
    const float* RC = (const float*)(p->ws + WS_ROPE); const float* RS = RC + 4096 * 32;
    const float* shw = p->in[14] + (size_t)l * 3 * RAWC;
    const float* w0 = p->in[15] + (size_t)l * 512; const float* w2 = p->in[16] + (size_t)l * 2 * 64 * 256;
    const float* a0 = p->in[17] + (size_t)l * 512; const float* a2 = p->in[18] + (size_t)l * 2 * 64 * 256;
    const float* g2 = p->in[19] + (size_t)l * 128 * 256;
    const float* k_k = p->in[20] + l * 256; const float* k_a = p->in[21] + l * 256; const float* r_k = p->in[22] + l * 256;
    const float* dw = p->in[10] + (size_t)l * 2 * 16 * 128; const float* db = p->in[11] + l * 256;
    bf16x8 Fw[2][2][2], Fa[2][2][2], Fg[2][4];
#pragma unroll
    for (int ct2 = 0; ct2 < 2; ++ct2) { const int c = (wave * 2 + ct2) * 16 + fr;
#pragma unroll
        for (int i = 0; i < 2; ++i)
#pragma unroll
            for (int ks = 0; ks < 2; ++ks) { Fw[i][ct2][ks] = load_wfrag(w2 + (size_t)i * 64 * 256, ks * 32 + quad * 8, c); Fa[i][ct2][ks] = load_wfrag(a2 + (size_t)i * 64 * 256, ks * 32 + quad * 8, c); }
#pragma unroll
        for (int ks = 0; ks < 4; ++ks) Fg[ct2][ks] = load_wfrag(g2, ks * 32 + quad * 8, c); }
    const int cgp = tid % 144, part = tid / 144, c8 = cgp * 8;
    const int tokb = part == 0 ? 0 : (part == 1 ? 6 : 11), toke = part == 0 ? 6 : (part == 1 ? 11 : 16);
    for (int tile = bid; tile < MT / 16; tile += G) {
        const int row0 = tile * 16; const bool lat = row0 < ML;
        const int t0 = lat ? (row0 & 4095) : ((row0 - ML) & 255); const int T = lat ? 4096 : 256;
        if (part < 3) {
            float sw0[8], sw1[8], sw2[8];
#pragma unroll
            for (int e = 0; e < 8; ++e) { sw0[e] = shw[c8 + e]; sw1[e] = shw[RAWC + c8 + e]; sw2[e] = shw[2 * RAWC + c8 + e]; }
            const u32x4 z4 = {0u, 0u, 0u, 0u};
            const bf16_t* rp = RAW + (size_t)(row0 + tokb) * RAWC + c8;
            const int ntok = toke - tokb;
            u32x4 rw[8];
#pragma unroll
            for (int j = 0; j < 8; ++j) { const int tt = t0 + tokb - 1 + j; rw[j] = (j < ntok + 2 && tt >= 0 && tt < T) ? *(const u32x4*)(rp + (ptrdiff_t)(j - 1) * RAWC) : z4; }
#pragma unroll
            for (int j = 0; j < 6; ++j) {
                if (j < ntok) {
                    const int tok = tokb + j; const u32x4 prv = rw[j], cur = rw[j + 1], nxt = rw[j + 2];
                    f32x4 o0, o1;
#pragma unroll
                    for (int e = 0; e < 4; ++e) {
                        const float x0 = sw0[2 * e] * bflo(prv[e]) + sw1[2 * e] * bflo(cur[e]) + sw2[2 * e] * bflo(nxt[e]);
                        const float x1 = sw0[2 * e + 1] * bfhi(prv[e]) + sw1[2 * e + 1] * bfhi(cur[e]) + sw2[2 * e + 1] * bfhi(nxt[e]);
                        if (e < 2) { o0[2 * e] = x0; o0[2 * e + 1] = x1; } else { o1[2 * e - 4] = x0; o1[2 * e - 3] = x1; }
                    }
                    *(LAS f32x4*)(SH + tok * RAWC + c8) = o0; *(LAS f32x4*)(SH + tok * RAWC + c8 + 4) = o1;
                }
            }
        }
        { const int tok = tid >> 5, j = tid & 31; GL[j * 16 + tok] = bf2f(P1[(size_t)(row0 + tok) * P1C + 768 + j]); }
        __syncthreads();
        for (int idx = tid; idx < 16 * 192; idx += NTHREADS) {
            const int tok = idx / 192, j2 = (idx % 192) * 2; const float xa = SH[tok * RAWC + 768 + j2], xb = SH[tok * RAWC + 768 + j2 + 1];
            float ya, yb;
            if (j2 < 128) { ya = 1.0f - 2.0f * __builtin_amdgcn_rcpf(__expf(2.0f * xa) + 1.0f); yb = 1.0f - 2.0f * __builtin_amdgcn_rcpf(__expf(2.0f * xb) + 1.0f); }
            else if (j2 < 256) { ya = xa; yb = xb; }
            else { ya = sigmoidf_(xa); yb = sigmoidf_(xb); }
            *(LAS unsigned*)(ACT + tok * 784 + j2 * 2) = cvtpk(ya, yb);
        }
#pragma unroll 1
        for (int i = 0; i < 8; ++i) {
            const int pair = wave * 8 + i, tok = pair >> 2, h = pair & 3, c = h * 64 + lane; const size_t row = row0 + tok;
            const float r = SH[tok * RAWC + c], k = SH[tok * RAWC + 256 + c], v = SH[tok * RAWC + 512 + c];
            const float val = k * k_k[c]; const float ss = wave_sum(val * val); const float kk = val * rsqrtf(ss + 1e-12f);
            KK[tok * 256 + c] = kk;
            const float bon = wave_sum(r * k * r_k[c]);
            if (lane == 0) BONUS[row * 4 + h] = bon;
            PREP[row * PRC + c] = (hf)r; PREP[row * PRC + 256 + c] = (hf)kk; PREP[row * PRC + 512 + c] = (hf)v;
        }
        __syncthreads();
        {
#define BFRAG(s2) (*(const LAS bf16x8*)(ACT + fr * 784 + ((s2) * 32 + quad * 8) * 2))
            const size_t row = row0 + fr;
#pragma unroll
            for (int ct2 = 0; ct2 < 2; ++ct2) {
                const int c0 = (wave * 2 + ct2) * 16 + quad * 4;
                const f32x4 zf = {0.f, 0.f, 0.f, 0.f};
                const f32x4 k4 = *(const LAS f32x4*)(SH + fr * RAWC + 256 + c0), kk4 = *(const LAS f32x4*)(KK + fr * 256 + c0), ka4 = *(const f32x4*)(k_a + c0);
#pragma unroll
                for (int i = 0; i < 2; ++i) {
                    f32x4 aw = __builtin_amdgcn_mfma_f32_16x16x32_bf16(Fw[i][ct2][0], BFRAG(i * 2), zf, 0, 0, 0); aw = __builtin_amdgcn_mfma_f32_16x16x32_bf16(Fw[i][ct2][1], BFRAG(i * 2 + 1), aw, 0, 0, 0);
                    f32x4 aa = __builtin_amdgcn_mfma_f32_16x16x32_bf16(Fa[i][ct2][0], BFRAG(4 + i * 2), zf, 0, 0, 0); aa = __builtin_amdgcn_mfma_f32_16x16x32_bf16(Fa[i][ct2][1], BFRAG(4 + i * 2 + 1), aa, 0, 0, 0);
                    const f32x4 z = aw + *(const f32x4*)(w0 + i * 256 + c0), az = aa + *(const f32x4*)(a0 + i * 256 + c0);
                    float dec[4], bb[4], kd[4];
#pragma unroll
                    for (int j = 0; j < 4; ++j) { dec[j] = __expf(-__expf(-softplusf_(-z[j]) - 0.5f)); const float a = sigmoidf_(az[j]); bb[j] = -(kk4[j] * a); kd[j] = k4[j] * (1.0f + (a - 1.0f) * ka4[j]); }
                    hf* dst = PREP + row * PRC + 768 + i * 768 + c0;
                    *(u32x2*)dst = pack_h4(dec[0], dec[1], dec[2], dec[3]); *(u32x2*)(dst + 256) = pack_h4(bb[0], bb[1], bb[2], bb[3]); *(u32x2*)(dst + 512) = pack_h4(kd[0], kd[1], kd[2], kd[3]);
                }
                f32x4 ag = __builtin_amdgcn_mfma_f32_16x16x32_bf16(Fg[ct2][0], BFRAG(8), zf, 0, 0, 0);
#pragma unroll
                for (int ks = 1; ks < 4; ++ks) ag = __builtin_amdgcn_mfma_f32_16x16x32_bf16(Fg[ct2][ks], BFRAG(8 + ks), ag, 0, 0, 0);
                *(u32x2*)(GG + row * 256 + c0) = pack_h4(ag[0], ag[1], ag[2], ag[3]);
            }
        }
        {
            const int c = tid & 127, i = (tid >> 7) & 1, th = tid >> 8;
            float acc[8]; const float bb = db[i * 128 + c];
#pragma unroll
            for (int q = 0; q < 8; ++q) acc[q] = bb;
            const float* W = dw + (size_t)i * 16 * 128 + c;
#pragma unroll
            for (int j = 0; j < 16; ++j) { const float wv = W[j * 128]; const f32x4 ta = *(const LAS f32x4*)(GL + (i * 16 + j) * 16 + th * 8), tb = *(const LAS f32x4*)(GL + (i * 16 + j) * 16 + th * 8 + 4);
                acc[0] = fmaf(ta.x, wv, acc[0]); acc[1] = fmaf(ta.y, wv, acc[1]); acc[2] = fmaf(ta.z, wv, acc[2]); acc[3] = fmaf(ta.w, wv, acc[3]);
                acc[4] = fmaf(tb.x, wv, acc[4]); acc[5] = fmaf(tb.y, wv, acc[5]); acc[6] = fmaf(tb.z, wv, acc[6]); acc[7] = fmaf(tb.w, wv, acc[7]); }
#pragma unroll
            for (int q = 0; q < 8; ++q) { const float glog = -softplusf_(-acc[q]) * (1.0f / 16.0f); PG[(size_t)(row0 + th * 8 + q) * PGC + 256 + i * 128 + c] = (hf)__expf(glog); }
            { const int tok = tid >> 5, c8q = (tid & 31) * 8; const u32x4 x = *(const u32x4*)(P1 + (size_t)(row0 + tok) * P1C + c8q); const float sc = c8q < 128 ? 0.17677669529663687f : 1.0f;
              u32x4 o;
#pragma unroll
              for (int e = 0; e < 4; ++e) { const h4 t = {(hf)(bflo(x[e]) * sc), (hf)(bfhi(x[e]) * sc), (hf)0.f, (hf)0.f}; o[e] = __builtin_bit_cast(u32x2, t).x; }
              *(u32x4*)(PG + (size_t)(row0 + tok) * PGC + c8q) = o; }
        }
        if (lat && do_rope) {
            for (int task = tid; task < 640; task += NTHREADS) {
                const int tok = task / 40, r = task % 40, hh = r >> 2, gi = r & 3; const int t = t0 + tok;
                bf16_t* ptr = P1 + (size_t)(row0 + tok) * P1C + 800 + hh * 64 + gi * 8;
                const u32x4 x1 = *(const u32x4*)ptr, x2 = *(const u32x4*)(ptr + 32);
                const f32x4 ca = *(const f32x4*)(RC + t * 32 + gi * 8), cb = *(const f32x4*)(RC + t * 32 + gi * 8 + 4), sa = *(const f32x4*)(RS + t * 32 + gi * 8), sb = *(const f32x4*)(RS + t * 32 + gi * 8 + 4);
                const float cs[8] = {ca.x, ca.y, ca.z, ca.w, cb.x, cb.y, cb.z, cb.w}, sn[8] = {sa.x, sa.y, sa.z, sa.w, sb.x, sb.y, sb.z, sb.w};
                u32x4 o1, o2;
#pragma unroll
                for (int e = 0; e < 4; ++e) {
                    const float a0_ = bflo(x1[e]), a1_ = bfhi(x1[e]), b0_ = bflo(x2[e]), b1_ = bfhi(x2[e]);
                    const float c0_ = cs[2 * e], c1_ = cs[2 * e + 1], s0_ = sn[2 * e], s1_ = sn[2 * e + 1];
                    o1[e] = cvtpk(a0_ * c0_ - b0_ * s0_, a1_ * c1_ - b1_ * s1_); o2[e] = cvtpk(a0_ * s0_ + b0_ * c0_, a1_ * s1_ + b1_ * c1_);
                }
                *(u32x4*)ptr = o1; *(u32x4*)(ptr + 32) = o2;
            }
        }
        __syncthreads();
    }
}
#ifndef NO_MIX
#define MIXLO(d, a, h, c) asm("v_fma_mix_f32 %0, %1, %2, %3 op_sel:[0,0,0] op_sel_hi:[0,1,0]" : "=v"(d) : "v"(a), "v"(h), "v"(c))
#define MIXHI(d, a, h, c) asm("v_fma_mix_f32 %0, %1, %2, %3 op_sel:[0,1,0] op_sel_hi:[0,1,0]" : "=v"(d) : "v"(a), "v"(h), "v"(c))
#else
#define MIXLO(d, a, h, c) d = fmaf(a, (float)__builtin_bit_cast(hf, (unsigned short)((h) & 0xffffu)), c)
#define MIXHI(d, a, h, c) d = fmaf(a, (float)__builtin_bit_cast(hf, (unsigned short)((h) >> 16)), c)
#endif
#define DSR128(dst, addr, OFF) asm volatile("ds_read_b128 %0, %1 offset:" #OFF : "=v"(dst) : "v"(addr))
#define DSR64(dst, addr, OFF) asm volatile("ds_read_b64 %0, %1 offset:" #OFF : "=v"(dst) : "v"(addr))
#define DSR16(dst, addr, OFF) asm volatile("ds_read_u16 %0, %1 offset:" #OFF : "=v"(dst) : "v"(addr))
#define LDS_BAR() do { asm volatile("s_waitcnt lgkmcnt(0)" ::: "memory"); __builtin_amdgcn_s_barrier(); asm volatile("" ::: "memory"); } while (0)
#define REP32(M) M(0) M(1) M(2) M(3) M(4) M(5) M(6) M(7) M(8) M(9) M(10) M(11) M(12) M(13) M(14) M(15) M(16) M(17) M(18) M(19) M(20) M(21) M(22) M(23) M(24) M(25) M(26) M(27) M(28) M(29) M(30) M(31)
__device__ __forceinline__ unsigned lds_addr(LAS unsigned char* p) { return (unsigned)(uintptr_t)p; }

__device__ __forceinline__ int chain_row(int b, int dir, int s) {
    if (s < 256) return ML + b * 256 + (dir ? 255 - s : s);
    const int t = s - 256; return b * 4096 + (dir ? 4095 - t : t);
}
constexpr int NCHUNK = (SEQ + CTXL) / 32;
__device__ __forceinline__ void rwkv_scan_item(unsigned char* ldsg, kparams_t p, int item, int tid, int expflag) {
    LAS unsigned char* lds = (LAS unsigned char*)ldsg;
    constexpr int STEPB = 704, BUFB = 32 * STEPB, NPIECE = 32 * 44;
    LAS unsigned char* obuf = lds + 2 * BUFB;
    const int chain = item >> 1, half_ = item & 1, b = chain >> 3, h = (chain >> 1) & 3, dir = chain & 1;
    const int lane = tid & 63, wave = tid >> 6, kq = lane & 15, rloc = wave * 4 + (lane >> 4);
    const hf* PREP = (const hf*)(p->ws + WS_PREP); hf* OR = (hf*)(p->ws + WS_OR) + (size_t)dir * MT * 256;
    int srcoff[6]; srcoff[0] = h * 64; srcoff[1] = 256 + h * 64; srcoff[2] = 768 + dir * 768 + h * 64; srcoff[3] = srcoff[2] + 256; srcoff[4] = srcoff[2] + 512; srcoff[5] = 512 + h * 64 + half_ * 32;
    float S[4];
#pragma unroll
    for (int i = 0; i < 4; ++i) S[i] = 0.f;
    u32x4 pre[3];
#define RW_ISSUE(cc) do { const bool isctx_ = (cc) < 8; _Pragma("unroll") for (int i_ = 0; i_ < 3; ++i_) { int pp = tid + i_ * NTHREADS; pp = pp < NPIECE ? pp : pp - NTHREADS; const int st = pp / 44, q = pp % 44; \
        const int s_ = (cc) * 32 + st, t_ = s_ - 256; const int row = isctx_ ? (ML + b * 256 + (dir ? 255 - s_ : s_)) : (b * 4096 + (dir ? 4095 - t_ : t_)); \
        const int arr = q >> 3; const int so = arr == 0 ? srcoff[0] : arr == 1 ? srcoff[1] : arr == 2 ? srcoff[2] : arr == 3 ? srcoff[3] : arr == 4 ? srcoff[4] : srcoff[5]; \
        pre[i_] = *(const u32x4*)(PREP + (size_t)row * PRC + so + (q & 7) * 8); } } while (0)
#define RW_COMMIT(cc) do { _Pragma("unroll") for (int i_ = 0; i_ < 3; ++i_) { const int pp = tid + i_ * NTHREADS; if (pp < NPIECE) { const int st = pp / 44, q = pp % 44; \
        *(LAS u32x4*)(lds + ((cc) & 1) * BUFB + st * STEPB + q * 16) = pre[i_]; } } } while (0)
    RW_ISSUE(0); RW_COMMIT(0); RW_ISSUE(1);
    __syncthreads();
    for (int c = 0; c < NCHUNK; ++c) {
        if (expflag != 2) { if (c + 1 < NCHUNK) RW_COMMIT(c + 1);
        if (c + 2 < NCHUNK) RW_ISSUE(c + 2); }
        if (c > 0 && tid < 128) { const int cc = c - 1; const int st = tid >> 2, pc = tid & 3; const int row = chain_row(b, dir, cc * 32 + st);
            *(u32x4*)(OR + (size_t)row * 256 + h * 64 + half_ * 32 + pc * 8) = *(const LAS u32x4*)(obuf + (cc & 1) * 2048 + st * 64 + pc * 16); }
        if (expflag != 1) {
            const unsigned abase = lds_addr(lds + (c & 1) * BUFB) + kq * 8, vbase = lds_addr(lds + (c & 1) * BUFB) + 640 + rloc * 2;
            LAS hf* op = (LAS hf*)(obuf + (c & 1) * 2048 + rloc * 2);
            u32x2 LR[2], LK[2], LW[2], LB[2], LD[2]; unsigned LV[2]; const float zero = 0.f;
#define RW_LOAD(slot, o0, o1, o2, o3, o4) do { DSR64(LR[slot], abase, o0); DSR64(LK[slot], abase, o1); DSR64(LW[slot], abase, o2); DSR64(LB[slot], abase, o3); DSR64(LD[slot], abase, o4); } while (0)
#define RW_COMPUTE(cur, st) do { \
                const float vv = (float)__builtin_bit_cast(hf, (unsigned short)LV[cur]); \
                float sa0 = 0.f, sa1 = 0.f; \
                _Pragma("unroll") for (int i = 0; i < 2; ++i) { MIXLO(sa0, S[2 * i], LK[cur][i], sa0); MIXHI(sa1, S[2 * i + 1], LK[cur][i], sa1); } \
                const float nsa = reduce16(sa0 + sa1); \
                float o0 = 0.f, o1 = 0.f; \
                _Pragma("unroll") for (int i = 0; i < 2; ++i) { float u0, u1; \
                    MIXLO(u0, vv, LD[cur][i], zero); MIXHI(u1, vv, LD[cur][i], zero); \
                    MIXLO(u0, nsa, LB[cur][i], u0); MIXHI(u1, nsa, LB[cur][i], u1); \
                    MIXLO(S[2 * i], S[2 * i], LW[cur][i], u0); MIXHI(S[2 * i + 1], S[2 * i + 1], LW[cur][i], u1); \
                    MIXLO(o0, S[2 * i], LR[cur][i], o0); MIXHI(o1, S[2 * i + 1], LR[cur][i], o1); } \
                const float o = reduce16(o0 + o1); \
                op[(st) * 32] = (hf)o; } while (0)
#define RW_PIN(n, cur) asm volatile("s_waitcnt lgkmcnt(" #n ")" : "+v"(LR[cur]), "+v"(LK[cur]), "+v"(LW[cur]), "+v"(LB[cur]), "+v"(LD[cur]), "+v"(LV[cur]))
            RW_LOAD(0, 0, 128, 256, 384, 512); DSR16(LV[0], vbase, 0);
            RW_LOAD(1, 704, 832, 960, 1088, 1216); DSR16(LV[1], vbase, 704); RW_PIN(6, 0); RW_COMPUTE(0, 0);
            RW_LOAD(0, 1408, 1536, 1664, 1792, 1920); DSR16(LV[0], vbase, 1408); RW_PIN(6, 1); RW_COMPUTE(1, 1);
            RW_LOAD(1, 2112, 2240, 2368, 2496, 2624); DSR16(LV[1], vbase, 2112); RW_PIN(6, 0); RW_COMPUTE(0, 2);
            RW_LOAD(0, 2816, 2944, 3072, 3200, 3328); DSR16(LV[0], vbase, 2816); RW_PIN(6, 1); RW_COMPUTE(1, 3);
            RW_LOAD(1, 3520, 3648, 3776, 3904, 4032); DSR16(LV[1], vbase, 3520); RW_PIN(6, 0); RW_COMPUTE(0, 4);
            RW_LOAD(0, 4224, 4352, 4480, 4608, 4736); DSR16(LV[0], vbase, 4224); RW_PIN(6, 1); RW_COMPUTE(1, 5);
            RW_LOAD(1, 4928, 5056, 5184, 5312, 5440); DSR16(LV[1], vbase, 4928); RW_PIN(6, 0); RW_COMPUTE(0, 6);
            RW_LOAD(0, 5632, 5760, 5888, 6016, 6144); DSR16(LV[0], vbase, 5632); RW_PIN(6, 1); RW_COMPUTE(1, 7);
            RW_LOAD(1, 6336, 6464, 6592, 6720, 6848); DSR16(LV[1], vbase, 6336); RW_PIN(6, 0); RW_COMPUTE(0, 8);
            RW_LOAD(0, 7040, 7168, 7296, 7424, 7552); DSR16(LV[0], vbase, 7040); RW_PIN(6, 1); RW_COMPUTE(1, 9);
            RW_LOAD(1, 7744, 7872, 8000, 8128, 8256); DSR16(LV[1], vbase, 7744); RW_PIN(6, 0); RW_COMPUTE(0, 10);
            RW_LOAD(0, 8448, 8576, 8704, 8832, 8960); DSR16(LV[0], vbase, 8448); RW_PIN(6, 1); RW_COMPUTE(1, 11);
            RW_LOAD(1, 9152, 9280, 9408, 9536, 9664); DSR16(LV[1], vbase, 9152); RW_PIN(6, 0); RW_COMPUTE(0, 12);
            RW_LOAD(0, 9856, 9984, 10112, 10240, 10368); DSR16(LV[0], vbase, 9856); RW_PIN(6, 1); RW_COMPUTE(1, 13);
            RW_LOAD(1, 10560, 10688, 10816, 10944, 11072); DSR16(LV[1], vbase, 10560); RW_PIN(6, 0); RW_COMPUTE(0, 14);
            RW_LOAD(0, 11264, 11392, 11520, 11648, 11776); DSR16(LV[0], vbase, 11264); RW_PIN(6, 1); RW_COMPUTE(1, 15);
            RW_LOAD(1, 11968, 12096, 12224, 12352, 12480); DSR16(LV[1], vbase, 11968); RW_PIN(6, 0); RW_COMPUTE(0, 16);
            RW_LOAD(0, 12672, 12800, 12928, 13056, 13184); DSR16(LV[0], vbase, 12672); RW_PIN(6, 1); RW_COMPUTE(1, 17);
            RW_LOAD(1, 13376, 13504, 13632, 13760, 13888); DSR16(LV[1], vbase, 13376); RW_PIN(6, 0); RW_COMPUTE(0, 18);
            RW_LOAD(0, 14080, 14208, 14336, 14464, 14592); DSR16(LV[0], vbase, 14080); RW_PIN(6, 1); RW_COMPUTE(1, 19);
            RW_LOAD(1, 14784, 14912, 15040, 15168, 15296); DSR16(LV[1], vbase, 14784); RW_PIN(6, 0); RW_COMPUTE(0, 20);
            RW_LOAD(0, 15488, 15616, 15744, 15872, 16000); DSR16(LV[0], vbase, 15488); RW_PIN(6, 1); RW_COMPUTE(1, 21);
            RW_LOAD(1, 16192, 16320, 16448, 16576, 16704); DSR16(LV[1], vbase, 16192); RW_PIN(6, 0); RW_COMPUTE(0, 22);
            RW_LOAD(0, 16896, 17024, 17152, 17280, 17408); DSR16(LV[0], vbase, 16896); RW_PIN(6, 1); RW_COMPUTE(1, 23);
            RW_LOAD(1, 17600, 17728, 17856, 17984, 18112); DSR16(LV[1], vbase, 17600); RW_PIN(6, 0); RW_COMPUTE(0, 24);
            RW_LOAD(0, 18304, 18432, 18560, 18688, 18816); DSR16(LV[0], vbase, 18304); RW_PIN(6, 1); RW_COMPUTE(1, 25);
            RW_LOAD(1, 19008, 19136, 19264, 19392, 19520); DSR16(LV[1], vbase, 19008); RW_PIN(6, 0); RW_COMPUTE(0, 26);
            RW_LOAD(0, 19712, 19840, 19968, 20096, 20224); DSR16(LV[0], vbase, 19712); RW_PIN(6, 1); RW_COMPUTE(1, 27);
            RW_LOAD(1, 20416, 20544, 20672, 20800, 20928); DSR16(LV[1], vbase, 20416); RW_PIN(6, 0); RW_COMPUTE(0, 28);
            RW_LOAD(0, 21120, 21248, 21376, 21504, 21632); DSR16(LV[0], vbase, 21120); RW_PIN(6, 1); RW_COMPUTE(1, 29);
            RW_LOAD(1, 21824, 21952, 22080, 22208, 22336); DSR16(LV[1], vbase, 21824); RW_PIN(6, 0); RW_COMPUTE(0, 30);
            RW_PIN(0, 1); RW_COMPUTE(1, 31);
#undef RW_LOAD
#undef RW_COMPUTE
#undef RW_PIN
        }
        LDS_BAR();
    }
    { const int cc = NCHUNK - 1; if (tid < 128) { const int st = tid >> 2, pc = tid & 3; const int row = chain_row(b, dir, cc * 32 + st);
        *(u32x4*)(OR + (size_t)row * 256 + h * 64 + half_ * 32 + pc * 8) = *(const LAS u32x4*)(obuf + (cc & 1) * 2048 + st * 64 + pc * 16); } }
#undef RW_ISSUE
#undef RW_COMMIT
}
__device__ __forceinline__ void gla_scan_item(unsigned char* ldsg, kparams_t p, int item, int tid) {
    const int chain = item >> 1, half_ = item & 1;
    LAS unsigned char* lds = (LAS unsigned char*)ldsg;
    constexpr int STEPB = 320, BUFB = 32 * STEPB, NPIECE = 32 * 20;
    LAS unsigned char* obuf = lds + 2 * BUFB;
    const int b = chain >> 3, h = (chain >> 1) & 3, dir = chain & 1;
    const int lane = tid & 63, wave = tid >> 6, dq = lane & 7, col = half_ * 32 + (wave & 3) * 8 + (lane >> 3);
    const hf* PG = (const hf*)(p->ws + WS_PG); const bf16_t* P1 = (const bf16_t*)(p->ws + WS_P1); hf* OG = (hf*)(p->ws + WS_OG) + (size_t)dir * MT * 256;
    float S[4];
#pragma unroll
    for (int i = 0; i < 4; ++i) S[i] = 0.f;
    u32x4 pre[3]; const int t4 = tid - 256;
#define GL_ISSUE(cc) do { const bool isctx_ = (cc) < 8; _Pragma("unroll") for (int i_ = 0; i_ < 3; ++i_) { int pp = t4 + i_ * 256; pp = pp < NPIECE ? pp : pp - 256; const int st = pp / 20, q = pp % 20; \
        const int s_ = (cc) * 32 + st, t_ = s_ - 256; const int row = isctx_ ? (ML + b * 256 + (dir ? 255 - s_ : s_)) : (b * 4096 + (dir ? 4095 - t_ : t_)); \
        const int arr = q >> 2; const int so = arr == 0 ? h * 32 : arr == 1 ? 128 + h * 32 : 256 + dir * 128 + h * 32; \
        const unsigned char* sp = q < 12 ? (const unsigned char*)(PG + (size_t)row * PGC + so + (q & 3) * 8) : (const unsigned char*)(P1 + (size_t)row * P1C + 256 + h * 64 + (q - 12) * 8); \
        pre[i_] = *(const u32x4*)sp; } } while (0)
#define GL_COMMIT(cc) do { _Pragma("unroll") for (int i_ = 0; i_ < 3; ++i_) { const int pp = t4 + i_ * 256; if (pp < NPIECE) { const int st = pp / 20, q = pp % 20; \
        *(LAS u32x4*)(lds + ((cc) & 1) * BUFB + st * STEPB + q * 16) = pre[i_]; } } } while (0)
    if (wave >= 4) { GL_ISSUE(0); GL_COMMIT(0); GL_ISSUE(1); }
    __syncthreads();
    for (int c = 0; c < NCHUNK; ++c) {
        if (wave >= 4) {
            if (c + 1 < NCHUNK) GL_COMMIT(c + 1);
            if (c + 2 < NCHUNK) GL_ISSUE(c + 2);
            if (c > 0 && t4 < 128) { const int cc = c - 1; const int st = t4 >> 2, pc = t4 & 3; const int row = chain_row(b, dir, cc * 32 + st);
                *(u32x4*)(OG + (size_t)row * 256 + h * 64 + half_ * 32 + pc * 8) = *(const LAS u32x4*)(obuf + (cc & 1) * 4096 + st * 128 + half_ * 64 + pc * 16); }
        }
        if (wave < 4) {
            const unsigned abase = lds_addr(lds + (c & 1) * BUFB) + dq * 8, vbase = lds_addr(lds + (c & 1) * BUFB) + 192 + col * 2;
            LAS hf* op = (LAS hf*)(obuf + (c & 1) * 4096 + col * 2);
            u32x2 LQ[2], LK[2], LE[2]; unsigned LV[2]; const float zero = 0.f;
#define GL_LOAD(slot, o0, o1, o2) do { DSR64(LQ[slot], abase, o0); DSR64(LK[slot], abase, o1); DSR64(LE[slot], abase, o2); } while (0)
#define GL_COMPUTE(cur, st) do { \
                const float vv = __uint_as_float(LV[cur] << 16); \
                float o0 = 0.f, o1 = 0.f; \
                _Pragma("unroll") for (int i = 0; i < 2; ++i) { float u0, u1; \
                    MIXLO(u0, vv, LK[cur][i], zero); MIXHI(u1, vv, LK[cur][i], zero); \
                    MIXLO(S[2 * i], S[2 * i], LE[cur][i], u0); MIXHI(S[2 * i + 1], S[2 * i + 1], LE[cur][i], u1); \
                    MIXLO(o0, S[2 * i], LQ[cur][i], o0); MIXHI(o1, S[2 * i + 1], LQ[cur][i], o1); } \
                const float o = reduce8(o0 + o1); \
                op[(st) * 64] = (hf)o; } while (0)
#define GL_PIN(n, cur) asm volatile("s_waitcnt lgkmcnt(" #n ")" : "+v"(LQ[cur]), "+v"(LK[cur]), "+v"(LE[cur]), "+v"(LV[cur]))
            GL_LOAD(0, 0, 64, 128); DSR16(LV[0], vbase, 0);
            GL_LOAD(1, 320, 384, 448); DSR16(LV[1], vbase, 320); GL_PIN(4, 0); GL_COMPUTE(0, 0);
            GL_LOAD(0, 640, 704, 768); DSR16(LV[0], vbase, 640); GL_PIN(4, 1); GL_COMPUTE(1, 1);
            GL_LOAD(1, 960, 1024, 1088); DSR16(LV[1], vbase, 960); GL_PIN(4, 0); GL_COMPUTE(0, 2);
            GL_LOAD(0, 1280, 1344, 1408); DSR16(LV[0], vbase, 1280); GL_PIN(4, 1); GL_COMPUTE(1, 3);
            GL_LOAD(1, 1600, 1664, 1728); DSR16(LV[1], vbase, 1600); GL_PIN(4, 0); GL_COMPUTE(0, 4);
            GL_LOAD(0, 1920, 1984, 2048); DSR16(LV[0], vbase, 1920); GL_PIN(4, 1); GL_COMPUTE(1, 5);
            GL_LOAD(1, 2240, 2304, 2368); DSR16(LV[1], vbase, 2240); GL_PIN(4, 0); GL_COMPUTE(0, 6);
            GL_LOAD(0, 2560, 2624, 2688); DSR16(LV[0], vbase, 2560); GL_PIN(4, 1); GL_COMPUTE(1, 7);
            GL_LOAD(1, 2880, 2944, 3008); DSR16(LV[1], vbase, 2880); GL_PIN(4, 0); GL_COMPUTE(0, 8);
            GL_LOAD(0, 3200, 3264, 3328); DSR16(LV[0], vbase, 3200); GL_PIN(4, 1); GL_COMPUTE(1, 9);
            GL_LOAD(1, 3520, 3584, 3648); DSR16(LV[1], vbase, 3520); GL_PIN(4, 0); GL_COMPUTE(0, 10);
            GL_LOAD(0, 3840, 3904, 3968); DSR16(LV[0], vbase, 3840); GL_PIN(4, 1); GL_COMPUTE(1, 11);
            GL_LOAD(1, 4160, 4224, 4288); DSR16(LV[1], vbase, 4160); GL_PIN(4, 0); GL_COMPUTE(0, 12);
            GL_LOAD(0, 4480, 4544, 4608); DSR16(LV[0], vbase, 4480); GL_PIN(4, 1); GL_COMPUTE(1, 13);
            GL_LOAD(1, 4800, 4864, 4928); DSR16(LV[1], vbase, 4800); GL_PIN(4, 0); GL_COMPUTE(0, 14);
            GL_LOAD(0, 5120, 5184, 5248); DSR16(LV[0], vbase, 5120); GL_PIN(4, 1); GL_COMPUTE(1, 15);
            GL_LOAD(1, 5440, 5504, 5568); DSR16(LV[1], vbase, 5440); GL_PIN(4, 0); GL_COMPUTE(0, 16);
            GL_LOAD(0, 5760, 5824, 5888); DSR16(LV[0], vbase, 5760); GL_PIN(4, 1); GL_COMPUTE(1, 17);
            GL_LOAD(1, 6080, 6144, 6208); DSR16(LV[1], vbase, 6080); GL_PIN(4, 0); GL_COMPUTE(0, 18);
            GL_LOAD(0, 6400, 6464, 6528); DSR16(LV[0], vbase, 6400); GL_PIN(4, 1); GL_COMPUTE(1, 19);
            GL_LOAD(1, 6720, 6784, 6848); DSR16(LV[1], vbase, 6720); GL_PIN(4, 0); GL_COMPUTE(0, 20);
            GL_LOAD(0, 7040, 7104, 7168); DSR16(LV[0], vbase, 7040); GL_PIN(4, 1); GL_COMPUTE(1, 21);
            GL_LOAD(1, 7360, 7424, 7488); DSR16(LV[1], vbase, 7360); GL_PIN(4, 0); GL_COMPUTE(0, 22);
            GL_LOAD(0, 7680, 7744, 7808); DSR16(LV[0], vbase, 7680); GL_PIN(4, 1); GL_COMPUTE(1, 23);
            GL_LOAD(1, 8000, 8064, 8128); DSR16(LV[1], vbase, 8000); GL_PIN(4, 0); GL_COMPUTE(0, 24);
            GL_LOAD(0, 8320, 8384, 8448); DSR16(LV[0], vbase, 8320); GL_PIN(4, 1); GL_COMPUTE(1, 25);
            GL_LOAD(1, 8640, 8704, 8768); DSR16(LV[1], vbase, 8640); GL_PIN(4, 0); GL_COMPUTE(0, 26);
            GL_LOAD(0, 8960, 9024, 9088); DSR16(LV[0], vbase, 8960); GL_PIN(4, 1); GL_COMPUTE(1, 27);
            GL_LOAD(1, 9280, 9344, 9408); DSR16(LV[1], vbase, 9280); GL_PIN(4, 0); GL_COMPUTE(0, 28);
            GL_LOAD(0, 9600, 9664, 9728); DSR16(LV[0], vbase, 9600); GL_PIN(4, 1); GL_COMPUTE(1, 29);
            GL_LOAD(1, 9920, 9984, 10048); DSR16(LV[1], vbase, 9920); GL_PIN(4, 0); GL_COMPUTE(0, 30);
            GL_PIN(0, 1); GL_COMPUTE(1, 31);
#undef GL_LOAD
#undef GL_COMPUTE
#undef GL_PIN
        }
        LDS_BAR();
    }
    if (t4 >= 0 && t4 < 128) { const int cc = NCHUNK - 1; const int st = t4 >> 2, pc = t4 & 3; const int row = chain_row(b, dir, cc * 32 + st);
        *(u32x4*)(OG + (size_t)row * 256 + h * 64 + half_ * 32 + pc * 8) = *(const LAS u32x4*)(obuf + (cc & 1) * 4096 + st * 128 + half_ * 64 + pc * 16); }
#undef GL_ISSUE
#undef GL_COMMIT
}
__device__ __forceinline__ bf16x8 mk_op(unsigned a, unsigned b, unsigned c, unsigned d) { const u32x4 t = {a, b, c, d}; return __builtin_bit_cast(bf16x8, t); }
__device__ __forceinline__ void ck_p1_step(const LAS unsigned char* in, LAS unsigned char* KKI, LAS unsigned char* BTI, LAS unsigned char* KDI, LAS unsigned char* RTI, LAS unsigned char* AUP, LAS unsigned char* VTI,
                                           int k, int t, float gprev, float gt, float gC) {
    const float inv = __builtin_amdgcn_rcpf(gt);
    const LAS unsigned char* sp = in + t * 768 + k * 2;
    const float r = (float)*(const LAS hf*)sp, kk = (float)*(const LAS hf*)(sp + 128), nb = (float)*(const LAS hf*)(sp + 384), kd = (float)*(const LAS hf*)(sp + 512), vv = (float)*(const LAS hf*)(sp + 640);
    const float nbi = nb * inv, kdi = kd * inv;
    const unsigned pa = cvtpk(kk * gprev, nbi), pb = cvtpk(kdi, r * gt), pc = cvtpk(nbi * gC, kdi * gC), pd = cvtpk(vv, vv);
    *(LAS unsigned short*)(KKI + t * 144 + k * 2) = (unsigned short)(pa & 0xffffu); *(LAS unsigned short*)(BTI + t * 144 + k * 2) = (unsigned short)(pa >> 16);
    *(LAS unsigned short*)(KDI + t * 144 + k * 2) = (unsigned short)(pb & 0xffffu); *(LAS unsigned short*)(RTI + t * 144 + k * 2) = (unsigned short)(pb >> 16);
    const int slot = (t >> 2) * 8 + (t & 3);
    *(LAS unsigned short*)(AUP + k * 80 + slot * 2) = (unsigned short)(pc & 0xffffu); *(LAS unsigned short*)(AUP + k * 80 + (slot + 4) * 2) = (unsigned short)(pc >> 16);
    *(LAS unsigned short*)(VTI + k * 32 + t * 2) = (unsigned short)(pd & 0xffffu);
}
__device__ __forceinline__ void rwkv_chunk_item(unsigned char* ldsg, kparams_t p, int chain, int tid, int expflag) {
    (void)expflag;
    LAS unsigned char* lds = (LAS unsigned char*)ldsg;
    constexpr int INB = 16 * 768, NPIECE = 16 * 48, NCH = (SEQ + CTXL) / 16, IMGB = 16640;
    LAS unsigned char* IMG0 = lds + 3 * INB;
    LAS unsigned char* NI = IMG0 + 2 * IMGB;
    LAS unsigned char* MMI = NI + 4096;
    LAS unsigned char* AOI = MMI + 512;
    LAS unsigned char* OBI = AOI + 1024;
    const int b = chain >> 3, h = (chain >> 1) & 3, dir = chain & 1;
    const int lane = tid & 63, wave = __builtin_amdgcn_readfirstlane(tid >> 6), fr = lane & 15, quad = lane >> 4;
    const hf* PREP = (const hf*)(p->ws + WS_PREP); hf* OR = (hf*)(p->ws + WS_OR) + (size_t)dir * MT * 256;
    const int so0 = h * 64, so1 = 256 + h * 64, so2 = 768 + dir * 768 + h * 64, so5 = 512 + h * 64;
    u32x4 pre[2];
    const int pp0_ = tid, pp1_ = tid < 256 ? tid + 512 : tid;
    const int st0_ = pp0_ / 48, q0_ = pp0_ % 48, st1_ = pp1_ / 48, q1_ = pp1_ % 48;
    const int ar0_ = q0_ >> 3, ar1_ = q1_ >> 3;
    const int sof0_ = (ar0_ == 0 ? so0 : ar0_ == 1 ? so1 : ar0_ == 2 ? so2 : ar0_ == 3 ? so2 + 256 : ar0_ == 4 ? so2 + 512 : so5) + (q0_ & 7) * 8;
    const int sof1_ = (ar1_ == 0 ? so0 : ar1_ == 1 ? so1 : ar1_ == 2 ? so2 : ar1_ == 3 ? so2 + 256 : ar1_ == 4 ? so2 + 512 : so5) + (q1_ & 7) * 8;
    const hf* pl0_ = PREP + (size_t)(b * 4096 + (dir ? 4095 - st0_ : st0_)) * PRC + sof0_;
    const hf* pl1_ = PREP + (size_t)(b * 4096 + (dir ? 4095 - st1_ : st1_)) * PRC + sof1_;
    const hf* cur0_ = PREP + (size_t)(ML + b * 256 + (dir ? 255 - st0_ : st0_)) * PRC + sof0_;
    const hf* cur1_ = PREP + (size_t)(ML + b * 256 + (dir ? 255 - st1_ : st1_)) * PRC + sof1_;
    const ptrdiff_t stepH_ = (ptrdiff_t)(dir ? -16 : 16) * PRC;
    const int lo0_ = st0_ * 768 + q0_ * 16, lo1_ = st1_ * 768 + q1_ * 16;
    int icc_ = 0, cbuf_ = 0, wcc_ = 0;
    const int wst_ = (tid & 127) >> 3, wpc_ = tid & 7;
    hf* wcur_ = OR + (size_t)(ML + b * 256 + (dir ? 255 - wst_ : wst_)) * 256 + h * 64 + wpc_ * 8;
    hf* wlat_ = OR + (size_t)(b * 4096 + (dir ? 4095 - wst_ : wst_)) * 256 + h * 64 + wpc_ * 8;
    const ptrdiff_t wstep_ = (ptrdiff_t)(dir ? -16 : 16) * 256;
#define CK_ISSUE(cc) do { if (icc_ == 16) { cur0_ = pl0_; cur1_ = pl1_; } pre[0] = *(const u32x4*)cur0_; pre[1] = *(const u32x4*)cur1_; cur0_ += stepH_; cur1_ += stepH_; ++icc_; } while (0)
#define CK_COMMIT(cc) do { *(LAS u32x4*)(lds + cbuf_ + lo0_) = pre[0]; if (tid < 256) *(LAS u32x4*)(lds + cbuf_ + lo1_) = pre[1]; cbuf_ = (cbuf_ == 2 * INB) ? 0 : cbuf_ + INB; } while (0)
#define CK_WRITEOUT(cc) do { if (wcc_ == 16) wcur_ = wlat_; if (tid < 128) *(u32x4*)wcur_ = *(const LAS u32x4*)(OBI + ((cc) & 1) * 2048 + wst_ * 128 + wpc_ * 16); wcur_ += wstep_; ++wcc_; } while (0)
    float gq0 = 1.f, gq1 = 1.f, gq2 = 1.f, gq3 = 1.f, gq4 = 1.f, gqC = 1.f;
#define CK_P1A(cc) do { const LAS unsigned char* in_ = lds + ((cc) % 3) * INB; LAS unsigned char* im_ = IMG0 + ((cc) & 1) * IMGB; const int wv_ = wave - 4, tb_ = wv_ * 4; \
        float w_[16]; _Pragma("unroll") for (int i_ = 0; i_ < 16; ++i_) w_[i_] = (float)*(const LAS hf*)(in_ + i_ * 768 + 256 + lane * 2); \
        const float G0_ = (w_[0] * w_[1]) * (w_[2] * w_[3]), G1_ = (w_[4] * w_[5]) * (w_[6] * w_[7]), G2_ = (w_[8] * w_[9]) * (w_[10] * w_[11]), G3_ = (w_[12] * w_[13]) * (w_[14] * w_[15]); \
        const float pfx_ = (wv_ > 0 ? G0_ : 1.f) * ((wv_ > 1 ? G1_ : 1.f) * (wv_ > 2 ? G2_ : 1.f)); \
        const float sfx_ = (wv_ < 3 ? G3_ : 1.f) * ((wv_ < 2 ? G2_ : 1.f) * (wv_ < 1 ? G1_ : 1.f)); \
        const LAS unsigned char* ow_ = in_ + tb_ * 768 + 256 + lane * 2; \
        const float o0_ = (float)*(const LAS hf*)ow_, o1_ = (float)*(const LAS hf*)(ow_ + 768), o2_ = (float)*(const LAS hf*)(ow_ + 1536), o3_ = (float)*(const LAS hf*)(ow_ + 2304); \
        gq0 = pfx_; gq1 = gq0 * o0_; gq2 = gq1 * o1_; gq3 = gq2 * o2_; gq4 = gq3 * o3_; gqC = gq4 * sfx_; \
        if (wave == 4) *(LAS float*)(im_ + 14336 + lane * 4) = gqC; \
        ck_p1_step(in_, im_, im_ + 2304, im_ + 4608, im_ + 6912, im_ + 9216, im_ + 14592, lane, tb_, gq0, gq1, gqC); \
        ck_p1_step(in_, im_, im_ + 2304, im_ + 4608, im_ + 6912, im_ + 9216, im_ + 14592, lane, tb_ + 1, gq1, gq2, gqC);  } while (0)
#define CK_P1B(cc) do { const LAS unsigned char* in_ = lds + ((cc) % 3) * INB; LAS unsigned char* im_ = IMG0 + ((cc) & 1) * IMGB; const int tb_ = (wave - 4) * 4; \
        ck_p1_step(in_, im_, im_ + 2304, im_ + 4608, im_ + 6912, im_ + 9216, im_ + 14592, lane, tb_ + 2, gq2, gq3, gqC); \
        ck_p1_step(in_, im_, im_ + 2304, im_ + 4608, im_ + 6912, im_ + 9216, im_ + 14592, lane, tb_ + 3, gq3, gq4, gqC); } while (0)
    f32x4 St[4];
#pragma unroll
    for (int i = 0; i < 4; ++i) St[i] = (f32x4){0.f, 0.f, 0.f, 0.f};
    CK_ISSUE(0); CK_COMMIT(0); CK_ISSUE(1); CK_COMMIT(1); CK_ISSUE(2);
    __syncthreads();
    if (wave >= 4) { CK_P1A(0); CK_P1B(0); }
    LDS_BAR();
#pragma unroll 1
    for (int c = 0; c < NCH; ++c) {
        LAS unsigned char* im = IMG0 + (c & 1) * IMGB;
        LAS unsigned char* KKI = im; LAS unsigned char* BTI = im + 2304; LAS unsigned char* KDI = im + 4608; LAS unsigned char* RTI = im + 6912; LAS unsigned char* AUP = im + 9216;
        LAS float* GC = (LAS float*)(im + 14336); LAS unsigned char* VTI = im + 14592;
        if (c + 2 < NCH) CK_COMMIT(c + 2);
        if (c + 3 < NCH) CK_ISSUE(c + 3);
        if (c > 0) CK_WRITEOUT(c - 1);
        if (wave >= 4) { if (c + 1 < NCH) CK_P1A(c + 1); }
        f32x4 accN = (f32x4){0.f, 0.f, 0.f, 0.f}, accNT = (f32x4){0.f, 0.f, 0.f, 0.f};
        if (wave < 4) {
            const LAS unsigned char* X = (wave < 2) ? KKI : RTI; const LAS unsigned char* Y = (wave & 1) ? KDI : BTI;
            f32x4 acc = (f32x4){0.f, 0.f, 0.f, 0.f};
#pragma unroll
            for (int ks = 0; ks < 2; ++ks) { const bf16x8 a = *(const LAS bf16x8*)(X + fr * 144 + (ks * 32 + quad * 8) * 2), bb = *(const LAS bf16x8*)(Y + fr * 144 + (ks * 32 + quad * 8) * 2);
                acc = __builtin_amdgcn_mfma_f32_16x16x32_bf16(a, bb, acc, 0, 0, 0);
                if (wave == 0) accNT = __builtin_amdgcn_mfma_f32_16x16x32_bf16(bb, a, accNT, 0, 0, 0); }
            accN = acc;
#pragma unroll
            for (int j = 0; j < 4; ++j) { const int t = quad * 4 + j, i = fr;
                if (wave == 0) { }
                else if (wave == 1) *(LAS unsigned short*)(MMI + (t * 16 + i) * 2) = (unsigned short)f2bf((i < t) ? acc[j] : 0.f);
                else { const int slot = (i >> 2) * 8 + (i & 3) + (wave == 3 ? 4 : 0); *(LAS unsigned short*)(AOI + (t * 32 + slot) * 2) = (unsigned short)f2bf((i <= t) ? acc[j] : 0.f); } }
        }
        if (wave == 0) {
            f32x4 nv, nT;
#pragma unroll
            for (int j = 0; j < 4; ++j) { nv[j] = (fr < quad * 4 + j) ? accN[j] : 0.f;
                                          nT[j] = (quad * 4 + j < fr) ? accNT[j] : 0.f; }
#pragma unroll
            for (int lv = 0; lv < 4; ++lv) {
                const unsigned n01 = cvtpk(nv[0], nv[1]), n23 = cvtpk(nv[2], nv[3]), t01 = cvtpk(nT[0], nT[1]), t23 = cvtpk(nT[2], nT[3]);
                const u32x2 rowv = {t01, t23};
                *(LAS u32x2*)(NI + lv * 1024 + (fr * 16 + quad * 4) * 2) = rowv;
                if (lv < 3) {
                    const f32x4 zf = {0.f, 0.f, 0.f, 0.f};
                    const bf16x8 opN = mk_op(n01, n23, 0u, 0u), opT = mk_op(t01, t23, 0u, 0u);
                    nv = __builtin_amdgcn_mfma_f32_16x16x32_bf16(opT, opN, zf, 0, 0, 0);
                    nT = __builtin_amdgcn_mfma_f32_16x16x32_bf16(opN, opT, zf, 0, 0, 0);
                }
            }
        }
        LDS_BAR();
        if (wave >= 4) { if (c + 1 < NCH) CK_P1B(c + 1); }
        if (wave < 4) {
            const int vrow = wave * 16 + fr;
            bf16x8 Sb[2], KKa[2], RTa[2];
#pragma unroll
            for (int p2 = 0; p2 < 2; ++p2) {
                Sb[p2] = mk_op(cvtpk(St[2 * p2][0], St[2 * p2][1]), cvtpk(St[2 * p2][2], St[2 * p2][3]), cvtpk(St[2 * p2 + 1][0], St[2 * p2 + 1][1]), cvtpk(St[2 * p2 + 1][2], St[2 * p2 + 1][3]));
                const u32x2 a0 = *(const LAS u32x2*)(KKI + fr * 144 + ((2 * p2) * 16 + quad * 4) * 2), a1 = *(const LAS u32x2*)(KKI + fr * 144 + ((2 * p2 + 1) * 16 + quad * 4) * 2);
                KKa[p2] = mk_op(a0.x, a0.y, a1.x, a1.y);
                const u32x2 r0 = *(const LAS u32x2*)(RTI + fr * 144 + ((2 * p2) * 16 + quad * 4) * 2), r1 = *(const LAS u32x2*)(RTI + fr * 144 + ((2 * p2 + 1) * 16 + quad * 4) * 2);
                RTa[p2] = mk_op(r0.x, r0.y, r1.x, r1.y);
            }
            const f32x4 zf = {0.f, 0.f, 0.f, 0.f};
            f32x4 rhs = __builtin_amdgcn_mfma_f32_16x16x32_bf16(KKa[0], Sb[0], zf, 0, 0, 0); rhs = __builtin_amdgcn_mfma_f32_16x16x32_bf16(KKa[1], Sb[1], rhs, 0, 0, 0);
            const u32x2 vt = *(const LAS u32x2*)(VTI + vrow * 32 + quad * 8), mm = *(const LAS u32x2*)(MMI + fr * 32 + quad * 8);
            rhs = __builtin_amdgcn_mfma_f32_16x16x32_bf16(mk_op(mm.x, mm.y, 0u, 0u), mk_op(vt.x, vt.y, 0u, 0u), rhs, 0, 0, 0);
            f32x4 ut = rhs;
#pragma unroll
            for (int lv = 3; lv >= 0; --lv) { const u32x2 na = *(const LAS u32x2*)(NI + lv * 1024 + (fr * 16 + quad * 4) * 2);
                ut = __builtin_amdgcn_mfma_f32_16x16x32_bf16(mk_op(na.x, na.y, 0u, 0u), mk_op(cvtpk(ut[0], ut[1]), cvtpk(ut[2], ut[3]), 0u, 0u), ut, 0, 0, 0); }
            const bf16x8 UVb = mk_op(cvtpk(ut[0], ut[1]), cvtpk(ut[2], ut[3]), vt.x, vt.y);
            f32x4 ot = __builtin_amdgcn_mfma_f32_16x16x32_bf16(RTa[0], Sb[0], zf, 0, 0, 0); ot = __builtin_amdgcn_mfma_f32_16x16x32_bf16(RTa[1], Sb[1], ot, 0, 0, 0);
            ot = __builtin_amdgcn_mfma_f32_16x16x32_bf16(*(const LAS bf16x8*)(AOI + fr * 64 + quad * 16), UVb, ot, 0, 0, 0);
#pragma unroll
            for (int j = 0; j < 4; ++j) *(LAS hf*)(OBI + (c & 1) * 2048 + ((quad * 4 + j) * 64 + vrow) * 2) = (hf)ot[j];
#pragma unroll
            for (int kt = 0; kt < 4; ++kt) { const f32x4 gc = *(const LAS f32x4*)(GC + kt * 16 + quad * 4);
                St[kt] = __builtin_amdgcn_mfma_f32_16x16x32_bf16(*(const LAS bf16x8*)(AUP + (kt * 16 + fr) * 80 + quad * 16), UVb, St[kt] * gc, 0, 0, 0); }
        }
        LDS_BAR();
    }
    CK_WRITEOUT(NCH - 1);
#undef CK_ISSUE
#undef CK_COMMIT
#undef CK_WRITEOUT
#undef CK_P1A
#undef CK_P1B
}
__device__ __forceinline__ void gla_chunk_item(unsigned char* ldsg, kparams_t p, int chain, int tid) {
    LAS unsigned char* lds = (LAS unsigned char*)ldsg;
    constexpr int INB = 16 * 320, NCH = (SEQ + CTXL) / 16, IMGB = 6400;
    LAS unsigned char* IMG0 = lds + 3 * INB;
    LAS unsigned char* QKI = IMG0 + 2 * IMGB;
    LAS unsigned char* OBI = QKI + 512;
    const int b = chain >> 3, h = (chain >> 1) & 3, dir = chain & 1;
    const int lane = tid & 63, wave = __builtin_amdgcn_readfirstlane(tid >> 6), fr = lane & 15, quad = lane >> 4;
    const hf* PG = (const hf*)(p->ws + WS_PG); const bf16_t* P1 = (const bf16_t*)(p->ws + WS_P1); hf* OG = (hf*)(p->ws + WS_OG) + (size_t)dir * MT * 256;
    const int pp_ = tid < 320 ? tid : 0, st_ = pp_ / 20, q_ = pp_ % 20;
    const size_t crow_ = (size_t)(ML + b * 256 + (dir ? 255 - st_ : st_)), lrow_ = (size_t)(b * 4096 + (dir ? 4095 - st_ : st_));
    const int ar_ = q_ >> 2, sog_ = (ar_ == 0 ? h * 32 : ar_ == 1 ? 128 + h * 32 : 256 + dir * 128 + h * 32) + (q_ & 3) * 8;
    const unsigned char* cur_ = q_ < 12 ? (const unsigned char*)(PG + crow_ * PGC + sog_) : (const unsigned char*)(P1 + crow_ * P1C + 256 + h * 64 + (q_ - 12) * 8);
    const unsigned char* lat_ = q_ < 12 ? (const unsigned char*)(PG + lrow_ * PGC + sog_) : (const unsigned char*)(P1 + lrow_ * P1C + 256 + h * 64 + (q_ - 12) * 8);
    const ptrdiff_t stepB_ = (ptrdiff_t)(dir ? -16 : 16) * (q_ < 12 ? PGC * 2 : P1C * 2);
    const int lo_ = st_ * 320 + q_ * 16;
    int icc_ = 0, cbuf_ = 0, wcc_ = 0;
    const int wst_ = (tid & 127) >> 3, wpc_ = tid & 7;
    hf* wcur_ = OG + (size_t)(ML + b * 256 + (dir ? 255 - wst_ : wst_)) * 256 + h * 64 + wpc_ * 8;
    hf* wlat_ = OG + (size_t)(b * 4096 + (dir ? 4095 - wst_ : wst_)) * 256 + h * 64 + wpc_ * 8;
    const ptrdiff_t wstep_ = (ptrdiff_t)(dir ? -16 : 16) * 256;
    u32x4 pre;
#define GK_ISSUE() do { if (icc_ == 16) cur_ = lat_; pre = *(const u32x4*)cur_; cur_ += stepB_; ++icc_; } while (0)
#define GK_COMMIT() do { if (tid < 320) *(LAS u32x4*)(lds + cbuf_ + lo_) = pre; cbuf_ = (cbuf_ == 2 * INB) ? 0 : cbuf_ + INB; } while (0)
#define GK_WRITEOUT(cc) do { if (wcc_ == 16) wcur_ = wlat_; if (tid < 128) *(u32x4*)wcur_ = *(const LAS u32x4*)(OBI + ((cc) & 1) * 2048 + wst_ * 128 + wpc_ * 16); wcur_ += wstep_; ++wcc_; } while (0)
#define GK_P1(cc) do { const LAS unsigned char* in_ = lds + ((cc) % 3) * INB; LAS unsigned char* im_ = IMG0 + ((cc) & 1) * IMGB; \
        const int k_ = lane & 31, go_ = (wave - 4) * 2 + (lane >> 5), t0_ = go_ * 2; \
        float e_[16]; _Pragma("unroll") for (int i_ = 0; i_ < 16; ++i_) e_[i_] = (float)*(const LAS hf*)(in_ + i_ * 320 + 128 + k_ * 2); \
        float pfx_ = 1.f, sfx_ = 1.f; _Pragma("unroll") for (int g_ = 0; g_ < 8; ++g_) { const float H_ = e_[2 * g_] * e_[2 * g_ + 1]; pfx_ *= (g_ < go_) ? H_ : 1.f; sfx_ *= (g_ > go_) ? H_ : 1.f; } \
        const float ea_ = (float)*(const LAS hf*)(in_ + t0_ * 320 + 128 + k_ * 2), eb_ = (float)*(const LAS hf*)(in_ + (t0_ + 1) * 320 + 128 + k_ * 2); \
        const float ga_ = pfx_ * ea_, gb_ = ga_ * eb_, gC_ = gb_ * sfx_; \
        if (go_ == 0) *(LAS float*)(im_ + 3584 + k_ * 4) = gC_; \
        _Pragma("unroll") for (int e2_ = 0; e2_ < 2; ++e2_) { const int t_ = t0_ + e2_; const float gt_ = e2_ == 0 ? ga_ : gb_; const float inv_ = __builtin_amdgcn_rcpf(gt_); \
            const float qv_ = (float)*(const LAS hf*)(in_ + t_ * 320 + k_ * 2), kv_ = (float)*(const LAS hf*)(in_ + t_ * 320 + 64 + k_ * 2); \
            const unsigned pa_ = cvtpk(qv_ * gt_, kv_ * inv_), pb_ = cvtpk(kv_ * inv_ * gC_, 0.f); \
            *(LAS unsigned short*)(im_ + t_ * 80 + k_ * 2) = (unsigned short)(pa_ & 0xffffu); *(LAS unsigned short*)(im_ + 1280 + t_ * 80 + k_ * 2) = (unsigned short)(pa_ >> 16); \
            *(LAS unsigned short*)(im_ + 2560 + k_ * 32 + t_ * 2) = (unsigned short)(pb_ & 0xffffu); \
              \
            *(LAS unsigned short*)(im_ + 3712 + k_ * 32 + t_ * 2) = *(const LAS unsigned short*)(in_ + t_ * 320 + 192 + k_ * 2); \
            *(LAS unsigned short*)(im_ + 3712 + (k_ + 32) * 32 + t_ * 2) = *(const LAS unsigned short*)(in_ + t_ * 320 + 192 + (k_ + 32) * 2); } } while (0)
    f32x4 St[2];
    St[0] = (f32x4){0.f, 0.f, 0.f, 0.f}; St[1] = St[0];
    GK_ISSUE(); GK_COMMIT(); GK_ISSUE(); GK_COMMIT(); GK_ISSUE();
    __syncthreads();
    if (wave >= 4) GK_P1(0);
    LDS_BAR();
#pragma unroll 1
    for (int c = 0; c < NCH; ++c) {
        LAS unsigned char* im = IMG0 + (c & 1) * IMGB;
        const LAS unsigned char* QI = im; const LAS unsigned char* KI = im + 1280; const LAS unsigned char* AUPG = im + 2560; const LAS float* GC = (const LAS float*)(im + 3584); const LAS unsigned char* VTI = im + 3712;
        if (c + 2 < NCH) GK_COMMIT();
        if (c + 3 < NCH) GK_ISSUE();
        if (c > 0) GK_WRITEOUT(c - 1);
        if (wave >= 4) { if (c + 1 < NCH) GK_P1(c + 1); }
        if (wave == 0) {
            const bf16x8 a = *(const LAS bf16x8*)(QI + fr * 80 + quad * 16), bb = *(const LAS bf16x8*)(KI + fr * 80 + quad * 16);
            const f32x4 zf = {0.f, 0.f, 0.f, 0.f};
            const f32x4 acc = __builtin_amdgcn_mfma_f32_16x16x32_bf16(a, bb, zf, 0, 0, 0);
            const unsigned p01 = cvtpk((fr <= quad * 4 + 0) ? acc[0] : 0.f, (fr <= quad * 4 + 1) ? acc[1] : 0.f), p23 = cvtpk((fr <= quad * 4 + 2) ? acc[2] : 0.f, (fr <= quad * 4 + 3) ? acc[3] : 0.f);
            *(LAS unsigned short*)(QKI + ((quad * 4 + 0) * 16 + fr) * 2) = (unsigned short)(p01 & 0xffffu); *(LAS unsigned short*)(QKI + ((quad * 4 + 1) * 16 + fr) * 2) = (unsigned short)(p01 >> 16);
            *(LAS unsigned short*)(QKI + ((quad * 4 + 2) * 16 + fr) * 2) = (unsigned short)(p23 & 0xffffu); *(LAS unsigned short*)(QKI + ((quad * 4 + 3) * 16 + fr) * 2) = (unsigned short)(p23 >> 16);
        }
        LDS_BAR();
        if (wave < 4) {
            const int vrow = wave * 16 + fr;
            const bf16x8 Sb = mk_op(cvtpk(St[0][0], St[0][1]), cvtpk(St[0][2], St[0][3]), cvtpk(St[1][0], St[1][1]), cvtpk(St[1][2], St[1][3]));
            const u32x2 q0 = *(const LAS u32x2*)(QI + fr * 80 + (quad * 4) * 2), q1 = *(const LAS u32x2*)(QI + fr * 80 + (16 + quad * 4) * 2);
            const u32x2 vt = *(const LAS u32x2*)(VTI + vrow * 32 + quad * 8), qk = *(const LAS u32x2*)(QKI + fr * 32 + quad * 8);
            const bf16x8 Vb = mk_op(vt.x, vt.y, 0u, 0u);
            const f32x4 zf = {0.f, 0.f, 0.f, 0.f};
            f32x4 ot = __builtin_amdgcn_mfma_f32_16x16x32_bf16(mk_op(q0.x, q0.y, q1.x, q1.y), Sb, zf, 0, 0, 0);
            ot = __builtin_amdgcn_mfma_f32_16x16x32_bf16(mk_op(qk.x, qk.y, 0u, 0u), Vb, ot, 0, 0, 0);
#pragma unroll
            for (int j = 0; j < 4; ++j) *(LAS hf*)(OBI + (c & 1) * 2048 + ((quad * 4 + j) * 64 + vrow) * 2) = (hf)ot[j];
#pragma unroll
            for (int kt = 0; kt < 2; ++kt) { const f32x4 gc = *(const LAS f32x4*)(GC + kt * 16 + quad * 4); const u32x2 au = *(const LAS u32x2*)(AUPG + (kt * 16 + fr) * 32 + quad * 8);
                St[kt] = __builtin_amdgcn_mfma_f32_16x16x32_bf16(mk_op(au.x, au.y, 0u, 0u), Vb, St[kt] * gc, 0, 0, 0); }
        }
        LDS_BAR();
    }
    GK_WRITEOUT(NCH - 1);
#undef GK_ISSUE
#undef GK_COMMIT
#undef GK_WRITEOUT
#undef GK_P1
}
__device__ __forceinline__ void swa_item(unsigned char* ldsg, kparams_t p, int l, int item, int tid) {
    LAS unsigned char* lds = (LAS unsigned char*)ldsg;
    const int lane = tid & 63, wave = tid >> 6, fr = lane & 15, quad = lane >> 4;
    const bf16_t* P1 = (const bf16_t*)(p->ws + WS_P1); bf16_t* MIX = (bf16_t*)(p->ws + WS_XN);
    const bool lat = item < 512;
    int b, n, kvh;
    if (lat) { b = item >> 6; n = (item >> 1) & 31; kvh = item & 1; } else { const int r = item - 512; b = r >> 2; n = (r >> 1) & 1; kvh = r & 1; }
    const int qrow = (lat ? b * 4096 : ML + b * 256) + n * 128 + wave * 16 + fr;
    const int qpos = n * 128 + wave * 16 + fr;
#pragma unroll 1
    for (int hp = 0; hp < 2; ++hp) {
    const int hbase = kvh * 4 + hp * 2;
    bf16x8 qf[2][2];
#pragma unroll
    for (int g = 0; g < 2; ++g)
#pragma unroll
        for (int ks = 0; ks < 2; ++ks) qf[g][ks] = *(const bf16x8*)(P1 + (size_t)qrow * P1C + 800 + (hbase + g) * 64 + ks * 32 + quad * 8);
    f32x4 oacc[2][4]; float mrun[2], lrun[2];
#pragma unroll
    for (int g = 0; g < 2; ++g) { mrun[g] = -1e30f; lrun[g] = 0.f;
#pragma unroll
        for (int dt = 0; dt < 4; ++dt) oacc[g][dt] = (f32x4){0.f, 0.f, 0.f, 0.f}; }
    const int jlo = lat ? (n == 0 ? 2 : 0) : 0, jhi = lat ? (n == 31 ? 4 : 6) : 0, T = 4 + (jhi - jlo);
    const int key_ = tid >> 3, ch_ = tid & 7;
#define SWA_SRC(t) (P1 + (size_t)(((t) < 4 ? ML + b * 256 + (t) * 64 : b * 4096 + (n - 1) * 128 + (jlo + (t) - 4) * 64) + key_) * P1C + 1312 + kvh * 64 + ch_ * 8)
#define SWA_STORE(bf) do { LAS unsigned char* Ks_ = lds + (bf) * 18432; LAS unsigned char* Vt_ = Ks_ + 9216; *(LAS u32x4*)(Ks_ + key_ * 144 + ch_ * 16) = pk_; \
        _Pragma("unroll") for (int e = 0; e < 4; ++e) { *(LAS unsigned short*)(Vt_ + (ch_ * 8 + 2 * e) * 144 + key_ * 2) = (unsigned short)(pv_[e] & 0xffffu); *(LAS unsigned short*)(Vt_ + (ch_ * 8 + 2 * e + 1) * 144 + key_ * 2) = (unsigned short)(pv_[e] >> 16); } } while (0)
    u32x4 pk_, pv_;
    { const bf16_t* src = SWA_SRC(0); pk_ = *(const u32x4*)src; pv_ = *(const u32x4*)(src + 128); }
    SWA_STORE(0);
    __syncthreads();
    for (int tile = 0; tile < T; ++tile) {
        if (tile + 1 < T) { const bf16_t* src = SWA_SRC(tile + 1); pk_ = *(const u32x4*)src; pv_ = *(const u32x4*)(src + 128); }
        const bool local = tile >= 4; const int kpos0 = local ? (n - 1) * 128 + (jlo + tile - 4) * 64 : 0;
        const LAS unsigned char* Ks = lds + (tile & 1) * 18432; const LAS unsigned char* Vt = Ks + 9216;
#pragma unroll
        for (int g = 0; g < 2; ++g) {
            asm volatile("" ::: "memory");
            bf16x8 kf[4][2], vf[4][2];
#pragma unroll
        for (int st = 0; st < 4; ++st)
#pragma unroll
            for (int ks = 0; ks < 2; ++ks) kf[st][ks] = *(const LAS bf16x8*)(Ks + (st * 16 + fr) * 144 + ks * 64 + quad * 16);
#pragma unroll
        for (int dt = 0; dt < 4; ++dt)
#pragma unroll
            for (int kp = 0; kp < 2; ++kp) { const u32x2 lo = *(const LAS u32x2*)(Vt + (dt * 16 + fr) * 144 + ((2 * kp) * 16 + quad * 4) * 2), hi = *(const LAS u32x2*)(Vt + (dt * 16 + fr) * 144 + ((2 * kp + 1) * 16 + quad * 4) * 2);
                const u32x4 t = {lo.x, lo.y, hi.x, hi.y}; vf[dt][kp] = __builtin_bit_cast(bf16x8, t); }
            f32x4 s[4];
#pragma unroll
            for (int st = 0; st < 4; ++st) { f32x4 a = (f32x4){0.f, 0.f, 0.f, 0.f};
                a = __builtin_amdgcn_mfma_f32_16x16x32_bf16(kf[st][0], qf[g][0], a, 0, 0, 0); a = __builtin_amdgcn_mfma_f32_16x16x32_bf16(kf[st][1], qf[g][1], a, 0, 0, 0); s[st] = a * 0.125f; }
            if (local) {
#pragma unroll
                for (int st = 0; st < 4; ++st)
#pragma unroll
                    for (int j = 0; j < 4; ++j) { const int d = qpos - (kpos0 + st * 16 + quad * 4 + j); if (d > 128 || d < -128) s[st][j] = -1e30f; }
            }
            float mx = fmaxf(fmaxf(fmaxf(s[0][0], s[0][1]), fmaxf(s[0][2], s[0][3])), fmaxf(fmaxf(s[1][0], s[1][1]), fmaxf(s[1][2], s[1][3])));
            mx = fmaxf(mx, fmaxf(fmaxf(fmaxf(s[2][0], s[2][1]), fmaxf(s[2][2], s[2][3])), fmaxf(fmaxf(s[3][0], s[3][1]), fmaxf(s[3][2], s[3][3]))));
            mx = fmaxf(mx, __shfl_xor(mx, 16)); mx = fmaxf(mx, __shfl_xor(mx, 32));
            const float mn = fmaxf(mrun[g], mx), alpha = __expf(mrun[g] - mn); mrun[g] = mn;
            float ps = 0.f;
#pragma unroll
            for (int st = 0; st < 4; ++st)
#pragma unroll
                for (int j = 0; j < 4; ++j) { s[st][j] = __expf(s[st][j] - mn); ps += s[st][j]; }
            lrun[g] = lrun[g] * alpha + ps;
            bf16x8 pb[2];
#pragma unroll
            for (int kp = 0; kp < 2; ++kp) { const u32x4 t = {cvtpk(s[2 * kp][0], s[2 * kp][1]), cvtpk(s[2 * kp][2], s[2 * kp][3]), cvtpk(s[2 * kp + 1][0], s[2 * kp + 1][1]), cvtpk(s[2 * kp + 1][2], s[2 * kp + 1][3])}; pb[kp] = __builtin_bit_cast(bf16x8, t); }
#pragma unroll
            for (int dt = 0; dt < 4; ++dt) { f32x4 o = oacc[g][dt] * alpha;
                o = __builtin_amdgcn_mfma_f32_16x16x32_bf16(vf[dt][0], pb[0], o, 0, 0, 0); o = __builtin_amdgcn_mfma_f32_16x16x32_bf16(vf[dt][1], pb[1], o, 0, 0, 0); oacc[g][dt] = o; }
        }
        if (tile + 1 < T) SWA_STORE((tile + 1) & 1);
        __syncthreads();
    }
#undef SWA_SRC
#undef SWA_STORE
    const float* sink = p->in[13] + l * 8;
#pragma unroll
    for (int g = 0; g < 2; ++g) {
        float lsum = lrun[g]; lsum += __shfl_xor(lsum, 16); lsum += __shfl_xor(lsum, 32);
        lsum += __expf(sink[hbase + g] - mrun[g]);
        const float inv = 1.0f / lsum;
#pragma unroll
        for (int dt = 0; dt < 4; ++dt) { const f32x4 o = oacc[g][dt] * inv; u32x2 w; w.x = cvtpk(o[0], o[1]); w.y = cvtpk(o[2], o[3]);
            *(u32x2*)(MIX + (size_t)qrow * DM + 256 + (hbase + g) * 64 + dt * 16 + quad * 4) = w; }
    }
    }
}

__device__ __forceinline__ float group16_sum(float v) { v += __shfl_xor(v, 1); v += __shfl_xor(v, 2); v += __shfl_xor(v, 4); v += __shfl_xor(v, 8); return v; }
__device__ __forceinline__ void phase_finalize(kparams_t p, int l, int nrows, int gw, int ngw, int lane) {
    const hf* OR = (const hf*)(p->ws + WS_OR); const hf* OG = (const hf*)(p->ws + WS_OG); const hf* PREP = (const hf*)(p->ws + WS_PREP); const hf* GG = (const hf*)(p->ws + WS_GG);
    const float* BONUS = (const float*)(p->ws + WS_BONUS); const bf16_t* P1 = (const bf16_t*)(p->ws + WS_P1); bf16_t* MIX = (bf16_t*)(p->ws + WS_XN);
    const float* ln_g = p->in[23] + l * 256; const float* ln_b = p->in[24] + l * 256; const float* gng = p->in[12] + l * 64;
    const int c = lane * 4, h = lane >> 4;
    const f32x4 lg4 = *(const f32x4*)(ln_g + c), lb4 = *(const f32x4*)(ln_b + c), gn4 = *(const f32x4*)(gng + (c & 63));
    for (int row = gw; row < nrows; row += ngw) {
        {
            const h4 a = *(const h4*)(OR + (size_t)row * 256 + c), bq = *(const h4*)(OR + (size_t)MT * 256 + (size_t)row * 256 + c);
            float o[4]; float s = 0.f;
#pragma unroll
            for (int e = 0; e < 4; ++e) { o[e] = (float)a[e] + (float)bq[e]; s += o[e]; }
            const float mu = group16_sum(s) * (1.0f / 64.0f); float q = 0.f;
#pragma unroll
            for (int e = 0; e < 4; ++e) { o[e] -= mu; q += o[e] * o[e]; }
            const float rs = rsqrtf(group16_sum(q) * (1.0f / 64.0f) + 64e-5f);
            const float bon = BONUS[(size_t)row * 4 + h];
            const h4 v4 = *(const h4*)(PREP + (size_t)row * PRC + 512 + c), g4 = *(const h4*)(GG + (size_t)row * 256 + c);
            float y[4];
#pragma unroll
            for (int e = 0; e < 4; ++e) y[e] = (o[e] * rs * lg4[e] + lb4[e] + bon * (float)v4[e]) * (float)g4[e];
            u32x2 w; w.x = cvtpk(y[0], y[1]); w.y = cvtpk(y[2], y[3]);
            *(u32x2*)(MIX + (size_t)row * DM + 768 + c) = w;
        }
        {
            const h4 a = *(const h4*)(OG + (size_t)row * 256 + c), bq = *(const h4*)(OG + (size_t)MT * 256 + (size_t)row * 256 + c);
            float o[4]; float q = 0.f;
#pragma unroll
            for (int e = 0; e < 4; ++e) { o[e] = (float)a[e] + (float)bq[e]; q += o[e] * o[e]; }
            const float rs = rsqrtf(group16_sum(q) * (1.0f / 64.0f) + 1e-6f);
            const u32x2 gt = *(const u32x2*)(P1 + (size_t)row * P1C + 512 + c);
            const float gv[4] = {bflo(gt.x), bfhi(gt.x), bflo(gt.y), bfhi(gt.y)};
            float y[4];
#pragma unroll
            for (int e = 0; e < 4; ++e) y[e] = o[e] * rs * gn4[e] * gv[e] * sigmoidf_(gv[e]);
            u32x2 w; w.x = cvtpk(y[0], y[1]); w.y = cvtpk(y[2], y[3]);
            *(u32x2*)(MIX + (size_t)row * DM + c) = w;
        }
    }
}
__global__ void __launch_bounds__(NTHREADS, 2) hybrid_fwd(Params p_arg) {
    extern __shared__ __attribute__((aligned(16))) unsigned char lds[];
#ifndef EXP_REP
#define EXP_REP 1
#endif
#ifndef EXP_FLAG
#define EXP_FLAG(rep) 0
#endif
#ifndef MAXSTEP
#define MAXSTEP 1000
#endif
    constexpr int NSTEP = 1 + 9 * NLAYER + 1;
#ifdef PROBE
    unsigned long long tacc1 = 0, tacc2 = 0;
#endif
    { volatile LAS unsigned* st0 = (volatile LAS unsigned*)((LAS unsigned char*)lds + 147392); if (threadIdx.x < 2) st0[threadIdx.x] = 0u; __syncthreads();
      (void)xcd_barrier_post((unsigned*)(p_arg.ws + WS_CTL) + 1024, st0); }
    int rep = 0;
#pragma unroll 1
    for (int step = 0; step < NSTEP; ++step) {
#ifdef PROBE
        const unsigned long long t0_ = __builtin_amdgcn_s_memrealtime();
#endif
        kparams_t kp = (kparams_t)__builtin_amdgcn_kernarg_segment_ptr();
        asm volatile("" : "+s"(kp));
        kparams_t p = kp;
        int tid = threadIdx.x, bid = blockIdx.x, G = gridDim.x;
        asm volatile("" : "+v"(tid)); asm volatile("" : "+s"(bid)); asm volatile("" : "+s"(G));
        const int lane = tid & 63, wave = __builtin_amdgcn_readfirstlane(tid >> 6);
        const int gw = bid * NWAVES + wave, ngw = G * NWAVES;
        unsigned char* ws = p->ws;
        bf16_t* XN = (bf16_t*)(ws + WS_XN); float* XC = (float*)(ws + WS_XC); float* XL = p->out;
        if (step == 0) { phase_mod(lds, p, tid, bid, G); }
        else if (step == NSTEP - 1) { final_norm_rows(XL, p->in[28], gw, ngw, lane);
#ifdef PROBE
            cg::this_grid().sync();
            if (bid == 0) { const float v1 = (float)tacc1 * 0.01f; if (tid == 0) XL[0] = v1; }
            if (bid == PROBE_B2) { const float v2 = (float)tacc2 * 0.01f; for (int i = tid; i < (1 << 20); i += NTHREADS) XL[1024 + i] = v2; }
#endif
            break; }
        else {
            const int l = (step - 1) / 9, ph = (step - 1) % 9;

            const bool lastl = (l == NLAYER - 1);
            const int mrows = lastl ? ML : MT;
            const float* modl = (const float*)(ws + WS_MOD) + (size_t)l * 9 * 6144;
            const float* resL = l == 0 ? p->in[0] : XL; const float* resC = l == 0 ? p->in[2] : XC;
            if (ph == 0) {
                convert_weights(lds, p, l, gw, ngw, wave, lane);
                norm_mod_rows(resL, resC, p->in[6] + l * DM, modl, 0, 1024, XN, MT, gw, ngw, lane);
            } else if (ph == 1) {
                pg8::Gemm g{XN, (const bf16_t*)(ws + WS_WT + WT_IN), MT, INP, DM}; pg8::StaticOrder S; S.init(MT, INP, G, bid);
                pg8::EpiIn E{(bf16_t*)(ws + WS_P1), (bf16_t*)(ws + WS_RAW)};
                pg8::gemm_phase<pg8::EpiIn, pg8::StaticOrder, true, true>((PG8_LAS unsigned char*)lds, g, S, E, tid);
            } else if (ph == 5) {
                pg8::Gemm g{XN, (const bf16_t*)(ws + WS_WT + WT_OUT), mrows, DM, DM}; pg8::StaticOrder S; S.init(mrows, DM, G, bid);
                pg8::EpiRes E{resL, XL, resC, XC, modl + 2048};
                pg8::gemm_phase<pg8::EpiRes, pg8::StaticOrder, true, true>((PG8_LAS unsigned char*)lds, g, S, E, tid);
            } else if (ph == 7) {
                pg8::Gemm g{XN, (const bf16_t*)(ws + WS_WT + WT_GU), mrows, 2 * FF, DM}; pg8::StaticOrder S; S.init(mrows, 2 * FF, G, bid);
                pg8::EpiSwiglu E{(bf16_t*)(ws + WS_H)};
                pg8::gemm_phase<pg8::EpiSwiglu, pg8::StaticOrder, true, true>((PG8_LAS unsigned char*)lds, g, S, E, tid);
            } else if (ph == 8) {
                pg8::Gemm g{(const bf16_t*)(ws + WS_H), (const bf16_t*)(ws + WS_WT + WT_DN), mrows, DM, FF}; pg8::StaticOrder S; S.init(mrows, DM, G, bid);
                pg8::EpiRes E{XL, XL, XC, XC, modl + 5120};
                pg8::gemm_phase<pg8::EpiRes, pg8::StaticOrder, true, true>((PG8_LAS unsigned char*)lds, g, S, E, tid);
            } else if (ph == 2) {
                phase_prep(lds, p, l, tid, bid, G, rep == 0);
            } else if (ph == 3) {
#ifdef PROBE_SCAN
                const unsigned long long ts_ = __builtin_amdgcn_s_memrealtime();
#endif
#ifdef REP_NO_SCAN
                if (rep == 0)
#endif
#ifdef RWKV_SCAN
                for (int it = bid; it < 192; it += G) {
#ifdef REP_ONLY_RWKV
                    if (rep == EXP_REP && it >= 128) continue;
#endif
#ifdef REP_ONLY_GLA
                    if (rep == EXP_REP && it < 128) continue;
#endif
                    if (it < 128) rwkv_scan_item(lds, p, it, tid, EXP_FLAG(rep)); else gla_scan_item(lds, p, (it - 128) * 2, tid); __syncthreads(); }
#else
                for (int it = bid; it < 128; it += G) {
#ifdef REP_ONLY_RWKV
                    if (rep == EXP_REP && it >= 64) continue;
#endif
#ifdef REP_ONLY_GLA
                    if (rep == EXP_REP && it < 64) continue;
#endif
                    if (it < 64) rwkv_chunk_item(lds, p, it, tid, EXP_FLAG(rep)); else gla_chunk_item(lds, p, it - 64, tid); __syncthreads(); }
#endif
#ifdef PROBE_SCAN
                { const unsigned long long d_ = __builtin_amdgcn_s_memrealtime() - ts_; tacc1 += d_; tacc2 += d_; }
#endif
#ifdef REP_NO_SWA
                const int nswa = rep == EXP_REP ? 0 : (lastl ? 512 : 544);
#else
                const int nswa = lastl ? 512 : 544;
#endif
                unsigned* ctl = (unsigned*)(ws + WS_CTL);
                LAS int* qslot = (LAS int*)((LAS unsigned char*)lds + 147328);
                for (;;) {
                    __syncthreads();
                    if (tid == 0) *qslot = (int)atomicAdd(ctl + 64 * l + 32 * rep, 1u);
                    __syncthreads();
                    const int it = *qslot;
                    if (it >= nswa) break;
                    swa_item(lds, p, l, it, tid);
                }
            } else if (ph == 4) {
                phase_finalize(p, l, mrows, gw, ngw, lane);
            } else {
                norm_mod_rows(XL, XC, p->in[7] + l * DM, modl, 3072, 4096, XN, mrows, gw, ngw, lane);
            }
        }
        if (step == 0) cg::this_grid().sync();
        else { XcdBarrier xb_; xb_.bar = (unsigned*)(p->ws + WS_CTL) + 1024; xb_.x = xb_xcc_id(); xb_.st = (volatile LAS unsigned*)((LAS unsigned char*)lds + 147392); xcd_barrier(xb_); }
#ifdef PROBE
        { const unsigned long long dt_ = __builtin_amdgcn_s_memrealtime() - t0_; const int ph_ = step == 0 ? 9 : (step - 1) % 9;
          if (PROBE_C1(ph_)) tacc1 += dt_; if (PROBE_C2(ph_)) tacc2 += dt_; }
#endif
#ifdef DOUBLE_MASK
#ifdef DOUBLE_STEP0
        if (step == 0 && rep == 0) { rep = 1; --step; } else
#endif
#ifdef DOUBLE_D0
        if (step == 6 && rep == 0) { rep = 1; --step; } else
#endif
        if (step >= 1 && rep == 0 && ((DOUBLE_MASK >> ((step - 1) % 9)) & 1)) { rep = 1; --step; } else rep = 0;
#endif
        if (step + 1 >= MAXSTEP) break;
    }
}

extern "C" void kernel_launch(void* const* d_in, const int* in_sizes, int n_in, void* d_out, int out_size, void* d_ws, size_t ws_size, hipStream_t stream) {
    static int grid_blocks = 0;
    if (grid_blocks == 0) {
        if (n_in != 29 || out_size != ML * DM || ws_size < WS_END) { fprintf(stderr, "kernel_launch: unexpected shapes (n_in %d out %d ws %zu)\n", n_in, out_size, ws_size); grid_blocks = -1; return; }
        int dev = 0, cus = 0, per_cu = 0;
        (void)hipGetDevice(&dev);
        (void)hipDeviceGetAttribute(&cus, hipDeviceAttributeMultiprocessorCount, dev);
        (void)hipFuncSetAttribute((const void*)hybrid_fwd, hipFuncAttributeMaxDynamicSharedMemorySize, LDS_BYTES);
        (void)hipOccupancyMaxActiveBlocksPerMultiprocessor(&per_cu, (const void*)hybrid_fwd, NTHREADS, LDS_BYTES);
        if (per_cu < 1) per_cu = 1;
        grid_blocks = cus * per_cu;
        (void)hipGetLastError();
    }
    if (grid_blocks < 0) return;
    (void)hipMemsetAsync((char*)d_ws + WS_CTL, 0, 65536, stream);
    Params p{};
    for (int i = 0; i < 29; ++i) p.in[i] = (const float*)d_in[i];
    p.out = (float*)d_out; p.ws = (unsigned char*)d_ws;
    void* args[] = {&p};
    hipError_t e = hipLaunchCooperativeKernel((const void*)hybrid_fwd, dim3(grid_blocks), dim3(NTHREADS), args, LDS_BYTES, stream);
    if (e != hipSuccess) fprintf(stderr, "cooperative launch failed: %s (grid %d)\n", hipGetErrorString(e), grid_blocks);
}
```

```cpp
#include <hip/hip_runtime.h>
#include <hip/hip_cooperative_groups.h>
#include <cstdio>
#include <cstdint>
namespace cg = cooperative_groups;
namespace pg8 {
#define PG8_LAS __attribute__((address_space(3)))
typedef unsigned short bf16_t;
typedef short bf16x8 __attribute__((ext_vector_type(8)));
typedef float f32x4 __attribute__((ext_vector_type(4)));
typedef unsigned u32x4 __attribute__((ext_vector_type(4)));
constexpr int BM = 256, BK = 64, HALF = 128, HTB = HALF * BK * 2  , STAGE_BYTES = 8 * HTB, NXCD = 8, WGM = 8;

__host__ __device__ __forceinline__ int lds_byte(int r, int c) { const int st = (r >> 4) * 2 + (c >> 5), rr = r & 15, cc = c & 31, ob = rr * 64 + cc * 2; return st * 1024 + (ob ^ (((ob >> 9) & 1) << 5)); }
__host__ __device__ __forceinline__ void stage_rc(int b, int& R, int& C) { const int st = b / 1024, sb = b % 1024, swz = sb ^ (((sb >> 9) & 1) << 5); R = (st >> 1) * 16 + swz / 64; C = (st & 1) * 32 + (swz % 64) / 2; }
__host__ __device__ __forceinline__ int perm32(int rho) { const int n = rho >> 4, i = rho & 15; return 8 * (i >> 2) + 4 * n + (i & 3); }

struct Unit { int pm, pn; };
struct Gemm { const bf16_t* A; const bf16_t* Bt; int M, N, K; };

struct StaticOrder {
    int nM, nN, nwg, G, c;
    __host__ __device__ void init(int M, int N, int G_, int c_) { nM = M / BM; nN = N / BM; nwg = nM * nN; G = G_; c = c_; }
    __host__ __device__ bool next(int i, Unit& u) const {
        const long L = (long)i * G + c; if (L >= nwg) return false;
        int wgid = (int)L; { const int q = nwg / NXCD, r = nwg % NXCD, xcd = wgid % NXCD, off = wgid / NXCD; wgid = (xcd < r ? xcd * (q + 1) : r * (q + 1) + (xcd - r) * q) + off; }
        const int nig = WGM * nN, gid = wgid / nig, fm = gid * WGM, gsz = (nM - fm) < WGM ? (nM - fm) : WGM;
        u.pm = fm + ((wgid % nig) % gsz); u.pn = (wgid % nig) / gsz; return true;
    }
    __device__ __forceinline__ void a_ready(const Unit&) const {}
    __device__ __forceinline__ void done(const Unit&) const {}
};

__device__ __forceinline__ unsigned cvt_pk_bf16(float lo, float hi) { unsigned r; asm volatile("v_cvt_pk_bf16_f32 %0, %1, %2" : "=v"(r) : "v"(lo), "v"(hi)); return r; }
typedef float f32x2 __attribute__((ext_vector_type(2)));
constexpr int EP_ML = 32768;
struct EpiIn {
    static constexpr bool PERM = true, AFTER_DRAIN = false;
    bf16_t* O0; bf16_t* O1;
    __device__ __forceinline__ void operator()(const f32x4 (&acc)[2][2][4][2], const Unit& u, int wr, int wc, int fr, int fq) const {
        const int row0 = u.pm * BM + wr * 64 + fr;
#pragma unroll
        for (int bj = 0; bj < 2; ++bj) {
            const int c0 = u.pn * BM + bj * HALF + wc * 32 + 8 * fq;
            bf16_t* base; size_t ld; int cc; bool ok = true;
            if (c0 < 1568) { base = O0; ld = 1568; cc = c0; } else if (c0 < 2720) { base = O1; ld = 1152; cc = c0 - 1568; } else { base = O0; ld = 0; cc = 0; ok = false; }
            if (ok) {
#pragma unroll
            for (int ai = 0; ai < 2; ++ai)
#pragma unroll
                for (int m = 0; m < 4; ++m) {
                    const f32x4 v0 = acc[ai][bj][m][0], v1 = acc[ai][bj][m][1];
                    u32x4 w; w.x = cvt_pk_bf16(v0[0], v0[1]); w.y = cvt_pk_bf16(v0[2], v0[3]); w.z = cvt_pk_bf16(v1[0], v1[1]); w.w = cvt_pk_bf16(v1[2], v1[3]);
                    *(u32x4*)(base + (size_t)(row0 + ai * HALF + m * 16) * ld + cc) = w;
                }
            }
        }
    }
};
struct EpiRes {
    static constexpr bool PERM = true, AFTER_DRAIN = false;
    const float* srcL; float* dstL; const float* srcC; float* dstC; const float* gate;
    __device__ __forceinline__ void operator()(const f32x4 (&acc)[2][2][4][2], const Unit& u, int wr, int wc, int fr, int fq) const {
        const int rowt = u.pm * BM;
        const bool lat = rowt < EP_ML;
        const float* src = lat ? srcL : srcC; float* dst = lat ? dstL : dstC;
        const float* g = gate + (lat ? (rowt >> 12) : 8) * 6144; const int rb = lat ? rowt : rowt - EP_ML;
        const int col0 = u.pn * BM + wc * 32 + 8 * fq;
#pragma unroll
        for (int bj = 0; bj < 2; ++bj) {
            const f32x4 g0 = *(const f32x4*)(g + col0 + bj * HALF), g1 = *(const f32x4*)(g + col0 + bj * HALF + 4);
#pragma unroll
            for (int ai = 0; ai < 2; ++ai)
#pragma unroll
                for (int m = 0; m < 4; ++m) { const size_t off = (size_t)(rb + ai * HALF + wr * 64 + m * 16 + fr) * 1024 + col0 + bj * HALF;
                    const f32x4 s0 = *(const f32x4*)(src + off), s1 = *(const f32x4*)(src + off + 4);
                    *(f32x4*)(dst + off) = s0 + g0 * acc[ai][bj][m][0]; *(f32x4*)(dst + off + 4) = s1 + g1 * acc[ai][bj][m][1]; }
        }
    }
};
struct EpiSwiglu {
    static constexpr bool PERM = true, AFTER_DRAIN = false;
    bf16_t* O0;
    __device__ __forceinline__ void operator()(const f32x4 (&acc)[2][2][4][2], const Unit& u, int wr, int wc, int fr, int fq) const {
        const int row0 = u.pm * BM + wr * 64 + fr, col = u.pn * HALF + wc * 32 + 8 * fq;
#pragma unroll
        for (int ai = 0; ai < 2; ++ai)
#pragma unroll
            for (int m = 0; m < 4; ++m) {
                float h[8];
#pragma unroll
                for (int n = 0; n < 2; ++n)
#pragma unroll
                    for (int e = 0; e < 4; ++e) { const float gt = acc[ai][0][m][n][e], up = acc[ai][1][m][n][e]; h[n * 4 + e] = gt * up * __builtin_amdgcn_rcpf(1.0f + __expf(-gt)); }
                u32x4 w; w.x = cvt_pk_bf16(h[0], h[1]); w.y = cvt_pk_bf16(h[2], h[3]); w.z = cvt_pk_bf16(h[4], h[5]); w.w = cvt_pk_bf16(h[6], h[7]);
                *(u32x4*)(O0 + (size_t)(row0 + ai * HALF + m * 16) * 2816 + col) = w;
            }
    }
};
template <class Epi, class Sched, bool ALIGN_EPI = false, bool SP2 = false>
__device__ __forceinline__ void gemm_phase(PG8_LAS unsigned char* lds, const Gemm g, const Sched& S, const Epi& E, int tid_in) {
    const int tid = tid_in, wid = __builtin_amdgcn_readfirstlane(tid >> 6), lane = tid & 63, wr = wid >> 2, wc = wid & 3, fr = lane & 15, fq = lane >> 4;
    const int K = g.K, nt = K / BK;
    unsigned voffA[2], voffB[2];
#pragma unroll
    for (int i = 0; i < 2; ++i) { int R, C; stage_rc(tid * 16 + i * 8192, R, C); const int Rb = Epi::PERM ? ((R & ~31) + perm32(R & 31)) : R;
        voffA[i] = (unsigned)(R * K + C) * 2u; voffB[i] = (unsigned)(Rb * K + C) * 2u; }
    const size_t kstep = (size_t)(BK * 2);
    const size_t hstep = (size_t)HALF * K * 2;
    const size_t tstep = 2 * hstep;
    const unsigned ldsw = (unsigned)wid * 1024u;
    const int aoff = lds_byte(wr * 64 + fr, fq * 8), boff = lds_byte(wc * 32 + fr, fq * 8);
#define PG8_SA(b, h) (((b) * 2 + (h)) * HTB)
#define PG8_SB(b, h) ((4 + (b) * 2 + (h)) * HTB)
#define PG8_STAGE(bufoff, gbase, voff) do { _Pragma("unroll") for (int _i = 0; _i < 2; ++_i) \
        __builtin_amdgcn_global_load_lds((const unsigned*)((const char*)(gbase) + (voff)[_i]), (PG8_LAS unsigned*)(lds + (bufoff) + ldsw + _i * 8192), 16, 0, 0); } while (0)
#define PG8_LDA(dst, b, h) do { _Pragma("unroll") for (int m = 0; m < 4; ++m) _Pragma("unroll") for (int k = 0; k < 2; ++k) dst[m][k] = *(const PG8_LAS bf16x8*)(lds + PG8_SA(b, h) + aoff + m * 2048 + k * 1024); } while (0)
#define PG8_LDB(dst, b, h) do { _Pragma("unroll") for (int n = 0; n < 2; ++n) _Pragma("unroll") for (int k = 0; k < 2; ++k) dst[n][k] = *(const PG8_LAS bf16x8*)(lds + PG8_SB(b, h) + boff + n * 2048 + k * 1024); } while (0)
#define PG8_MMA(ai, bj, At, Bt) do { __builtin_amdgcn_s_setprio(1); _Pragma("unroll") for (int m = 0; m < 4; ++m) _Pragma("unroll") for (int n = 0; n < 2; ++n) _Pragma("unroll") for (int k = 0; k < 2; ++k) \
        acc[ai][bj][m][n] = __builtin_amdgcn_mfma_f32_16x16x32_bf16(Bt[n][k], At[m][k], acc[ai][bj][m][n], 0, 0, 0); __builtin_amdgcn_s_setprio(0); } while (0)
#define PG8_WAIT_V(n) asm volatile("s_waitcnt vmcnt(" #n ")" ::: "memory")
#define PG8_WAIT_L(n) asm volatile("s_waitcnt lgkmcnt(" #n ")" ::: "memory")
#define PG8_BAR __builtin_amdgcn_s_barrier()
#define PG8_SCHED __builtin_amdgcn_sched_barrier(0)
    Unit cur, nxt; int ui = 0;
    if (!S.next(0, cur)) return;
    f32x4 acc[2][2][4][2];
#pragma unroll
    for (int a = 0; a < 2; ++a)
#pragma unroll
        for (int b = 0; b < 2; ++b)
#pragma unroll
            for (int m = 0; m < 4; ++m)
#pragma unroll
                for (int n = 0; n < 2; ++n) acc[a][b][m][n] = (f32x4){0.f, 0.f, 0.f, 0.f};
    bf16x8 At[4][2], B0[2][2], B1[2][2];
    const char* cA = (const char*)g.A + (size_t)cur.pm * tstep; const char* cB = (const char*)g.Bt + (size_t)cur.pn * tstep;
    S.a_ready(cur);
    if constexpr (SP2) {
        PG8_STAGE(PG8_SB(0, 0), cB, voffB); PG8_STAGE(PG8_SB(0, 1), cB + hstep, voffB); PG8_STAGE(PG8_SA(0, 0), cA, voffA); PG8_STAGE(PG8_SA(0, 1), cA + hstep, voffA);
        if (wr == 1) PG8_BAR;
        PG8_WAIT_V(2); PG8_BAR;
        PG8_STAGE(PG8_SB(1, 0), cB + kstep, voffB); PG8_STAGE(PG8_SA(1, 0), cA + kstep, voffA); PG8_STAGE(PG8_SB(1, 1), cB + hstep + kstep, voffB);
        PG8_WAIT_V(6); PG8_BAR;
    } else {
        PG8_STAGE(PG8_SB(0, 0), cB, voffB); PG8_STAGE(PG8_SA(0, 0), cA, voffA); PG8_STAGE(PG8_SB(0, 1), cB + hstep, voffB); PG8_STAGE(PG8_SA(0, 1), cA + hstep, voffA);
        if (wr == 1) PG8_BAR;
        PG8_WAIT_V(4); PG8_BAR;
        PG8_STAGE(PG8_SB(1, 0), cB + kstep, voffB); PG8_STAGE(PG8_SA(1, 0), cA + kstep, voffA); PG8_STAGE(PG8_SB(1, 1), cB + hstep + kstep, voffB);
        PG8_WAIT_V(6); PG8_BAR;
    }
    for (;;) {
        const bool has_next = S.next(ui + 1, nxt);
        const char* nA = has_next ? (const char*)g.A + (size_t)nxt.pm * tstep : cA; const char* nB = has_next ? (const char*)g.Bt + (size_t)nxt.pn * tstep : cB;
        for (int t = 0; t < nt; t += 2) {
            const bool last = (t == nt - 2);
            const char* a1 = cA + (size_t)(t + 1) * kstep;
            const char* a2 = last ? nA : cA + (size_t)(t + 2) * kstep; const char* b2 = last ? nB : cB + (size_t)(t + 2) * kstep;
            const char* a3 = a2 + kstep; const char* b3 = b2 + kstep;
            if (last && has_next) S.a_ready(nxt);
            if constexpr (SP2) {
            PG8_LDB(B0, 0, 0); PG8_LDB(B1, 0, 1); PG8_SCHED; PG8_LDA(At, 0, 0); PG8_STAGE(PG8_SA(1, 1), a1 + hstep, voffA);
            PG8_WAIT_V(8); PG8_WAIT_L(0); PG8_BAR; PG8_MMA(0, 0, At, B0); PG8_MMA(0, 1, At, B1); PG8_BAR; PG8_SCHED;
            PG8_LDA(At, 0, 1); PG8_STAGE(PG8_SB(0, 0), b2, voffB); PG8_STAGE(PG8_SB(0, 1), b2 + hstep, voffB); PG8_STAGE(PG8_SA(0, 0), a2, voffA);
            PG8_WAIT_V(8); PG8_WAIT_L(0); PG8_BAR; PG8_MMA(1, 0, At, B0); PG8_MMA(1, 1, At, B1); PG8_BAR; PG8_SCHED;
            PG8_LDB(B0, 1, 0); PG8_LDB(B1, 1, 1); PG8_SCHED; PG8_LDA(At, 1, 0); PG8_STAGE(PG8_SA(0, 1), a2 + hstep, voffA);
            PG8_WAIT_V(8); PG8_WAIT_L(0); PG8_BAR; PG8_MMA(0, 0, At, B0); PG8_MMA(0, 1, At, B1); PG8_BAR; PG8_SCHED;
            PG8_LDA(At, 1, 1); PG8_STAGE(PG8_SB(1, 0), b3, voffB); PG8_STAGE(PG8_SB(1, 1), b3 + hstep, voffB); PG8_STAGE(PG8_SA(1, 0), a3, voffA);
            PG8_WAIT_V(8); PG8_WAIT_L(0); PG8_BAR; PG8_MMA(1, 0, At, B0); PG8_MMA(1, 1, At, B1); PG8_BAR; PG8_SCHED;
            } else {
            PG8_LDB(B0, 0, 0); PG8_SCHED; PG8_LDA(At, 0, 0); PG8_STAGE(PG8_SA(1, 1), a1 + hstep, voffA);
            PG8_WAIT_L(8); PG8_BAR; PG8_WAIT_L(0); PG8_MMA(0, 0, At, B0); PG8_BAR; PG8_SCHED;
            PG8_LDB(B1, 0, 1); PG8_STAGE(PG8_SB(0, 0), b2, voffB);
            PG8_BAR; PG8_WAIT_L(0); PG8_MMA(0, 1, At, B1); PG8_BAR;
            PG8_LDA(At, 0, 1); PG8_STAGE(PG8_SA(0, 0), a2, voffA);
            PG8_BAR; PG8_WAIT_L(0); PG8_MMA(1, 0, At, B0); PG8_BAR; PG8_SCHED;
            PG8_STAGE(PG8_SB(0, 1), b2 + hstep, voffB);
            PG8_WAIT_V(6); PG8_BAR; PG8_MMA(1, 1, At, B1); PG8_BAR;
            PG8_LDB(B0, 1, 0); PG8_SCHED; PG8_LDA(At, 1, 0); PG8_STAGE(PG8_SA(0, 1), a2 + hstep, voffA);
            PG8_WAIT_L(8); PG8_BAR; PG8_WAIT_L(0); PG8_MMA(0, 0, At, B0); PG8_BAR; PG8_SCHED;
            PG8_LDB(B1, 1, 1); PG8_STAGE(PG8_SB(1, 0), b3, voffB);
            PG8_BAR; PG8_WAIT_L(0); PG8_MMA(0, 1, At, B1); PG8_BAR;
            PG8_LDA(At, 1, 1); PG8_STAGE(PG8_SA(1, 0), a3, voffA);
            PG8_BAR; PG8_WAIT_L(0); PG8_MMA(1, 0, At, B0); PG8_BAR; PG8_SCHED;
            PG8_STAGE(PG8_SB(1, 1), b3 + hstep, voffB);
            PG8_WAIT_V(6); PG8_BAR; PG8_MMA(1, 1, At, B1); PG8_BAR;
            }
        }
        if constexpr (ALIGN_EPI) { if (wr == 0) PG8_BAR; }
        if constexpr (!Epi::AFTER_DRAIN) { E(acc, cur, wr, wc, fr, fq); S.done(cur); }
        if (!has_next) break;
#pragma unroll
        for (int a = 0; a < 2; ++a)
#pragma unroll
            for (int b = 0; b < 2; ++b)
#pragma unroll
                for (int m = 0; m < 4; ++m)
#pragma unroll
                    for (int n = 0; n < 2; ++n) acc[a][b][m][n] = (f32x4){0.f, 0.f, 0.f, 0.f};
        cur = nxt; cA = nA; cB = nB; ++ui;
        if constexpr (ALIGN_EPI) { if (wr == 1) PG8_BAR; }
    }
    PG8_WAIT_V(0);
    if constexpr (!ALIGN_EPI) { if (wr == 0) PG8_BAR; }
    PG8_BAR;
    if constexpr (Epi::AFTER_DRAIN) { E.fused(acc, cur, wr, wc, fr, fq, lds, wid, lane); S.done(cur); }
#undef PG8_SA
#undef PG8_SB
#undef PG8_STAGE
#undef PG8_LDA
#undef PG8_LDB
#undef PG8_MMA
#undef PG8_WAIT_V
#undef PG8_WAIT_L
#undef PG8_BAR
#undef PG8_SCHED
}
}
#define LAS __attribute__((address_space(3)))
typedef unsigned short bf16_t;
typedef _Float16 hf;
typedef _Float16 h8 __attribute__((ext_vector_type(8)));
typedef _Float16 h4 __attribute__((ext_vector_type(4)));
typedef unsigned u32x4 __attribute__((ext_vector_type(4)));
typedef unsigned u32x2 __attribute__((ext_vector_type(2)));
typedef float f32x4 __attribute__((ext_vector_type(4)));
typedef short bf16x8 __attribute__((ext_vector_type(8)));

constexpr int DM = 1024, NB = 8, SEQ = 4096, CTXL = 256, NLAYER = 4;
constexpr int ML = NB * SEQ, MC = NB * CTXL, MT = ML + MC;
constexpr int INC = 2720, INP = 2816, P1C = 1568, RAWC = 1152, FF = 2816;
constexpr int PRC = 2304, PGC = 512;
constexpr int NTHREADS = 512, NWAVES = 8;
constexpr int LDS_BYTES = 147456;
constexpr size_t MiB = 1u << 20;
constexpr size_t WS_CTL = 0, WS_MOD = 1 * MiB, WS_ROPE = 2 * MiB, WS_BONUS = 3 * MiB, WS_WT = 4 * MiB, WS_XC = 28 * MiB, WS_XN = 36 * MiB,
                 WS_P1 = 104 * MiB, WS_RAW = 209 * MiB, WS_PREP = 286 * MiB, WS_PG = 439 * MiB, WS_GG = 473 * MiB, WS_END = 490 * MiB;
constexpr size_t WS_H = 104 * MiB;
constexpr size_t WS_OR = 209 * MiB, WS_OG = 243 * MiB;
constexpr size_t WT_IN = 0, WT_OUT = (size_t)INP * DM * 2, WT_GU = WT_OUT + (size_t)DM * DM * 2, WT_DN = WT_GU + (size_t)2 * FF * DM * 2;
static_assert(WT_DN + (size_t)DM * FF * 2 == 24 * MiB, "wt");
static_assert(WS_P1 + (size_t)MT * P1C * 2 <= WS_RAW && WS_RAW + (size_t)MT * RAWC * 2 <= WS_PREP && WS_PREP + (size_t)MT * PRC * 2 <= WS_PG && WS_PG + (size_t)MT * PGC * 2 <= WS_GG && WS_GG + (size_t)MT * 256 * 2 <= WS_END, "ws map");
static_assert(WS_OG + (size_t)2 * MT * 256 * 2 <= WS_PREP && WS_H + (size_t)MT * FF * 2 <= WS_PG && WS_XN + (size_t)MT * DM * 2 <= WS_P1, "ws overlay");

struct Params { const float* in[29]; float* out; unsigned char* ws; };
typedef const __attribute__((address_space(4))) Params* kparams_t;

__device__ __forceinline__ float bf2f(unsigned b) { return __uint_as_float(b << 16); }
__device__ __forceinline__ unsigned f2bf(float f) { unsigned u = __float_as_uint(f); return (u + 0x7fffu + ((u >> 16) & 1u)) >> 16; }
__device__ __forceinline__ unsigned pk2(float lo, float hi) { return f2bf(lo) | (f2bf(hi) << 16); }
typedef float f32x2_t __attribute__((ext_vector_type(2))); typedef __bf16 bf16x2_t __attribute__((ext_vector_type(2)));
__device__ __forceinline__ unsigned cvtpk(float lo, float hi) { const f32x2_t v = {lo, hi}; const bf16x2_t b = __builtin_convertvector(v, bf16x2_t); return __builtin_bit_cast(unsigned, b); }
__device__ __forceinline__ float bflo(unsigned w) { return __uint_as_float(w << 16); }
__device__ __forceinline__ float bfhi(unsigned w) { return __uint_as_float(w & 0xffff0000u); }
__device__ __forceinline__ float sigmoidf_(float x) { return __builtin_amdgcn_rcpf(1.0f + __expf(-x)); }
__device__ __forceinline__ float softplusf_(float x) { return fmaxf(x, 0.f) + __logf(1.0f + __expf(-fabsf(x))); }
template <int CTRL> __device__ __forceinline__ float dpp_add(float x) {
    return x + __int_as_float(__builtin_amdgcn_update_dpp(0, __float_as_int(x), CTRL, 0xF, 0xF, true));
}
__device__ __forceinline__ float reduce4(float x) { x = dpp_add<0xB1>(x); x = dpp_add<0x4E>(x); return x; }
__device__ __forceinline__ float reduce16(float x) { x = dpp_add<0xB1>(x); x = dpp_add<0x4E>(x); x = dpp_add<0x141>(x); x = dpp_add<0x140>(x); return x; }
__device__ __forceinline__ float reduce8(float x) { x = dpp_add<0xB1>(x); x = dpp_add<0x4E>(x); x = dpp_add<0x141>(x); return x; }
__device__ __forceinline__ float wave_sum(float v) {
    v = reduce16(v);
    const int vi = __float_as_int(v);
    const float r0 = __int_as_float(__builtin_amdgcn_readlane(vi, 0)), r1 = __int_as_float(__builtin_amdgcn_readlane(vi, 16)), r2 = __int_as_float(__builtin_amdgcn_readlane(vi, 32)), r3 = __int_as_float(__builtin_amdgcn_readlane(vi, 48));
    return (r0 + r1) + (r2 + r3);
}

__device__ __forceinline__ void phase_mod(unsigned char* lds, kparams_t p, int tid, int bid, int G) {
    float* sc = (float*)lds;
    float* part = (float*)(lds + 36864);
    const float* c = p->in[1]; const float* cctx = p->in[3]; const float* ada_w = p->in[4]; const float* ada_b = p->in[5];
    float* MOD = (float*)(p->ws + WS_MOD);
    for (int i = tid; i < 9 * 1024; i += NTHREADS) { const float x = i < 8192 ? c[i] : cctx[i - 8192]; sc[i] = x * sigmoidf_(x); }
    __syncthreads();
    const int cl = tid & 31, kg = tid >> 5;
    for (int item = bid; item < NLAYER * 192; item += G) {
        const int l = item / 192, cgp = item % 192, col = cgp * 32 + cl;
        float acc[9];
#pragma unroll
        for (int s = 0; s < 9; ++s) acc[s] = 0.f;
        const float* w = ada_w + ((size_t)l * 1024 + kg * 64) * 6144 + col;
#pragma unroll 16
        for (int kk = 0; kk < 64; ++kk) { const float wv = w[(size_t)kk * 6144];
#pragma unroll
            for (int s = 0; s < 9; ++s) acc[s] = fmaf(sc[s * 1024 + kg * 64 + kk], wv, acc[s]); }
#pragma unroll
        for (int s = 0; s < 9; ++s) part[(kg * 9 + s) * 32 + cl] = acc[s];
        __syncthreads();
        if (tid < 288) { const int s = tid >> 5; float a = ada_b[l * 6144 + col];
#pragma unroll
            for (int k2 = 0; k2 < 16; ++k2) a += part[(k2 * 9 + s) * 32 + cl];
            MOD[((size_t)l * 9 + s) * 6144 + col] = a; }
        __syncthreads();
    }
    float* RC = (float*)(p->ws + WS_ROPE); float* RS = RC + 4096 * 32;
    for (int idx = bid * NTHREADS + tid; idx < 4096 * 32; idx += G * NTHREADS) {
        const int t = idx >> 5, j = idx & 31; const float pos = (float)(j < 16 ? (t >> 6) : (t & 63));
        const float inv = exp2f(-(float)(j & 15) * (13.287712379549449f / 16.0f));
        const float ang = pos * inv; const float rev = ang * 0.15915494309189535f; const float fr = rev - floorf(rev);
        const float a2 = fr * 6.283185307179586f;
        RC[idx] = __cosf(a2); RS[idx] = __sinf(a2);
    }
}

__device__ __forceinline__ void transpose_item(const float* W, int K, int N, bf16_t* WT, int k0, int n0, int drow0, LAS float* scr, int lane) {
#pragma unroll 16
    for (int i = 0; i < 32; ++i) { const int kk = 2 * i + (lane >> 5); scr[kk * 33 + (lane & 31)] = W[(size_t)(k0 + kk) * N + n0 + (lane & 31)]; }
    asm volatile("s_waitcnt lgkmcnt(0)" ::: "memory");
    const int c = lane & 7;
#pragma unroll
    for (int j = 0; j < 4; ++j) { const int n = (lane >> 3) + 8 * j; const LAS float* s = scr + (8 * c) * 33 + n;
        u32x4 o; o.x = pk2(s[0 * 33], s[1 * 33]); o.y = pk2(s[2 * 33], s[3 * 33]); o.z = pk2(s[4 * 33], s[5 * 33]); o.w = pk2(s[6 * 33], s[7 * 33]);
        *(u32x4*)(WT + (size_t)(drow0 + n) * K + k0 + 8 * c) = o; }
    asm volatile("s_waitcnt lgkmcnt(0)" ::: "memory");
}
__device__ __forceinline__ void convert_weights(unsigned char* lds, kparams_t p, int l, int gw, int ngw, int wave, int lane) {
    LAS float* scr = (LAS float*)((LAS unsigned char*)lds + wave * 16384);
    unsigned char* wt = p->ws + WS_WT;
    constexpr int I_IN = 16 * 85, I_OUT = 16 * 32, I_G = 16 * 88, I_D = 44 * 32;
    constexpr int NIT = I_IN + I_OUT + 2 * I_G + I_D;
    for (int it = gw; it < NIT; it += ngw) {
        int r = it;
        if (r < I_IN) { const int kb = r / 85, nb = r % 85; transpose_item(p->in[8] + (size_t)l * DM * INC, DM, INC, (bf16_t*)(wt + WT_IN), kb * 64, nb * 32, nb * 32, scr, lane); continue; } r -= I_IN;
        if (r < I_OUT) { const int kb = r / 32, nb = r % 32; transpose_item(p->in[9] + (size_t)l * DM * DM, DM, DM, (bf16_t*)(wt + WT_OUT), kb * 64, nb * 32, nb * 32, scr, lane); continue; } r -= I_OUT;
        if (r < I_G) { const int kb = r / 88, nb = r % 88, n0 = nb * 32; transpose_item(p->in[25] + (size_t)l * DM * FF, DM, FF, (bf16_t*)(wt + WT_GU), kb * 64, n0, (n0 >> 7) * 256 + (n0 & 127), scr, lane); continue; } r -= I_G;
        if (r < I_G) { const int kb = r / 88, nb = r % 88, n0 = nb * 32; transpose_item(p->in[26] + (size_t)l * DM * FF, DM, FF, (bf16_t*)(wt + WT_GU), kb * 64, n0, (n0 >> 7) * 256 + 128 + (n0 & 127), scr, lane); continue; } r -= I_G;
        { const int kb = r / 32, nb = r % 32; transpose_item(p->in[27] + (size_t)l * FF * DM, FF, DM, (bf16_t*)(wt + WT_DN), kb * 64, nb * 32, nb * 32, scr, lane); }
    }
}

__device__ __forceinline__ void norm_mod_rows(const float* srcL, const float* srcC, const float* gamma, const float* modl, int shoff, int scoff, bf16_t* XN, int nrows, int gw, int ngw, int lane) {
    int m = gw; f32x4 v[4];
    if (m < nrows) { const float* xr = m < ML ? srcL + (size_t)m * DM : srcC + (size_t)(m - ML) * DM;
#pragma unroll
        for (int j = 0; j < 4; ++j) v[j] = ((const f32x4*)xr)[lane + 64 * j]; }
    while (m < nrows) {
        const int mn = m + ngw; f32x4 vn[4];
        if (mn < nrows) { const float* xr = mn < ML ? srcL + (size_t)mn * DM : srcC + (size_t)(mn - ML) * DM;
#pragma unroll
            for (int j = 0; j < 4; ++j) vn[j] = ((const f32x4*)xr)[lane + 64 * j]; }
        const int s = m < ML ? (m >> 12) : 8; const float* md = modl + (size_t)s * 6144;
        float ss = 0.f;
#pragma unroll
        for (int j = 0; j < 4; ++j) ss += (v[j].x * v[j].x + v[j].y * v[j].y) + (v[j].z * v[j].z + v[j].w * v[j].w);
        const float rstd = rsqrtf(wave_sum(ss) * (1.0f / DM) + 1e-6f);
#pragma unroll
        for (int j = 0; j < 4; ++j) { const int c4 = lane + 64 * j; const f32x4 g = ((const f32x4*)gamma)[c4], sc = ((const f32x4*)(md + scoff))[c4], sh = ((const f32x4*)(md + shoff))[c4];
            const f32x4 y = (v[j] * rstd * g) * (sc + 1.0f) + sh; u32x2 o; o.x = cvtpk(y.x, y.y); o.y = cvtpk(y.z, y.w);
            ((u32x2*)(XN + (size_t)m * DM))[c4] = o; }
#pragma unroll
        for (int j = 0; j < 4; ++j) v[j] = vn[j];
        m = mn;
    }
}
__device__ __forceinline__ void final_norm_rows(float* x, const float* gamma, int gw, int ngw, int lane) {
    for (int m = gw; m < ML; m += ngw) {
        float* xr = x + (size_t)m * DM; f32x4 v[4]; float ss = 0.f;
#pragma unroll
        for (int j = 0; j < 4; ++j) { v[j] = ((const f32x4*)xr)[lane + 64 * j]; ss += (v[j].x * v[j].x + v[j].y * v[j].y) + (v[j].z * v[j].z + v[j].w * v[j].w); }
        const float rstd = rsqrtf(wave_sum(ss) * (1.0f / DM) + 1e-6f);
#pragma unroll
        for (int j = 0; j < 4; ++j) { const int c4 = lane + 64 * j; ((f32x4*)xr)[c4] = v[j] * rstd * ((const f32x4*)gamma)[c4]; }
    }
}
#define XB_TMO      128
#define XB_XCNT(j)  (256  + 64 * (j))
#define XB_XSUB(j)  (1280 + 64 * (j))
#define XB_XGEN(j)  (2304 + 64 * (j))
#define XB_TOP      3328
#define XB_TOPGEN   3392
#define XCD_BAR_WORDS 3456
#define XB_SPIN_CAP (1u << 18)

__device__ __forceinline__ unsigned xb_ld(unsigned* p)              { return __hip_atomic_load(p, __ATOMIC_RELAXED, __HIP_MEMORY_SCOPE_AGENT); }
__device__ __forceinline__ unsigned xb_add(unsigned* p, unsigned v) { return __hip_atomic_fetch_add(p, v, __ATOMIC_RELAXED, __HIP_MEMORY_SCOPE_AGENT); }
__device__ __forceinline__ unsigned xb_xcc_id() { return (unsigned)__builtin_amdgcn_s_getreg((3 << 11) | 20) & 0xFu; }
#define XB_SPIN(cond, bar) do { unsigned _sp = 0; while (cond) { __builtin_amdgcn_s_sleep(1); \
    if ((++_sp & 255u) == 0u) { if (xb_ld(&(bar)[XB_TMO])) break; if (_sp > XB_SPIN_CAP) { atomicAdd(&(bar)[XB_TMO], 1u); break; } } } } while (0)

struct XcdBarrier {
    unsigned* bar; unsigned x;
    volatile LAS unsigned* st;
};

__device__ __forceinline__ XcdBarrier xcd_barrier_post(unsigned* bar, volatile LAS unsigned* st) {
    XcdBarrier b; b.bar = bar; b.x = xb_xcc_id(); b.st = st;
    if (threadIdx.x == 0) (void)xb_add(&bar[XB_XCNT(b.x)], 1u);
    return b;
}
__device__ __forceinline__ void xcd_barrier_complete(unsigned* bar, unsigned x, unsigned& nloc, unsigned& nx) {
    const unsigned G = gridDim.x * gridDim.y * gridDim.z;
    unsigned sum, cnt, mine, sp = 0u;
    for (;;) {
        sum = 0u; cnt = 0u; mine = 0u;
#pragma unroll
        for (unsigned j = 0; j < 16; ++j) { const unsigned c = xb_ld(&bar[XB_XCNT(j)]); sum += c; cnt += (c > 0u) ? 1u : 0u; mine = (j == x) ? c : mine; }
        if (sum == G) break;
        __builtin_amdgcn_s_sleep(1);
        if ((++sp & 255u) == 0u) { if (xb_ld(&bar[XB_TMO])) break; if (sp > XB_SPIN_CAP) { atomicAdd(&bar[XB_TMO], 1u); break; } }
    }
    nloc = mine > 0u ? mine : 1u; nx = cnt > 0u ? cnt : 1u;
}

__device__ __forceinline__ void xcd_barrier(const XcdBarrier& b) {
    asm volatile("s_waitcnt vmcnt(0)" ::: "memory");
    __syncthreads();
    if (threadIdx.x == 0) {
        unsigned* bar = b.bar;
        __builtin_amdgcn_s_waitcnt(0);
        unsigned nloc = b.st[0], nx = b.st[1];
        if (nloc == 0u) { xcd_barrier_complete(bar, b.x, nloc, nx); b.st[0] = nloc; b.st[1] = nx; }
        const unsigned old = xb_add(&bar[XB_XSUB(b.x)], 1u);
        const unsigned gen = old / nloc;
        if (old + 1u == (gen + 1u) * nloc) {
            __builtin_amdgcn_fence(__ATOMIC_RELEASE, "agent");
            asm volatile("s_waitcnt vmcnt(0)" ::: "memory");
            const unsigned og = xb_add(&bar[XB_TOP], 1u);
            const unsigned tg = og / nx;
            if (og + 1u == (tg + 1u) * nx) xb_add(&bar[XB_TOPGEN], 1u);
            else XB_SPIN(xb_ld(&bar[XB_TOPGEN]) == tg, bar);
            __builtin_amdgcn_fence(__ATOMIC_ACQUIRE, "agent");
            xb_add(&bar[XB_XGEN(b.x)], 1u);
            asm volatile("s_waitcnt vmcnt(0)" ::: "memory");
        } else {
            XB_SPIN(xb_ld(&bar[XB_XGEN(b.x)]) == gen, bar);
            __builtin_amdgcn_fence(__ATOMIC_ACQUIRE, "agent");
            asm volatile("s_waitcnt vmcnt(0)" ::: "memory");
        }
    }
    __syncthreads();
}
__device__ __forceinline__ bf16x8 load_wfrag(const float* W, int k0, int c) {
    u32x4 t; t.x = pk2(W[(k0 + 0) * 256 + c], W[(k0 + 1) * 256 + c]); t.y = pk2(W[(k0 + 2) * 256 + c], W[(k0 + 3) * 256 + c]);
    t.z = pk2(W[(k0 + 4) * 256 + c], W[(k0 + 5) * 256 + c]); t.w = pk2(W[(k0 + 6) * 256 + c], W[(k0 + 7) * 256 + c]);
    return __builtin_bit_cast(bf16x8, t);
}
__device__ __forceinline__ u32x2 pack_h4(float a, float b, float c, float d) {
    const h4 v = {(hf)a, (hf)b, (hf)c, (hf)d}; return __builtin_bit_cast(u32x2, v);
}
__device__ __forceinline__ void phase_prep(unsigned char* ldsg, kparams_t p, int l, int tid, int bid, int G, bool do_rope) {
    LAS unsigned char* lds = (LAS unsigned char*)ldsg;
    LAS float* SH = (LAS float*)lds;
    LAS unsigned char* ACT = lds + 73728;
    LAS float* KK = (LAS float*)(lds + 86272);
    LAS float* GL = (LAS float*)(lds + 102656);
    const int lane = tid & 63, wave = tid >> 6, fr = lane & 15, quad = lane >> 4;
    bf16_t* P1 = (bf16_t*)(p->ws + WS_P1); const bf16_t* RAW = (const bf16_t*)(p->ws + WS_RAW);
    hf* PREP = (hf*)(p->ws + WS_PREP); hf* PG = (hf*)(p->ws + WS_PG); hf* GG = (hf*)(p->ws + WS_GG); float* BONUS = (float*)(p->ws + WS_BONUS);
    const float* RC = (const float*)(p->ws + WS_ROPE); const float* RS = RC + 4096 * 32;
    const float* shw = p->in[14] + (size_t)l * 3 * RAWC;
    const float* w0 = p->in[15] + (size_t)l * 512; const float* w2 = p->in[16] + (size_t)l * 2 * 64 * 256;
    const float* a0 = p->in[17] + (size_t)l * 512; const float* a2 = p->in[18] + (size_t)l * 2 * 64 * 256;
    const float* g2 = p->in[19] + (size_t)l * 128 * 256;
    const float* k_k = p->in[20] + l * 256; const float* k_a = p->in[21] + l * 256; const float* r_k = p->in[22] + l * 256;
    const float* dw = p->in[10] + (size_t)l * 2 * 16 * 128; const float* db = p->in[11] + l * 256;
    bf16x8 Fw[2][2][2], Fa[2][2][2], Fg[2][4];
#pragma unroll
    for (int ct2 = 0; ct2 < 2; ++ct2) { const int c = (wave * 2 + ct2) * 16 + fr;
#pragma unroll
        for (int i = 0; i < 2; ++i)
#pragma unroll
            for (int ks = 0; ks < 2; ++ks) { Fw[i][ct2][ks] = load_wfrag(w2 + (size_t)i * 64 * 256, ks * 32 + quad * 8, c); Fa[i][ct2][ks] = load_wfrag(a2 + (size_t)i * 64 * 256, ks * 32 + quad * 8, c); }
#pragma unroll
        for (int ks = 0; ks < 4; ++ks) Fg[ct2][ks] = load_wfrag(g2, ks * 32 + quad * 8, c); }
    const int cgp = tid % 144, part = tid / 144, c8 = cgp * 8;
    const int tokb = part == 0 ? 0 : (part == 1 ? 6 : 11), toke = part == 0 ? 6 : (part == 1 ? 11 : 16);
    for (int tile = bid; tile < MT / 16; tile += G) {
        const int row0 = tile * 16; const bool lat = row0 < ML;
        const int t0 = lat ? (row0 & 4095) : ((row0 - ML) & 255); const int T = lat ? 4096 : 256;
        if (part < 3) {
            float sw0[8], sw1[8], sw2[8];
#pragma unroll
            for (int e = 0; e < 8; ++e) { sw0[e] = shw[c8 + e]; sw1[e] = shw[RAWC + c8 + e]; sw2[e] = shw[2 * RAWC + c8 + e]; }
            const u32x4 z4 = {0u, 0u, 0u, 0u};
            const bf16_t* rp = RAW + (size_t)(row0 + tokb) * RAWC + c8;
            const int ntok = toke - tokb;
            u32x4 rw[8];
#pragma unroll
            for (int j = 0; j < 8; ++j) { const int tt = t0 + tokb - 1 + j; rw[j] = (j < ntok + 2 && tt >= 0 && tt < T) ? *(const u32x4*)(rp + (ptrdiff_t)(j - 1) * RAWC) : z4; }
#pragma unroll
            for (int j = 0; j < 6; ++j) {
                if (j < ntok) {
                    const int tok = tokb + j; const u32x4 prv = rw[j], cur = rw[j + 1], nxt = rw[j + 2];
                    f32x4 o0, o1;
#pragma unroll
                    for (int e = 0; e < 4; ++e) {
                        const float x0 = sw0[2 * e] * bflo(prv[e]) + sw1[2 * e] * bflo(cur[e]) + sw2[2 * e] * bflo(nxt[e]);
                        const float x1 = sw0[2 * e + 1] * bfhi(prv[e]) + sw1[2 * e + 1] * bfhi(cur[e]) + sw2[2 * e + 1] * bfhi(nxt[e]);
                        if (e < 2) { o0[2 * e] = x0; o0[2 * e + 1] = x1; } else { o1[2 * e - 4] = x0; o1[2 * e - 3] = x1; }
                    }
                    *(LAS f32x4*)(SH + tok * RAWC + c8) = o0; *(LAS f32x4*)(SH + tok * RAWC + c8 + 4) = o1;
                }
            }
        }
        { const int tok = tid >> 5, j = tid & 31; GL[j * 16 + tok] = bf2f(P1[(size_t)(row0 + tok) * P1C + 768 + j]); }
        __syncthreads();
        for (int idx = tid; idx < 16 * 192; idx += NTHREADS) {
            const int tok = idx / 192, j2 = (idx % 192) * 2; const float xa = SH[tok * RAWC + 768 + j2], xb = SH[tok * RAWC + 768 + j2 + 1];
            float ya, yb;
            if (j2 < 128) { ya = 1.0f - 2.0f * __builtin_amdgcn_rcpf(__expf(2.0f * xa) + 1.0f); yb = 1.0f - 2.0f * __builtin_amdgcn_rcpf(__expf(2.0f * xb) + 1.0f); }
            else if (j2 < 256) { ya = xa; yb = xb; }
            else { ya = sigmoidf_(xa); yb = sigmoidf_(xb); }
            *(LAS unsigned*)(ACT + tok * 784 + j2 * 2) = cvtpk(ya, yb);
        }
#pragma unroll 1
        for (int i = 0; i < 8; ++i) {
            const int pair = wave * 8 + i, tok = pair >> 2, h = pair & 3, c = h * 64 + lane; const size_t row = row0 + tok;
            const float r = SH[tok * RAWC + c], k = SH[tok * RAWC + 256 + c], v = SH[tok * RAWC + 512 + c];
            const float val = k * k_k[c]; const float ss = wave_sum(val * val); const float kk = val * rsqrtf(ss + 1e-12f);
            KK[tok * 256 + c] = kk;
            const float bon = wave_sum(r * k * r_k[c]);
            if (lane == 0) BONUS[row * 4 + h] = bon;
            PREP[row * PRC + c] = (hf)r; PREP[row * PRC + 256 + c] = (hf)kk; PREP[row * PRC + 512 + c] = (hf)v;
        }
        __syncthreads();
        {
#define BFRAG(s2) (*(const LAS bf16x8*)(ACT + fr * 784 + ((s2) * 32 + quad * 8) * 2))
            const size_t row = row0 + fr;
#pragma unroll
            for (int ct2 = 0; ct2 < 2; ++ct2) {
                const int c0 = (wave * 2 + ct2) * 16 + quad * 4;
                const f32x4 zf = {0.f, 0.f, 0.f, 0.f};
                const f32x4 k4 = *(const LAS f32x4*)(SH + fr * RAWC + 256 + c0), kk4 = *(const LAS f32x4*)(KK + fr * 256 + c0), ka4 = *(const f32x4*)(k_a + c0);
#pragma unroll
                for (int i = 0; i < 2; ++i) {
                    f32x4 aw = __builtin_amdgcn_mfma_f32_16x16x32_bf16(Fw[i][ct2][0], BFRAG(i * 2), zf, 0, 0, 0); aw = __builtin_amdgcn_mfma_f32_16x16x32_bf16(Fw[i][ct2][1], BFRAG(i * 2 + 1), aw, 0, 0, 0);
                    f32x4 aa = __builtin_amdgcn_mfma_f32_16x16x32_bf16(Fa[i][ct2][0], BFRAG(4 + i * 2), zf, 0, 0, 0); aa = __builtin_amdgcn_mfma_f32_16x16x32_bf16(Fa[i][ct2][1], BFRAG(4 + i * 2 + 1), aa, 0, 0, 0);
                    const f32x4 z = aw + *(const f32x4*)(w0 + i * 256 + c0), az = aa + *(const f32x4*)(a0 + i * 256 + c0);
                    float dec[4], bb[4], kd[4];
#pragma unroll
                    for (int j = 0; j < 4; ++j) { dec[j] = __expf(-__expf(-softplusf_(-z[j]) - 0.5f)); const float a = sigmoidf_(az[j]); bb[j] = -(kk4[j] * a); kd[j] = k4[j] * (1.0f + (a - 1.0f) * ka4[j]); }
                    hf* dst = PREP + row * PRC + 768 + i * 768 + c0;
                    *(u32x2*)dst = pack_h4(dec[0], dec[1], dec[2], dec[3]); *(u32x2*)(dst + 256) = pack_h4(bb[0], bb[1], bb[2], bb[3]); *(u32x2*)(dst + 512) = pack_h4(kd[0], kd[1], kd[2], kd[3]);
                }
                f32x4 ag = __builtin_amdgcn_mfma_f32_16x16x32_bf16(Fg[ct2][0], BFRAG(8), zf, 0, 0, 0);
#pragma unroll
                for (int ks = 1; ks < 4; ++ks) ag = __builtin_amdgcn_mfma_f32_16x16x32_bf16(Fg[ct2][ks], BFRAG(8 + ks), ag, 0, 0, 0);
                *(u32x2*)(GG + row * 256 + c0) = pack_h4(ag[0], ag[1], ag[2], ag[3]);
            }
        }
        {
            const int c = tid & 127, i = (tid >> 7) & 1, th = tid >> 8;
            float acc[8]; const float bb = db[i * 128 + c];
#pragma unroll
            for (int q = 0; q < 8; ++q) acc[q] = bb;
            const float* W = dw + (size_t)i * 16 * 128 + c;
#pragma unroll
            for (int j = 0; j < 16; ++j) { const float wv = W[j * 128]; const f32x4 ta = *(const LAS f32x4*)(GL + (i * 16 + j) * 16 + th * 8), tb = *(const LAS f32x4*)(GL + (i * 16 + j) * 16 + th * 8 + 4);
                acc[0] = fmaf(ta.x, wv, acc[0]); acc[1] = fmaf(ta.y, wv, acc[1]); acc[2] = fmaf(ta.z, wv, acc[2]); acc[3] = fmaf(ta.w, wv, acc[3]);
                acc[4] = fmaf(tb.x, wv, acc[4]); acc[5] = fmaf(tb.y, wv, acc[5]); acc[6] = fmaf(tb.z, wv, acc[6]); acc[7] = fmaf(tb.w, wv, acc[7]); }
#pragma unroll
            for (int q = 0; q < 8; ++q) { const float glog = -softplusf_(-acc[q]) * (1.0f / 16.0f); PG[(size_t)(row0 + th * 8 + q) * PGC + 256 + i * 128 + c] = (hf)__expf(glog); }
            { const int tok = tid >> 5, c8q = (tid & 31) * 8; const u32x4 x = *(const u32x4*)(P1 + (size_t)(row0 + tok) * P1C + c8q); const float sc = c8q < 128 ? 0.17677669529663687f : 1.0f;
              u32x4 o;
#pragma unroll
              for (int e = 0; e < 4; ++e) { const h4 t = {(hf)(bflo(x[e]) * sc), (hf)(bfhi(x[e]) * sc), (hf)0.f, (hf)0.f}; o[e] = __builtin_bit_cast(u32x2, t).x; }
              *(u32x4*)(PG + (size_t)(row0 + tok) * PGC + c8q) = o; }
        }
        if (lat && do_rope) {
            for (int task = tid; task < 640; task += NTHREADS) {
                const int tok = task / 40, r = task % 40, hh = r >> 2, gi = r & 3; const int t = t0 + tok;
                bf16_t* ptr = P1 + (size_t)(row0 + tok) * P1C + 800 + hh * 64 + gi * 8;
                const u32x4 x1 = *(const u32x4*)ptr, x2 = *(const u32x4*)(ptr + 32);
                const f32x4 ca = *(const f32x4*)(RC + t * 32 + gi * 8), cb = *(const f32x4*)(RC + t * 32 + gi * 8 + 4), sa = *(const f32x4*)(RS + t * 32 + gi * 8), sb = *(const f32x4*)(RS + t * 32 + gi * 8 + 4);
                const float cs[8] = {ca.x, ca.y, ca.z, ca.w, cb.x, cb.y, cb.z, cb.w}, sn[8] = {sa.x, sa.y, sa.z, sa.w, sb.x, sb.y, sb.z, sb.w};
                u32x4 o1, o2;
#pragma unroll
                for (int e = 0; e < 4; ++e) {
                    const float a0_ = bflo(x1[e]), a1_ = bfhi(x1[e]), b0_ = bflo(x2[e]), b1_ = bfhi(x2[e]);
                    const float c0_ = cs[2 * e], c1_ = cs[2 * e + 1], s0_ = sn[2 * e], s1_ = sn[2 * e + 1];
                    o1[e] = cvtpk(a0_ * c0_ - b0_ * s0_, a1_ * c1_ - b1_ * s1_); o2[e] = cvtpk(a0_ * s0_ + b0_ * c0_, a1_ * s1_ + b1_ * c1_);
                }
                *(u32x4*)ptr = o1; *(u32x4*)(ptr + 32) = o2;
            }
        }
        __syncthreads();
    }
}
#ifndef NO_MIX
#define MIXLO(d, a, h, c) asm("v_fma_mix_f32 %0, %1, %2, %3 op_sel:[0,0,0] op_sel_hi:[0,1,0]" : "=v"(d) : "v"(a), "v"(h), "v"(c))
#define MIXHI(d, a, h, c) asm("v_fma_mix_f32 %0, %1, %2, %3 op_sel:[0,1,0] op_sel_hi:[0,1,0]" : "=v"(d) : "v"(a), "v"(h), "v"(c))
#else
#define MIXLO(d, a, h, c) d = fmaf(a, (float)__builtin_bit_cast(hf, (unsigned short)((h) & 0xffffu)), c)
#define MIXHI(d, a, h, c) d = fmaf(a, (float)__builtin_bit_cast(hf, (unsigned short)((h) >> 16)), c)
#endif
#define DSR128(dst, addr, OFF) asm volatile("ds_read_b128 %0, %1 offset:" #OFF : "=v"(dst) : "v"(addr))
#define DSR64(dst, addr, OFF) asm volatile("ds_read_b64 %0, %1 offset:" #OFF : "=v"(dst) : "v"(addr))
#define DSR16(dst, addr, OFF) asm volatile("ds_read_u16 %0, %1 offset:" #OFF : "=v"(dst) : "v"(addr))
#define LDS_BAR() do { asm volatile("s_waitcnt lgkmcnt(0)" ::: "memory"); __builtin_amdgcn_s_barrier(); asm volatile("" ::: "memory"); } while (0)
#define REP32(M) M(0) M(1) M(2) M(3) M(4) M(5) M(6) M(7) M(8) M(9) M(10) M(11) M(12) M(13) M(14) M(15) M(16) M(17) M(18) M(19) M(20) M(21) M(22) M(23) M(24) M(25) M(26) M(27) M(28) M(29) M(30) M(31)
__device__ __forceinline__ unsigned lds_addr(LAS unsigned char* p) { return (unsigned)(uintptr_t)p; }

__device__ __forceinline__ int chain_row(int b, int dir, int s) {
    if (s < 256) return ML + b * 256 + (dir ? 255 - s : s);
    const int t = s - 256; return b * 4096 + (dir ? 4095 - t : t);
}
constexpr int NCHUNK = (SEQ + CTXL) / 32;
__device__ __forceinline__ void rwkv_scan_item(unsigned char* ldsg, kparams_t p, int item, int tid, int expflag) {
    LAS unsigned char* lds = (LAS unsigned char*)ldsg;
    constexpr int STEPB = 704, BUFB = 32 * STEPB, NPIECE = 32 * 44;
    LAS unsigned char* obuf = lds + 2 * BUFB;
    const int chain = item >> 1, half_ = item & 1, b = chain >> 3, h = (chain >> 1) & 3, dir = chain & 1;
    const int lane = tid & 63, wave = tid >> 6, kq = lane & 15, rloc = wave * 4 + (lane >> 4);
    const hf* PREP = (const hf*)(p->ws + WS_PREP); hf* OR = (hf*)(p->ws + WS_OR) + (size_t)dir * MT * 256;
    int srcoff[6]; srcoff[0] = h * 64; srcoff[1] = 256 + h * 64; srcoff[2] = 768 + dir * 768 + h * 64; srcoff[3] = srcoff[2] + 256; srcoff[4] = srcoff[2] + 512; srcoff[5] = 512 + h * 64 + half_ * 32;
    float S[4];
#pragma unroll
    for (int i = 0; i < 4; ++i) S[i] = 0.f;
    u32x4 pre[3];
#define RW_ISSUE(cc) do { const bool isctx_ = (cc) < 8; _Pragma("unroll") for (int i_ = 0; i_ < 3; ++i_) { int pp = tid + i_ * NTHREADS; pp = pp < NPIECE ? pp : pp - NTHREADS; const int st = pp / 44, q = pp % 44; \
        const int s_ = (cc) * 32 + st, t_ = s_ - 256; const int row = isctx_ ? (ML + b * 256 + (dir ? 255 - s_ : s_)) : (b * 4096 + (dir ? 4095 - t_ : t_)); \
        const int arr = q >> 3; const int so = arr == 0 ? srcoff[0] : arr == 1 ? srcoff[1] : arr == 2 ? srcoff[2] : arr == 3 ? srcoff[3] : arr == 4 ? srcoff[4] : srcoff[5]; \
        pre[i_] = *(const u32x4*)(PREP + (size_t)row * PRC + so + (q & 7) * 8); } } while (0)
#define RW_COMMIT(cc) do { _Pragma("unroll") for (int i_ = 0; i_ < 3; ++i_) { const int pp = tid + i_ * NTHREADS; if (pp < NPIECE) { const int st = pp / 44, q = pp % 44; \
        *(LAS u32x4*)(lds + ((cc) & 1) * BUFB + st * STEPB + q * 16) = pre[i_]; } } } while (0)
    RW_ISSUE(0); RW_COMMIT(0); RW_ISSUE(1);
    __syncthreads();
    for (int c = 0; c < NCHUNK; ++c) {
        if (expflag != 2) { if (c + 1 < NCHUNK) RW_COMMIT(c + 1);
        if (c + 2 < NCHUNK) RW_ISSUE(c + 2); }
        if (c > 0 && tid < 128) { const int cc = c - 1; const int st = tid >> 2, pc = tid & 3; const int row = chain_row(b, dir, cc * 32 + st);
            *(u32x4*)(OR + (size_t)row * 256 + h * 64 + half_ * 32 + pc * 8) = *(const LAS u32x4*)(obuf + (cc & 1) * 2048 + st * 64 + pc * 16); }
        if (expflag != 1) {
            const unsigned abase = lds_addr(lds + (c & 1) * BUFB) + kq * 8, vbase = lds_addr(lds + (c & 1) * BUFB) + 640 + rloc * 2;
            LAS hf* op = (LAS hf*)(obuf + (c & 1) * 2048 + rloc * 2);
            u32x2 LR[2], LK[2], LW[2], LB[2], LD[2]; unsigned LV[2]; const float zero = 0.f;
#define RW_LOAD(slot, o0, o1, o2, o3, o4) do { DSR64(LR[slot], abase, o0); DSR64(LK[slot], abase, o1); DSR64(LW[slot], abase, o2); DSR64(LB[slot], abase, o3); DSR64(LD[slot], abase, o4); } while (0)
#define RW_COMPUTE(cur, st) do { \
                const float vv = (float)__builtin_bit_cast(hf, (unsigned short)LV[cur]); \
                float sa0 = 0.f, sa1 = 0.f; \
                _Pragma("unroll") for (int i = 0; i < 2; ++i) { MIXLO(sa0, S[2 * i], LK[cur][i], sa0); MIXHI(sa1, S[2 * i + 1], LK[cur][i], sa1); } \
                const float nsa = reduce16(sa0 + sa1); \
                float o0 = 0.f, o1 = 0.f; \
                _Pragma("unroll") for (int i = 0; i < 2; ++i) { float u0, u1; \
                    MIXLO(u0, vv, LD[cur][i], zero); MIXHI(u1, vv, LD[cur][i], zero); \
                    MIXLO(u0, nsa, LB[cur][i], u0); MIXHI(u1, nsa, LB[cur][i], u1); \
                    MIXLO(S[2 * i], S[2 * i], LW[cur][i], u0); MIXHI(S[2 * i + 1], S[2 * i + 1], LW[cur][i], u1); \
                    MIXLO(o0, S[2 * i], LR[cur][i], o0); MIXHI(o1, S[2 * i + 1], LR[cur][i], o1); } \
                const float o = reduce16(o0 + o1); \
                op[(st) * 32] = (hf)o; } while (0)
#define RW_PIN(n, cur) asm volatile("s_waitcnt lgkmcnt(" #n ")" : "+v"(LR[cur]), "+v"(LK[cur]), "+v"(LW[cur]), "+v"(LB[cur]), "+v"(LD[cur]), "+v"(LV[cur]))
            RW_LOAD(0, 0, 128, 256, 384, 512); DSR16(LV[0], vbase, 0);
            RW_LOAD(1, 704, 832, 960, 1088, 1216); DSR16(LV[1], vbase, 704); RW_PIN(6, 0); RW_COMPUTE(0, 0);
            RW_LOAD(0, 1408, 1536, 1664, 1792, 1920); DSR16(LV[0], vbase, 1408); RW_PIN(6, 1); RW_COMPUTE(1, 1);
            RW_LOAD(1, 2112, 2240, 2368, 2496, 2624); DSR16(LV[1], vbase, 2112); RW_PIN(6, 0); RW_COMPUTE(0, 2);
            RW_LOAD(0, 2816, 2944, 3072, 3200, 3328); DSR16(LV[0], vbase, 2816); RW_PIN(6, 1); RW_COMPUTE(1, 3);
            RW_LOAD(1, 3520, 3648, 3776, 3904, 4032); DSR16(LV[1], vbase, 3520); RW_PIN(6, 0); RW_COMPUTE(0, 4);
            RW_LOAD(0, 4224, 4352, 4480, 4608, 4736); DSR16(LV[0], vbase, 4224); RW_PIN(6, 1); RW_COMPUTE(1, 5);
            RW_LOAD(1, 4928, 5056, 5184, 5312, 5440); DSR16(LV[1], vbase, 4928); RW_PIN(6, 0); RW_COMPUTE(0, 6);
            RW_LOAD(0, 5632, 5760, 5888, 6016, 6144); DSR16(LV[0], vbase, 5632); RW_PIN(6, 1); RW_COMPUTE(1, 7);
            RW_LOAD(1, 6336, 6464, 6592, 6720, 6848); DSR16(LV[1], vbase, 6336); RW_PIN(6, 0); RW_COMPUTE(0, 8);
            RW_LOAD(0, 7040, 7168, 7296, 7424, 7552); DSR16(LV[0], vbase, 7040); RW_PIN(6, 1); RW_COMPUTE(1, 9);
            RW_LOAD(1, 7744, 7872, 8000, 8128, 8256); DSR16(LV[1], vbase, 7744); RW_PIN(6, 0); RW_COMPUTE(0, 10);
            RW_LOAD(0, 8448, 8576, 8704, 8832, 8960); DSR16(LV[0], vbase, 8448); RW_PIN(6, 1); RW_COMPUTE(1, 11);
            RW_LOAD(1, 9152, 9280, 9408, 9536, 9664); DSR16(LV[1], vbase, 9152); RW_PIN(6, 0); RW_COMPUTE(0, 12);
            RW_LOAD(0, 9856, 9984, 10112, 10240, 10368); DSR16(LV[0], vbase, 9856); RW_PIN(6, 1); RW_COMPUTE(1, 13);
            RW_LOAD(1, 10560, 10688, 10816, 10944, 11072); DSR16(LV[1], vbase, 10560); RW_PIN(6, 0); RW_COMPUTE(0, 14);
            RW_LOAD(0, 11264, 11392, 11520, 11648, 11776); DSR16(LV[0], vbase, 11264); RW_PIN(6, 1); RW_COMPUTE(1, 15);
            RW_LOAD(1, 11968, 12096, 12224, 12352, 12480); DSR16(LV[1], vbase, 11968); RW_PIN(6, 0); RW_COMPUTE(0, 16);
            RW_LOAD(0, 12672, 12800, 12928, 13056, 13184); DSR16(LV[0], vbase, 12672); RW_PIN(6, 1); RW_COMPUTE(1, 17);
            RW_LOAD(1, 13376, 13504, 13632, 13760, 13888); DSR16(LV[1], vbase, 13376); RW_PIN(6, 0); RW_COMPUTE(0, 18);
            RW_LOAD(0, 14080, 14208, 14336, 14464, 14592); DSR16(LV[0], vbase, 14080); RW_PIN(6, 1); RW_COMPUTE(1, 19);
            RW_LOAD(1, 14784, 14912, 15040, 15168, 15296); DSR16(LV[1], vbase, 14784); RW_PIN(6, 0); RW_COMPUTE(0, 20);
            RW_LOAD(0, 15488, 15616, 15744, 15872, 16000); DSR16(LV[0], vbase, 15488); RW_PIN(6, 1); RW_COMPUTE(1, 21);
            RW_LOAD(1, 16192, 16320, 16448, 16576, 16704); DSR16(LV[1], vbase, 16192); RW_PIN(6, 0); RW_COMPUTE(0, 22);
            RW_LOAD(0, 16896, 17024, 17152, 17280, 17408); DSR16(LV[0], vbase, 16896); RW_PIN(6, 1); RW_COMPUTE(1, 23);
            RW_LOAD(1, 17600, 17728, 17856, 17984, 18112); DSR16(LV[1], vbase, 17600); RW_PIN(6, 0); RW_COMPUTE(0, 24);
            RW_LOAD(0, 18304, 18432, 18560, 18688, 18816); DSR16(LV[0], vbase, 18304); RW_PIN(6, 1); RW_COMPUTE(1, 25);
            RW_LOAD(1, 19008, 19136, 19264, 19392, 19520); DSR16(LV[1], vbase, 19008); RW_PIN(6, 0); RW_COMPUTE(0, 26);
            RW_LOAD(0, 19712, 19840, 19968, 20096, 20224); DSR16(LV[0], vbase, 19712); RW_PIN(6, 1); RW_COMPUTE(1, 27);
            RW_LOAD(1, 20416, 20544, 20672, 20800, 20928); DSR16(LV[1], vbase, 20416); RW_PIN(6, 0); RW_COMPUTE(0, 28);
            RW_LOAD(0, 21120, 21248, 21376, 21504, 21632); DSR16(LV[0], vbase, 21120); RW_PIN(6, 1); RW_COMPUTE(1, 29);
            RW_LOAD(1, 21824, 21952, 22080, 22208, 22336); DSR16(LV[1], vbase, 21824); RW_PIN(6, 0); RW_COMPUTE(0, 30);
            RW_PIN(0, 1); RW_COMPUTE(1, 31);
#undef RW_LOAD
#undef RW_COMPUTE
#undef RW_PIN
        }
        LDS_BAR();
    }
    { const int cc = NCHUNK - 1; if (tid < 128) { const int st = tid >> 2, pc = tid & 3; const int row = chain_row(b, dir, cc * 32 + st);
        *(u32x4*)(OR + (size_t)row * 256 + h * 64 + half_ * 32 + pc * 8) = *(const LAS u32x4*)(obuf + (cc & 1) * 2048 + st * 64 + pc * 16); } }
#undef RW_ISSUE
#undef RW_COMMIT
}
__device__ __forceinline__ void gla_scan_item(unsigned char* ldsg, kparams_t p, int item, int tid) {
    const int chain = item >> 1, half_ = item & 1;
    LAS unsigned char* lds = (LAS unsigned char*)ldsg;
    constexpr int STEPB = 320, BUFB = 32 * STEPB, NPIECE = 32 * 20;
    LAS unsigned char* obuf = lds + 2 * BUFB;
    const int b = chain >> 3, h = (chain >> 1) & 3, dir = chain & 1;
    const int lane = tid & 63, wave = tid >> 6, dq = lane & 7, col = half_ * 32 + (wave & 3) * 8 + (lane >> 3);
    const hf* PG = (const hf*)(p->ws + WS_PG); const bf16_t* P1 = (const bf16_t*)(p->ws + WS_P1); hf* OG = (hf*)(p->ws + WS_OG) + (size_t)dir * MT * 256;
    float S[4];
#pragma unroll
    for (int i = 0; i < 4; ++i) S[i] = 0.f;
    u32x4 pre[3]; const int t4 = tid - 256;
#define GL_ISSUE(cc) do { const bool isctx_ = (cc) < 8; _Pragma("unroll") for (int i_ = 0; i_ < 3; ++i_) { int pp = t4 + i_ * 256; pp = pp < NPIECE ? pp : pp - 256; const int st = pp / 20, q = pp % 20; \
        const int s_ = (cc) * 32 + st, t_ = s_ - 256; const int row = isctx_ ? (ML + b * 256 + (dir ? 255 - s_ : s_)) : (b * 4096 + (dir ? 4095 - t_ : t_)); \
        const int arr = q >> 2; const int so = arr == 0 ? h * 32 : arr == 1 ? 128 + h * 32 : 256 + dir * 128 + h * 32; \
        const unsigned char* sp = q < 12 ? (const unsigned char*)(PG + (size_t)row * PGC + so + (q & 3) * 8) : (const unsigned char*)(P1 + (size_t)row * P1C + 256 + h * 64 + (q - 12) * 8); \
        pre[i_] = *(const u32x4*)sp; } } while (0)
#define GL_COMMIT(cc) do { _Pragma("unroll") for (int i_ = 0; i_ < 3; ++i_) { const int pp = t4 + i_ * 256; if (pp < NPIECE) { const int st = pp / 20, q = pp % 20; \
        *(LAS u32x4*)(lds + ((cc) & 1) * BUFB + st * STEPB + q * 16) = pre[i_]; } } } while (0)
    if (wave >= 4) { GL_ISSUE(0); GL_COMMIT(0); GL_ISSUE(1); }
    __syncthreads();
    for (int c = 0; c < NCHUNK; ++c) {
        if (wave >= 4) {
            if (c + 1 < NCHUNK) GL_COMMIT(c + 1);
            if (c + 2 < NCHUNK) GL_ISSUE(c + 2);
            if (c > 0 && t4 < 128) { const int cc = c - 1; const int st = t4 >> 2, pc = t4 & 3; const int row = chain_row(b, dir, cc * 32 + st);
                *(u32x4*)(OG + (size_t)row * 256 + h * 64 + half_ * 32 + pc * 8) = *(const LAS u32x4*)(obuf + (cc & 1) * 4096 + st * 128 + half_ * 64 + pc * 16); }
        }
        if (wave < 4) {
            const unsigned abase = lds_addr(lds + (c & 1) * BUFB) + dq * 8, vbase = lds_addr(lds + (c & 1) * BUFB) + 192 + col * 2;
            LAS hf* op = (LAS hf*)(obuf + (c & 1) * 4096 + col * 2);
            u32x2 LQ[2], LK[2], LE[2]; unsigned LV[2]; const float zero = 0.f;
#define GL_LOAD(slot, o0, o1, o2) do { DSR64(LQ[slot], abase, o0); DSR64(LK[slot], abase, o1); DSR64(LE[slot], abase, o2); } while (0)
#define GL_COMPUTE(cur, st) do { \
                const float vv = __uint_as_float(LV[cur] << 16); \
                float o0 = 0.f, o1 = 0.f; \
                _Pragma("unroll") for (int i = 0; i < 2; ++i) { float u0, u1; \
                    MIXLO(u0, vv, LK[cur][i], zero); MIXHI(u1, vv, LK[cur][i], zero); \
                    MIXLO(S[2 * i], S[2 * i], LE[cur][i], u0); MIXHI(S[2 * i + 1], S[2 * i + 1], LE[cur][i], u1); \
                    MIXLO(o0, S[2 * i], LQ[cur][i], o0); MIXHI(o1, S[2 * i + 1], LQ[cur][i], o1); } \
                const float o = reduce8(o0 + o1); \
                op[(st) * 64] = (hf)o; } while (0)
#define GL_PIN(n, cur) asm volatile("s_waitcnt lgkmcnt(" #n ")" : "+v"(LQ[cur]), "+v"(LK[cur]), "+v"(LE[cur]), "+v"(LV[cur]))
            GL_LOAD(0, 0, 64, 128); DSR16(LV[0], vbase, 0);
            GL_LOAD(1, 320, 384, 448); DSR16(LV[1], vbase, 320); GL_PIN(4, 0); GL_COMPUTE(0, 0);
            GL_LOAD(0, 640, 704, 768); DSR16(LV[0], vbase, 640); GL_PIN(4, 1); GL_COMPUTE(1, 1);
            GL_LOAD(1, 960, 1024, 1088); DSR16(LV[1], vbase, 960); GL_PIN(4, 0); GL_COMPUTE(0, 2);
            GL_LOAD(0, 1280, 1344, 1408); DSR16(LV[0], vbase, 1280); GL_PIN(4, 1); GL_COMPUTE(1, 3);
            GL_LOAD(1, 1600, 1664, 1728); DSR16(LV[1], vbase, 1600); GL_PIN(4, 0); GL_COMPUTE(0, 4);
            GL_LOAD(0, 1920, 1984, 2048); DSR16(LV[0], vbase, 1920); GL_PIN(4, 1); GL_COMPUTE(1, 5);
            GL_LOAD(1, 2240, 2304, 2368); DSR16(LV[1], vbase, 2240); GL_PIN(4, 0); GL_COMPUTE(0, 6);
            GL_LOAD(0, 2560, 2624, 2688); DSR16(LV[0], vbase, 2560); GL_PIN(4, 1); GL_COMPUTE(1, 7);
            GL_LOAD(1, 2880, 2944, 3008); DSR16(LV[1], vbase, 2880); GL_PIN(4, 0); GL_COMPUTE(0, 8);
            GL_LOAD(0, 3200, 3264, 3328); DSR16(LV[0], vbase, 3200); GL_PIN(4, 1); GL_COMPUTE(1, 9);
            GL_LOAD(1, 3520, 3584, 3648); DSR16(LV[1], vbase, 3520); GL_PIN(4, 0); GL_COMPUTE(0, 10);
            GL_LOAD(0, 3840, 3904, 3968); DSR16(LV[0], vbase, 3840); GL_PIN(4, 1); GL_COMPUTE(1, 11);
            GL_LOAD(1, 4160, 4224, 4288); DSR16(LV[1], vbase, 4160); GL_PIN(4, 0); GL_COMPUTE(0, 12);
            GL_LOAD(0, 4480, 4544, 4608); DSR16(LV[0], vbase, 4480); GL_PIN(4, 1); GL_COMPUTE(1, 13);
            GL_LOAD(1, 4800, 4864, 4928); DSR16(LV[1], vbase, 4800); GL_PIN(4, 0); GL_COMPUTE(0, 14);
            GL_LOAD(0, 5120, 5184, 5248); DSR16(LV[0], vbase, 5120); GL_PIN(4, 1); GL_COMPUTE(1, 15);
            GL_LOAD(1, 5440, 5504, 5568); DSR16(LV[1], vbase, 5440); GL_PIN(4, 0); GL_COMPUTE(0, 16);
            GL_LOAD(0, 5760, 5824, 5888); DSR16(LV[0], vbase, 5760); GL_PIN(4, 1); GL_COMPUTE(1, 17);
            GL_LOAD(1, 6080, 6144, 6208); DSR16(LV[1], vbase, 6080); GL_PIN(4, 0); GL_COMPUTE(0, 18);
            GL_LOAD(0, 6400, 6464, 6528); DSR16(LV[0], vbase, 6400); GL_PIN(4, 1); GL_COMPUTE(1, 19);
            GL_LOAD(1, 6720, 6784, 6848); DSR16(LV[1], vbase, 6720); GL_PIN(4, 0); GL_COMPUTE(0, 20);
            GL_LOAD(0, 7040, 7104, 7168); DSR16(LV[0], vbase, 7040); GL_PIN(4, 1); GL_COMPUTE(1, 21);
            GL_LOAD(1, 7360, 7424, 7488); DSR16(LV[1], vbase, 7360); GL_PIN(4, 0); GL_COMPUTE(0, 22);
            GL_LOAD(0, 7680, 7744, 7808); DSR16(LV[0], vbase, 7680); GL_PIN(4, 1); GL_COMPUTE(1, 23);
            GL_LOAD(1, 8000, 8064, 8128); DSR16(LV[1], vbase, 8000); GL_PIN(4, 0); GL_COMPUTE(0, 24);
            GL_LOAD(0, 8320, 8384, 8448); DSR16(LV[0], vbase, 8320); GL_PIN(4, 1); GL_COMPUTE(1, 25);
            GL_LOAD(1, 8640, 8704, 8768); DSR16(LV[1], vbase, 8640); GL_PIN(4, 0); GL_COMPUTE(0, 26);
            GL_LOAD(0, 8960, 9024, 9088); DSR16(LV[0], vbase, 8960); GL_PIN(4, 1); GL_COMPUTE(1, 27);
            GL_LOAD(1, 9280, 9344, 9408); DSR16(LV[1], vbase, 9280); GL_PIN(4, 0); GL_COMPUTE(0, 28);
            GL_LOAD(0, 9600, 9664, 9728); DSR16(LV[0], vbase, 9600); GL_PIN(4, 1); GL_COMPUTE(1, 29);
            GL_LOAD(1, 9920, 9984, 10048); DSR16(LV[1], vbase, 9920); GL_PIN(4, 0); GL_COMPUTE(0, 30);
            GL_PIN(0, 1); GL_COMPUTE(1, 31);
#undef GL_LOAD
#undef GL_COMPUTE
#undef GL_PIN
        }
        LDS_BAR();
    }
    if (t4 >= 0 && t4 < 128) { const int cc = NCHUNK - 1; const int st = t4 >> 2, pc = t4 & 3; const int row = chain_row(b, dir, cc * 32 + st);
        *(u32x4*)(OG + (size_t)row * 256 + h * 64 + half_ * 32 + pc * 8) = *(const LAS u32x4*)(obuf + (cc & 1) * 4096 + st * 128 + half_ * 64 + pc * 16); }
#undef GL_ISSUE
#undef GL_COMMIT
}
__device__ __forceinline__ bf16x8 mk_op(unsigned a, unsigned b, unsigned c, unsigned d) { const u32x4 t = {a, b, c, d}; return __builtin_bit_cast(bf16x8, t); }
__device__ __forceinline__ void ck_p1_step(const LAS unsigned char* in, LAS unsigned char* KKI, LAS unsigned char* BTI, LAS unsigned char* KDI, LAS unsigned char* RTI, LAS unsigned char* AUP, LAS unsigned char* VTI,
                                           int k, int t, float gprev, float gt, float gC) {
    const float inv = __builtin_amdgcn_rcpf(gt);
    const LAS unsigned char* sp = in + t * 768 + k * 2;
    const float r = (float)*(const LAS hf*)sp, kk = (float)*(const LAS hf*)(sp + 128), nb = (float)*(const LAS hf*)(sp + 384), kd = (float)*(const LAS hf*)(sp + 512), vv = (float)*(const LAS hf*)(sp + 640);
    const float nbi = nb * inv, kdi = kd * inv;
    const unsigned pa = cvtpk(kk * gprev, nbi), pb = cvtpk(kdi, r * gt), pc = cvtpk(nbi * gC, kdi * gC), pd = cvtpk(vv, vv);
    *(LAS unsigned short*)(KKI + t * 144 + k * 2) = (unsigned short)(pa & 0xffffu); *(LAS unsigned short*)(BTI + t * 144 + k * 2) = (unsigned short)(pa >> 16);
    *(LAS unsigned short*)(KDI + t * 144 + k * 2) = (unsigned short)(pb & 0xffffu); *(LAS unsigned short*)(RTI + t * 144 + k * 2) = (unsigned short)(pb >> 16);
    const int slot = (t >> 2) * 8 + (t & 3);
    *(LAS unsigned short*)(AUP + k * 80 + slot * 2) = (unsigned short)(pc & 0xffffu); *(LAS unsigned short*)(AUP + k * 80 + (slot + 4) * 2) = (unsigned short)(pc >> 16);
    *(LAS unsigned short*)(VTI + k * 32 + t * 2) = (unsigned short)(pd & 0xffffu);
}
__device__ __forceinline__ void rwkv_chunk_item(unsigned char* ldsg, kparams_t p, int chain, int tid, int expflag) {
    (void)expflag;
    LAS unsigned char* lds = (LAS unsigned char*)ldsg;
    constexpr int INB = 16 * 768, NPIECE = 16 * 48, NCH = (SEQ + CTXL) / 16, IMGB = 16640;
    LAS unsigned char* IMG0 = lds + 3 * INB;
    LAS unsigned char* NI = IMG0 + 2 * IMGB;
    LAS unsigned char* MMI = NI + 4096;
    LAS unsigned char* AOI = MMI + 512;
    LAS unsigned char* OBI = AOI + 1024;
    const int b = chain >> 3, h = (chain >> 1) & 3, dir = chain & 1;
    const int lane = tid & 63, wave = __builtin_amdgcn_readfirstlane(tid >> 6), fr = lane & 15, quad = lane >> 4;
    const hf* PREP = (const hf*)(p->ws + WS_PREP); hf* OR = (hf*)(p->ws + WS_OR) + (size_t)dir * MT * 256;
    const int so0 = h * 64, so1 = 256 + h * 64, so2 = 768 + dir * 768 + h * 64, so5 = 512 + h * 64;
    u32x4 pre[2];
    const int pp0_ = tid, pp1_ = tid < 256 ? tid + 512 : tid;
    const int st0_ = pp0_ / 48, q0_ = pp0_ % 48, st1_ = pp1_ / 48, q1_ = pp1_ % 48;
    const int ar0_ = q0_ >> 3, ar1_ = q1_ >> 3;
    const int sof0_ = (ar0_ == 0 ? so0 : ar0_ == 1 ? so1 : ar0_ == 2 ? so2 : ar0_ == 3 ? so2 + 256 : ar0_ == 4 ? so2 + 512 : so5) + (q0_ & 7) * 8;
    const int sof1_ = (ar1_ == 0 ? so0 : ar1_ == 1 ? so1 : ar1_ == 2 ? so2 : ar1_ == 3 ? so2 + 256 : ar1_ == 4 ? so2 + 512 : so5) + (q1_ & 7) * 8;
    const hf* pl0_ = PREP + (size_t)(b * 4096 + (dir ? 4095 - st0_ : st0_)) * PRC + sof0_;
    const hf* pl1_ = PREP + (size_t)(b * 4096 + (dir ? 4095 - st1_ : st1_)) * PRC + sof1_;
    const hf* cur0_ = PREP + (size_t)(ML + b * 256 + (dir ? 255 - st0_ : st0_)) * PRC + sof0_;
    const hf* cur1_ = PREP + (size_t)(ML + b * 256 + (dir ? 255 - st1_ : st1_)) * PRC + sof1_;
    const ptrdiff_t stepH_ = (ptrdiff_t)(dir ? -16 : 16) * PRC;
    const int lo0_ = st0_ * 768 + q0_ * 16, lo1_ = st1_ * 768 + q1_ * 16;
    int icc_ = 0, cbuf_ = 0, wcc_ = 0;
    const int wst_ = (tid & 127) >> 3, wpc_ = tid & 7;
    hf* wcur_ = OR + (size_t)(ML + b * 256 + (dir ? 255 - wst_ : wst_)) * 256 + h * 64 + wpc_ * 8;
    hf* wlat_ = OR + (size_t)(b * 4096 + (dir ? 4095 - wst_ : wst_)) * 256 + h * 64 + wpc_ * 8;
    const ptrdiff_t wstep_ = (ptrdiff_t)(dir ? -16 : 16) * 256;
#define CK_ISSUE(cc) do { if (icc_ == 16) { cur0_ = pl0_; cur1_ = pl1_; } pre[0] = *(const u32x4*)cur0_; pre[1] = *(const u32x4*)cur1_; cur0_ += stepH_; cur1_ += stepH_; ++icc_; } while (0)
#define CK_COMMIT(cc) do { *(LAS u32x4*)(lds + cbuf_ + lo0_) = pre[0]; if (tid < 256) *(LAS u32x4*)(lds + cbuf_ + lo1_) = pre[1]; cbuf_ = (cbuf_ == 2 * INB) ? 0 : cbuf_ + INB; } while (0)
#define CK_WRITEOUT(cc) do { if (wcc_ == 16) wcur_ = wlat_; if (tid < 128) *(u32x4*)wcur_ = *(const LAS u32x4*)(OBI + ((cc) & 1) * 2048 + wst_ * 128 + wpc_ * 16); wcur_ += wstep_; ++wcc_; } while (0)
    float gq0 = 1.f, gq1 = 1.f, gq2 = 1.f, gq3 = 1.f, gq4 = 1.f, gqC = 1.f;
#define CK_P1A(cc) do { const LAS unsigned char* in_ = lds + ((cc) % 3) * INB; LAS unsigned char* im_ = IMG0 + ((cc) & 1) * IMGB; const int wv_ = wave - 4, tb_ = wv_ * 4; \
        float w_[16]; _Pragma("unroll") for (int i_ = 0; i_ < 16; ++i_) w_[i_] = (float)*(const LAS hf*)(in_ + i_ * 768 + 256 + lane * 2); \
        const float G0_ = (w_[0] * w_[1]) * (w_[2] * w_[3]), G1_ = (w_[4] * w_[5]) * (w_[6] * w_[7]), G2_ = (w_[8] * w_[9]) * (w_[10] * w_[11]), G3_ = (w_[12] * w_[13]) * (w_[14] * w_[15]); \
        const float pfx_ = (wv_ > 0 ? G0_ : 1.f) * ((wv_ > 1 ? G1_ : 1.f) * (wv_ > 2 ? G2_ : 1.f)); \
        const float sfx_ = (wv_ < 3 ? G3_ : 1.f) * ((wv_ < 2 ? G2_ : 1.f) * (wv_ < 1 ? G1_ : 1.f)); \
        const LAS unsigned char* ow_ = in_ + tb_ * 768 + 256 + lane * 2; \
        const float o0_ = (float)*(const LAS hf*)ow_, o1_ = (float)*(const LAS hf*)(ow_ + 768), o2_ = (float)*(const LAS hf*)(ow_ + 1536), o3_ = (float)*(const LAS hf*)(ow_ + 2304); \
        gq0 = pfx_; gq1 = gq0 * o0_; gq2 = gq1 * o1_; gq3 = gq2 * o2_; gq4 = gq3 * o3_; gqC = gq4 * sfx_; \
        if (wave == 4) *(LAS float*)(im_ + 14336 + lane * 4) = gqC; \
        ck_p1_step(in_, im_, im_ + 2304, im_ + 4608, im_ + 6912, im_ + 9216, im_ + 14592, lane, tb_, gq0, gq1, gqC); \
        ck_p1_step(in_, im_, im_ + 2304, im_ + 4608, im_ + 6912, im_ + 9216, im_ + 14592, lane, tb_ + 1, gq1, gq2, gqC);  } while (0)
#define CK_P1B(cc) do { const LAS unsigned char* in_ = lds + ((cc) % 3) * INB; LAS unsigned char* im_ = IMG0 + ((cc) & 1) * IMGB; const int tb_ = (wave - 4) * 4; \
        ck_p1_step(in_, im_, im_ + 2304, im_ + 4608, im_ + 6912, im_ + 9216, im_ + 14592, lane, tb_ + 2, gq2, gq3, gqC); \
        ck_p1_step(in_, im_, im_ + 2304, im_ + 4608, im_ + 6912, im_ + 9216, im_ + 14592, lane, tb_ + 3, gq3, gq4, gqC); } while (0)
    f32x4 St[4];
#pragma unroll
    for (int i = 0; i < 4; ++i) St[i] = (f32x4){0.f, 0.f, 0.f, 0.f};
    CK_ISSUE(0); CK_COMMIT(0); CK_ISSUE(1); CK_COMMIT(1); CK_ISSUE(2);
    __syncthreads();
    if (wave >= 4) { CK_P1A(0); CK_P1B(0); }
    LDS_BAR();
#pragma unroll 1
    for (int c = 0; c < NCH; ++c) {
        LAS unsigned char* im = IMG0 + (c & 1) * IMGB;
        LAS unsigned char* KKI = im; LAS unsigned char* BTI = im + 2304; LAS unsigned char* KDI = im + 4608; LAS unsigned char* RTI = im + 6912; LAS unsigned char* AUP = im + 9216;
        LAS float* GC = (LAS float*)(im + 14336); LAS unsigned char* VTI = im + 14592;
        if (c + 2 < NCH) CK_COMMIT(c + 2);
        if (c + 3 < NCH) CK_ISSUE(c + 3);
        if (c > 0) CK_WRITEOUT(c - 1);
        if (wave >= 4) { if (c + 1 < NCH) CK_P1A(c + 1); }
        f32x4 accN = (f32x4){0.f, 0.f, 0.f, 0.f}, accNT = (f32x4){0.f, 0.f, 0.f, 0.f};
        if (wave < 4) {
            const LAS unsigned char* X = (wave < 2) ? KKI : RTI; const LAS unsigned char* Y = (wave & 1) ? KDI : BTI;
            f32x4 acc = (f32x4){0.f, 0.f, 0.f, 0.f};
#pragma unroll
            for (int ks = 0; ks < 2; ++ks) { const bf16x8 a = *(const LAS bf16x8*)(X + fr * 144 + (ks * 32 + quad * 8) * 2), bb = *(const LAS bf16x8*)(Y + fr * 144 + (ks * 32 + quad * 8) * 2);
                acc = __builtin_amdgcn_mfma_f32_16x16x32_bf16(a, bb, acc, 0, 0, 0);
                if (wave == 0) accNT = __builtin_amdgcn_mfma_f32_16x16x32_bf16(bb, a, accNT, 0, 0, 0); }
            accN = acc;
#pragma unroll
            for (int j = 0; j < 4; ++j) { const int t = quad * 4 + j, i = fr;
                if (wave == 0) { }
                else if (wave == 1) *(LAS unsigned short*)(MMI + (t * 16 + i) * 2) = (unsigned short)f2bf((i < t) ? acc[j] : 0.f);
                else { const int slot = (i >> 2) * 8 + (i & 3) + (wave == 3 ? 4 : 0); *(LAS unsigned short*)(AOI + (t * 32 + slot) * 2) = (unsigned short)f2bf((i <= t) ? acc[j] : 0.f); } }
        }
        if (wave == 0) {
            f32x4 nv, nT;
#pragma unroll
            for (int j = 0; j < 4; ++j) { nv[j] = (fr < quad * 4 + j) ? accN[j] : 0.f;
                                          nT[j] = (quad * 4 + j < fr) ? accNT[j] : 0.f; }
#pragma unroll
            for (int lv = 0; lv < 4; ++lv) {
                const unsigned n01 = cvtpk(nv[0], nv[1]), n23 = cvtpk(nv[2], nv[3]), t01 = cvtpk(nT[0], nT[1]), t23 = cvtpk(nT[2], nT[3]);
                const u32x2 rowv = {t01, t23};
                *(LAS u32x2*)(NI + lv * 1024 + (fr * 16 + quad * 4) * 2) = rowv;
                if (lv < 3) {
                    const f32x4 zf = {0.f, 0.f, 0.f, 0.f};
                    const bf16x8 opN = mk_op(n01, n23, 0u, 0u), opT = mk_op(t01, t23, 0u, 0u);
                    nv = __builtin_amdgcn_mfma_f32_16x16x32_bf16(opT, opN, zf, 0, 0, 0);
                    nT = __builtin_amdgcn_mfma_f32_16x16x32_bf16(opN, opT, zf, 0, 0, 0);
                }
            }
        }
        LDS_BAR();
        if (wave >= 4) { if (c + 1 < NCH) CK_P1B(c + 1); }
        if (wave < 4) {
            const int vrow = wave * 16 + fr;
            bf16x8 Sb[2], KKa[2], RTa[2];
#pragma unroll
            for (int p2 = 0; p2 < 2; ++p2) {
                Sb[p2] = mk_op(cvtpk(St[2 * p2][0], St[2 * p2][1]), cvtpk(St[2 * p2][2], St[2 * p2][3]), cvtpk(St[2 * p2 + 1][0], St[2 * p2 + 1][1]), cvtpk(St[2 * p2 + 1][2], St[2 * p2 + 1][3]));
                const u32x2 a0 = *(const LAS u32x2*)(KKI + fr * 144 + ((2 * p2) * 16 + quad * 4) * 2), a1 = *(const LAS u32x2*)(KKI + fr * 144 + ((2 * p2 + 1) * 16 + quad * 4) * 2);
                KKa[p2] = mk_op(a0.x, a0.y, a1.x, a1.y);
                const u32x2 r0 = *(const LAS u32x2*)(RTI + fr * 144 + ((2 * p2) * 16 + quad * 4) * 2), r1 = *(const LAS u32x2*)(RTI + fr * 144 + ((2 * p2 + 1) * 16 + quad * 4) * 2);
                RTa[p2] = mk_op(r0.x, r0.y, r1.x, r1.y);
            }
            const f32x4 zf = {0.f, 0.f, 0.f, 0.f};
            f32x4 rhs = __builtin_amdgcn_mfma_f32_16x16x32_bf16(KKa[0], Sb[0], zf, 0, 0, 0); rhs = __builtin_amdgcn_mfma_f32_16x16x32_bf16(KKa[1], Sb[1], rhs, 0, 0, 0);
            const u32x2 vt = *(const LAS u32x2*)(VTI + vrow * 32 + quad * 8), mm = *(const LAS u32x2*)(MMI + fr * 32 + quad * 8);
            rhs = __builtin_amdgcn_mfma_f32_16x16x32_bf16(mk_op(mm.x, mm.y, 0u, 0u), mk_op(vt.x, vt.y, 0u, 0u), rhs, 0, 0, 0);
            f32x4 ut = rhs;
#pragma unroll
            for (int lv = 3; lv >= 0; --lv) { const u32x2 na = *(const LAS u32x2*)(NI + lv * 1024 + (fr * 16 + quad * 4) * 2);
                ut = __builtin_amdgcn_mfma_f32_16x16x32_bf16(mk_op(na.x, na.y, 0u, 0u), mk_op(cvtpk(ut[0], ut[1]), cvtpk(ut[2], ut[3]), 0u, 0u), ut, 0, 0, 0); }
            const bf16x8 UVb = mk_op(cvtpk(ut[0], ut[1]), cvtpk(ut[2], ut[3]), vt.x, vt.y);
            f32x4 ot = __builtin_amdgcn_mfma_f32_16x16x32_bf16(RTa[0], Sb[0], zf, 0, 0, 0); ot = __builtin_amdgcn_mfma_f32_16x16x32_bf16(RTa[1], Sb[1], ot, 0, 0, 0);
            ot = __builtin_amdgcn_mfma_f32_16x16x32_bf16(*(const LAS bf16x8*)(AOI + fr * 64 + quad * 16), UVb, ot, 0, 0, 0);
#pragma unroll
            for (int j = 0; j < 4; ++j) *(LAS hf*)(OBI + (c & 1) * 2048 + ((quad * 4 + j) * 64 + vrow) * 2) = (hf)ot[j];
#pragma unroll
            for (int kt = 0; kt < 4; ++kt) { const f32x4 gc = *(const LAS f32x4*)(GC + kt * 16 + quad * 4);
                St[kt] = __builtin_amdgcn_mfma_f32_16x16x32_bf16(*(const LAS bf16x8*)(AUP + (kt * 16 + fr) * 80 + quad * 16), UVb, St[kt] * gc, 0, 0, 0); }
        }
        LDS_BAR();
    }
    CK_WRITEOUT(NCH - 1);
#undef CK_ISSUE
#undef CK_COMMIT
#undef CK_WRITEOUT
#undef CK_P1A
#undef CK_P1B
}
__device__ __forceinline__ void gla_chunk_item(unsigned char* ldsg, kparams_t p, int chain, int tid) {
    LAS unsigned char* lds = (LAS unsigned char*)ldsg;
    constexpr int INB = 16 * 320, NCH = (SEQ + CTXL) / 16, IMGB = 6400;
    LAS unsigned char* IMG0 = lds + 3 * INB;
    LAS unsigned char* QKI = IMG0 + 2 * IMGB;
    LAS unsigned char* OBI = QKI + 512;
    const int b = chain >> 3, h = (chain >> 1) & 3, dir = chain & 1;
    const int lane = tid & 63, wave = __builtin_amdgcn_readfirstlane(tid >> 6), fr = lane & 15, quad = lane >> 4;
    const hf* PG = (const hf*)(p->ws + WS_PG); const bf16_t* P1 = (const bf16_t*)(p->ws + WS_P1); hf* OG = (hf*)(p->ws + WS_OG) + (size_t)dir * MT * 256;
    const int pp_ = tid < 320 ? tid : 0, st_ = pp_ / 20, q_ = pp_ % 20;
    const size_t crow_ = (size_t)(ML + b * 256 + (dir ? 255 - st_ : st_)), lrow_ = (size_t)(b * 4096 + (dir ? 4095 - st_ : st_));
    const int ar_ = q_ >> 2, sog_ = (ar_ == 0 ? h * 32 : ar_ == 1 ? 128 + h * 32 : 256 + dir * 128 + h * 32) + (q_ & 3) * 8;
    const unsigned char* cur_ = q_ < 12 ? (const unsigned char*)(PG + crow_ * PGC + sog_) : (const unsigned char*)(P1 + crow_ * P1C + 256 + h * 64 + (q_ - 12) * 8);
    const unsigned char* lat_ = q_ < 12 ? (const unsigned char*)(PG + lrow_ * PGC + sog_) : (const unsigned char*)(P1 + lrow_ * P1C + 256 + h * 64 + (q_ - 12) * 8);
    const ptrdiff_t stepB_ = (ptrdiff_t)(dir ? -16 : 16) * (q_ < 12 ? PGC * 2 : P1C * 2);
    const int lo_ = st_ * 320 + q_ * 16;
    int icc_ = 0, cbuf_ = 0, wcc_ = 0;
    const int wst_ = (tid & 127) >> 3, wpc_ = tid & 7;
    hf* wcur_ = OG + (size_t)(ML + b * 256 + (dir ? 255 - wst_ : wst_)) * 256 + h * 64 + wpc_ * 8;
    hf* wlat_ = OG + (size_t)(b * 4096 + (dir ? 4095 - wst_ : wst_)) * 256 + h * 64 + wpc_ * 8;
    const ptrdiff_t wstep_ = (ptrdiff_t)(dir ? -16 : 16) * 256;
    u32x4 pre;
#define GK_ISSUE() do { if (icc_ == 16) cur_ = lat_; pre = *(const u32x4*)cur_; cur_ += stepB_; ++icc_; } while (0)
#define GK_COMMIT() do { if (tid < 320) *(LAS u32x4*)(lds + cbuf_ + lo_) = pre; cbuf_ = (cbuf_ == 2 * INB) ? 0 : cbuf_ + INB; } while (0)
#define GK_WRITEOUT(cc) do { if (wcc_ == 16) wcur_ = wlat_; if (tid < 128) *(u32x4*)wcur_ = *(const LAS u32x4*)(OBI + ((cc) & 1) * 2048 + wst_ * 128 + wpc_ * 16); wcur_ += wstep_; ++wcc_; } while (0)
#define GK_P1(cc) do { const LAS unsigned char* in_ = lds + ((cc) % 3) * INB; LAS unsigned char* im_ = IMG0 + ((cc) & 1) * IMGB; \
        const int k_ = lane & 31, go_ = (wave - 4) * 2 + (lane >> 5), t0_ = go_ * 2; \
        float e_[16]; _Pragma("unroll") for (int i_ = 0; i_ < 16; ++i_) e_[i_] = (float)*(const LAS hf*)(in_ + i_ * 320 + 128 + k_ * 2); \
        float pfx_ = 1.f, sfx_ = 1.f; _Pragma("unroll") for (int g_ = 0; g_ < 8; ++g_) { const float H_ = e_[2 * g_] * e_[2 * g_ + 1]; pfx_ *= (g_ < go_) ? H_ : 1.f; sfx_ *= (g_ > go_) ? H_ : 1.f; } \
        const float ea_ = (float)*(const LAS hf*)(in_ + t0_ * 320 + 128 + k_ * 2), eb_ = (float)*(const LAS hf*)(in_ + (t0_ + 1) * 320 + 128 + k_ * 2); \
        const float ga_ = pfx_ * ea_, gb_ = ga_ * eb_, gC_ = gb_ * sfx_; \
        if (go_ == 0) *(LAS float*)(im_ + 3584 + k_ * 4) = gC_; \
        _Pragma("unroll") for (int e2_ = 0; e2_ < 2; ++e2_) { const int t_ = t0_ + e2_; const float gt_ = e2_ == 0 ? ga_ : gb_; const float inv_ = __builtin_amdgcn_rcpf(gt_); \
            const float qv_ = (float)*(const LAS hf*)(in_ + t_ * 320 + k_ * 2), kv_ = (float)*(const LAS hf*)(in_ + t_ * 320 + 64 + k_ * 2); \
            const unsigned pa_ = cvtpk(qv_ * gt_, kv_ * inv_), pb_ = cvtpk(kv_ * inv_ * gC_, 0.f); \
            *(LAS unsigned short*)(im_ + t_ * 80 + k_ * 2) = (unsigned short)(pa_ & 0xffffu); *(LAS unsigned short*)(im_ + 1280 + t_ * 80 + k_ * 2) = (unsigned short)(pa_ >> 16); \
            *(LAS unsigned short*)(im_ + 2560 + k_ * 32 + t_ * 2) = (unsigned short)(pb_ & 0xffffu); \
              \
            *(LAS unsigned short*)(im_ + 3712 + k_ * 32 + t_ * 2) = *(const LAS unsigned short*)(in_ + t_ * 320 + 192 + k_ * 2); \
            *(LAS unsigned short*)(im_ + 3712 + (k_ + 32) * 32 + t_ * 2) = *(const LAS unsigned short*)(in_ + t_ * 320 + 192 + (k_ + 32) * 2); } } while (0)
    f32x4 St[2];
    St[0] = (f32x4){0.f, 0.f, 0.f, 0.f}; St[1] = St[0];
    GK_ISSUE(); GK_COMMIT(); GK_ISSUE(); GK_COMMIT(); GK_ISSUE();
    __syncthreads();
    if (wave >= 4) GK_P1(0);
    LDS_BAR();
#pragma unroll 1
    for (int c = 0; c < NCH; ++c) {
        LAS unsigned char* im = IMG0 + (c & 1) * IMGB;
        const LAS unsigned char* QI = im; const LAS unsigned char* KI = im + 1280; const LAS unsigned char* AUPG = im + 2560; const LAS float* GC = (const LAS float*)(im + 3584); const LAS unsigned char* VTI = im + 3712;
        if (c + 2 < NCH) GK_COMMIT();
        if (c + 3 < NCH) GK_ISSUE();
        if (c > 0) GK_WRITEOUT(c - 1);
        if (wave >= 4) { if (c + 1 < NCH) GK_P1(c + 1); }
        if (wave == 0) {
            const bf16x8 a = *(const LAS bf16x8*)(QI + fr * 80 + quad * 16), bb = *(const LAS bf16x8*)(KI + fr * 80 + quad * 16);
            const f32x4 zf = {0.f, 0.f, 0.f, 0.f};
            const f32x4 acc = __builtin_amdgcn_mfma_f32_16x16x32_bf16(a, bb, zf, 0, 0, 0);
            const unsigned p01 = cvtpk((fr <= quad * 4 + 0) ? acc[0] : 0.f, (fr <= quad * 4 + 1) ? acc[1] : 0.f), p23 = cvtpk((fr <= quad * 4 + 2) ? acc[2] : 0.f, (fr <= quad * 4 + 3) ? acc[3] : 0.f);
            *(LAS unsigned short*)(QKI + ((quad * 4 + 0) * 16 + fr) * 2) = (unsigned short)(p01 & 0xffffu); *(LAS unsigned short*)(QKI + ((quad * 4 + 1) * 16 + fr) * 2) = (unsigned short)(p01 >> 16);
            *(LAS unsigned short*)(QKI + ((quad * 4 + 2) * 16 + fr) * 2) = (unsigned short)(p23 & 0xffffu); *(LAS unsigned short*)(QKI + ((quad * 4 + 3) * 16 + fr) * 2) = (unsigned short)(p23 >> 16);
        }
        LDS_BAR();
        if (wave < 4) {
            const int vrow = wave * 16 + fr;
            const bf16x8 Sb = mk_op(cvtpk(St[0][0], St[0][1]), cvtpk(St[0][2], St[0][3]), cvtpk(St[1][0], St[1][1]), cvtpk(St[1][2], St[1][3]));
            const u32x2 q0 = *(const LAS u32x2*)(QI + fr * 80 + (quad * 4) * 2), q1 = *(const LAS u32x2*)(QI + fr * 80 + (16 + quad * 4) * 2);
            const u32x2 vt = *(const LAS u32x2*)(VTI + vrow * 32 + quad * 8), qk = *(const LAS u32x2*)(QKI + fr * 32 + quad * 8);
            const bf16x8 Vb = mk_op(vt.x, vt.y, 0u, 0u);
            const f32x4 zf = {0.f, 0.f, 0.f, 0.f};
            f32x4 ot = __builtin_amdgcn_mfma_f32_16x16x32_bf16(mk_op(q0.x, q0.y, q1.x, q1.y), Sb, zf, 0, 0, 0);
            ot = __builtin_amdgcn_mfma_f32_16x16x32_bf16(mk_op(qk.x, qk.y, 0u, 0u), Vb, ot, 0, 0, 0);
#pragma unroll
            for (int j = 0; j < 4; ++j) *(LAS hf*)(OBI + (c & 1) * 2048 + ((quad * 4 + j) * 64 + vrow) * 2) = (hf)ot[j];
#pragma unroll
            for (int kt = 0; kt < 2; ++kt) { const f32x4 gc = *(const LAS f32x4*)(GC + kt * 16 + quad * 4); const u32x2 au = *(const LAS u32x2*)(AUPG + (kt * 16 + fr) * 32 + quad * 8);
                St[kt] = __builtin_amdgcn_mfma_f32_16x16x32_bf16(mk_op(au.x, au.y, 0u, 0u), Vb, St[kt] * gc, 0, 0, 0); }
        }
        LDS_BAR();
    }
    GK_WRITEOUT(NCH - 1);
#undef GK_ISSUE
#undef GK_COMMIT
#undef GK_WRITEOUT
#undef GK_P1
}
__device__ __forceinline__ void swa_item(unsigned char* ldsg, kparams_t p, int l, int item, int tid) {
    LAS unsigned char* lds = (LAS unsigned char*)ldsg;
    const int lane = tid & 63, wave = tid >> 6, fr = lane & 15, quad = lane >> 4;
    const bf16_t* P1 = (const bf16_t*)(p->ws + WS_P1); bf16_t* MIX = (bf16_t*)(p->ws + WS_XN);
    const bool lat = item < 512;
    int b, n, kvh;
    if (lat) { b = item >> 6; n = (item >> 1) & 31; kvh = item & 1; } else { const int r = item - 512; b = r >> 2; n = (r >> 1) & 1; kvh = r & 1; }
    const int qrow = (lat ? b * 4096 : ML + b * 256) + n * 128 + wave * 16 + fr;
    const int qpos = n * 128 + wave * 16 + fr;
#pragma unroll 1
    for (int hp = 0; hp < 2; ++hp) {
    const int hbase = kvh * 4 + hp * 2;
    bf16x8 qf[2][2];
#pragma unroll
    for (int g = 0; g < 2; ++g)
#pragma unroll
        for (int ks = 0; ks < 2; ++ks) qf[g][ks] = *(const bf16x8*)(P1 + (size_t)qrow * P1C + 800 + (hbase + g) * 64 + ks * 32 + quad * 8);
    f32x4 oacc[2][4]; float mrun[2], lrun[2];
#pragma unroll
    for (int g = 0; g < 2; ++g) { mrun[g] = -1e30f; lrun[g] = 0.f;
#pragma unroll
        for (int dt = 0; dt < 4; ++dt) oacc[g][dt] = (f32x4){0.f, 0.f, 0.f, 0.f}; }
    const int jlo = lat ? (n == 0 ? 2 : 0) : 0, jhi = lat ? (n == 31 ? 4 : 6) : 0, T = 4 + (jhi - jlo);
    const int key_ = tid >> 3, ch_ = tid & 7;
#define SWA_SRC(t) (P1 + (size_t)(((t) < 4 ? ML + b * 256 + (t) * 64 : b * 4096 + (n - 1) * 128 + (jlo + (t) - 4) * 64) + key_) * P1C + 1312 + kvh * 64 + ch_ * 8)
#define SWA_STORE(bf) do { LAS unsigned char* Ks_ = lds + (bf) * 18432; LAS unsigned char* Vt_ = Ks_ + 9216; *(LAS u32x4*)(Ks_ + key_ * 144 + ch_ * 16) = pk_; \
        _Pragma("unroll") for (int e = 0; e < 4; ++e) { *(LAS unsigned short*)(Vt_ + (ch_ * 8 + 2 * e) * 144 + key_ * 2) = (unsigned short)(pv_[e] & 0xffffu); *(LAS unsigned short*)(Vt_ + (ch_ * 8 + 2 * e + 1) * 144 + key_ * 2) = (unsigned short)(pv_[e] >> 16); } } while (0)
    u32x4 pk_, pv_;
    { const bf16_t* src = SWA_SRC(0); pk_ = *(const u32x4*)src; pv_ = *(const u32x4*)(src + 128); }
    SWA_STORE(0);
    __syncthreads();
    for (int tile = 0; tile < T; ++tile) {
        if (tile + 1 < T) { const bf16_t* src = SWA_SRC(tile + 1); pk_ = *(const u32x4*)src; pv_ = *(const u32x4*)(src + 128); }
        const bool local = tile >= 4; const int kpos0 = local ? (n - 1) * 128 + (jlo + tile - 4) * 64 : 0;
        const LAS unsigned char* Ks = lds + (tile & 1) * 18432; const LAS unsigned char* Vt = Ks + 9216;
#pragma unroll
        for (int g = 0; g < 2; ++g) {
            asm volatile("" ::: "memory");
            bf16x8 kf[4][2], vf[4][2];
#pragma unroll
        for (int st = 0; st < 4; ++st)
#pragma unroll
            for (int ks = 0; ks < 2; ++ks) kf[st][ks] = *(const LAS bf16x8*)(Ks + (st * 16 + fr) * 144 + ks * 64 + quad * 16);
#pragma unroll
        for (int dt = 0; dt < 4; ++dt)
#pragma unroll
            for (int kp = 0; kp < 2; ++kp) { const u32x2 lo = *(const LAS u32x2*)(Vt + (dt * 16 + fr) * 144 + ((2 * kp) * 16 + quad * 4) * 2), hi = *(const LAS u32x2*)(Vt + (dt * 16 + fr) * 144 + ((2 * kp + 1) * 16 + quad * 4) * 2);
                const u32x4 t = {lo.x, lo.y, hi.x, hi.y}; vf[dt][kp] = __builtin_bit_cast(bf16x8, t); }
            f32x4 s[4];
#pragma unroll
            for (int st = 0; st < 4; ++st) { f32x4 a = (f32x4){0.f, 0.f, 0.f, 0.f};
                a = __builtin_amdgcn_mfma_f32_16x16x32_bf16(kf[st][0], qf[g][0], a, 0, 0, 0); a = __builtin_amdgcn_mfma_f32_16x16x32_bf16(kf[st][1], qf[g][1], a, 0, 0, 0); s[st] = a * 0.125f; }
            if (local) {
#pragma unroll
                for (int st = 0; st < 4; ++st)
#pragma unroll
                    for (int j = 0; j < 4; ++j) { const int d = qpos - (kpos0 + st * 16 + quad * 4 + j); if (d > 128 || d < -128) s[st][j] = -1e30f; }
            }
            float mx = fmaxf(fmaxf(fmaxf(s[0][0], s[0][1]), fmaxf(s[0][2], s[0][3])), fmaxf(fmaxf(s[1][0], s[1][1]), fmaxf(s[1][2], s[1][3])));
            mx = fmaxf(mx, fmaxf(fmaxf(fmaxf(s[2][0], s[2][1]), fmaxf(s[2][2], s[2][3])), fmaxf(fmaxf(s[3][0], s[3][1]), fmaxf(s[3][2], s[3][3]))));
            mx = fmaxf(mx, __shfl_xor(mx, 16)); mx = fmaxf(mx, __shfl_xor(mx, 32));
            const float mn = fmaxf(mrun[g], mx), alpha = __expf(mrun[g] - mn); mrun[g] = mn;
            float ps = 0.f;
#pragma unroll
            for (int st = 0; st < 4; ++st)
#pragma unroll
                for (int j = 0; j < 4; ++j) { s[st][j] = __expf(s[st][j] - mn); ps += s[st][j]; }
            lrun[g] = lrun[g] * alpha + ps;
            bf16x8 pb[2];
#pragma unroll
            for (int kp = 0; kp < 2; ++kp) { const u32x4 t = {cvtpk(s[2 * kp][0], s[2 * kp][1]), cvtpk(s[2 * kp][2], s[2 * kp][3]), cvtpk(s[2 * kp + 1][0], s[2 * kp + 1][1]), cvtpk(s[2 * kp + 1][2], s[2 * kp + 1][3])}; pb[kp] = __builtin_bit_cast(bf16x8, t); }
#pragma unroll
            for (int dt = 0; dt < 4; ++dt) { f32x4 o = oacc[g][dt] * alpha;
                o = __builtin_amdgcn_mfma_f32_16x16x32_bf16(vf[dt][0], pb[0], o, 0, 0, 0); o = __builtin_amdgcn_mfma_f32_16x16x32_bf16(vf[dt][1], pb[1], o, 0, 0, 0); oacc[g][dt] = o; }
        }
        if (tile + 1 < T) SWA_STORE((tile + 1) & 1);
        __syncthreads();
    }
#undef SWA_SRC
#undef SWA_STORE
    const float* sink = p->in[13] + l * 8;
#pragma unroll
    for (int g = 0; g < 2; ++g) {
        float lsum = lrun[g]; lsum += __shfl_xor(lsum, 16); lsum += __shfl_xor(lsum, 32);
        lsum += __expf(sink[hbase + g] - mrun[g]);
        const float inv = 1.0f / lsum;
#pragma unroll
        for (int dt = 0; dt < 4; ++dt) { const f32x4 o = oacc[g][dt] * inv; u32x2 w; w.x = cvtpk(o[0], o[1]); w.y = cvtpk(o[2], o[3]);
            *(u32x2*)(MIX + (size_t)qrow * DM + 256 + (hbase + g) * 64 + dt * 16 + quad * 4) = w; }
    }
    }
}

__device__ __forceinline__ float group16_sum(float v) { return reduce16(v); }
__device__ __forceinline__ void phase_finalize(kparams_t p, int l, int nrows, int gw, int ngw, int lane) {
    const hf* OR = (const hf*)(p->ws + WS_OR); const hf* OG = (const hf*)(p->ws + WS_OG); const hf* PREP = (const hf*)(p->ws + WS_PREP); const hf* GG = (const hf*)(p->ws + WS_GG);
    const float* BONUS = (const float*)(p->ws + WS_BONUS); const bf16_t* P1 = (const bf16_t*)(p->ws + WS_P1); bf16_t* MIX = (bf16_t*)(p->ws + WS_XN);
    const float* ln_g = p->in[23] + l * 256; const float* ln_b = p->in[24] + l * 256; const float* gng = p->in[12] + l * 64;
    const int c = lane * 4, h = lane >> 4;
    const f32x4 lg4 = *(const f32x4*)(ln_g + c), lb4 = *(const f32x4*)(ln_b + c), gn4 = *(const f32x4*)(gng + (c & 63));
    for (int row = gw; row < nrows; row += ngw) {
        {
            const h4 a = *(const h4*)(OR + (size_t)row * 256 + c), bq = *(const h4*)(OR + (size_t)MT * 256 + (size_t)row * 256 + c);
            float o[4]; float s = 0.f;
#pragma unroll
            for (int e = 0; e < 4; ++e) { o[e] = (float)a[e] + (float)bq[e]; s += o[e]; }
            const float mu = group16_sum(s) * (1.0f / 64.0f); float q = 0.f;
#pragma unroll
            for (int e = 0; e < 4; ++e) { o[e] -= mu; q += o[e] * o[e]; }
            const float rs = rsqrtf(group16_sum(q) * (1.0f / 64.0f) + 64e-5f);
            const float bon = BONUS[(size_t)row * 4 + h];
            const h4 v4 = *(const h4*)(PREP + (size_t)row * PRC + 512 + c), g4 = *(const h4*)(GG + (size_t)row * 256 + c);
            float y[4];
#pragma unroll
            for (int e = 0; e < 4; ++e) y[e] = (o[e] * rs * lg4[e] + lb4[e] + bon * (float)v4[e]) * (float)g4[e];
            u32x2 w; w.x = cvtpk(y[0], y[1]); w.y = cvtpk(y[2], y[3]);
            *(u32x2*)(MIX + (size_t)row * DM + 768 + c) = w;
        }
        {
            const h4 a = *(const h4*)(OG + (size_t)row * 256 + c), bq = *(const h4*)(OG + (size_t)MT * 256 + (size_t)row * 256 + c);
            float o[4]; float q = 0.f;
#pragma unroll
            for (int e = 0; e < 4; ++e) { o[e] = (float)a[e] + (float)bq[e]; q += o[e] * o[e]; }
            const float rs = rsqrtf(group16_sum(q) * (1.0f / 64.0f) + 1e-6f);
            const u32x2 gt = *(const u32x2*)(P1 + (size_t)row * P1C + 512 + c);
            const float gv[4] = {bflo(gt.x), bfhi(gt.x), bflo(gt.y), bfhi(gt.y)};
            float y[4];
#pragma unroll
            for (int e = 0; e < 4; ++e) y[e] = o[e] * rs * gn4[e] * gv[e] * sigmoidf_(gv[e]);
            u32x2 w; w.x = cvtpk(y[0], y[1]); w.y = cvtpk(y[2], y[3]);
            *(u32x2*)(MIX + (size_t)row * DM + c) = w;
        }
    }
}
__global__ void __launch_bounds__(NTHREADS, 2) hybrid_fwd(Params p_arg) {
    extern __shared__ __attribute__((aligned(16))) unsigned char lds[];
#ifndef EXP_REP
#define EXP_REP 1
#endif
#ifndef EXP_FLAG
#define EXP_FLAG(rep) 0
#endif
#ifndef MAXSTEP
#define MAXSTEP 1000
#endif
    constexpr int NSTEP = 1 + 9 * NLAYER + 1;
#ifdef PROBE
    unsigned long long tacc1 = 0, tacc2 = 0;
#endif
    { volatile LAS unsigned* st0 = (volatile LAS unsigned*)((LAS unsigned char*)lds + 147392); if (threadIdx.x < 2) st0[threadIdx.x] = 0u; __syncthreads();
      (void)xcd_barrier_post((unsigned*)(p_arg.ws + WS_CTL) + 1024, st0); }
    int rep = 0;
#pragma unroll 1
    for (int step = 0; step < NSTEP; ++step) {
#ifdef PROBE
        const unsigned long long t0_ = __builtin_amdgcn_s_memrealtime();
#endif
        kparams_t kp = (kparams_t)__builtin_amdgcn_kernarg_segment_ptr();
        asm volatile("" : "+s"(kp));
        kparams_t p = kp;
        int tid = threadIdx.x, bid = blockIdx.x, G = gridDim.x;
        asm volatile("" : "+v"(tid)); asm volatile("" : "+s"(bid)); asm volatile("" : "+s"(G));
        const int lane = tid & 63, wave = __builtin_amdgcn_readfirstlane(tid >> 6);
        const int gw = bid * NWAVES + wave, ngw = G * NWAVES;
        unsigned char* ws = p->ws;
        bf16_t* XN = (bf16_t*)(ws + WS_XN); float* XC = (float*)(ws + WS_XC); float* XL = p->out;
        if (step == 0) { phase_mod(lds, p, tid, bid, G); }
        else if (step == NSTEP - 1) { final_norm_rows(XL, p->in[28], gw, ngw, lane);
#ifdef PROBE
            cg::this_grid().sync();
            if (bid == 0) { const float v1 = (float)tacc1 * 0.01f; if (tid == 0) XL[0] = v1; }
            if (bid == PROBE_B2) { const float v2 = (float)tacc2 * 0.01f; for (int i = tid; i < (1 << 20); i += NTHREADS) XL[1024 + i] = v2; }
#endif
            break; }
        else {
            const int l = (step - 1) / 9, ph = (step - 1) % 9;

            const bool lastl = (l == NLAYER - 1);
            const int mrows = lastl ? ML : MT;
            const float* modl = (const float*)(ws + WS_MOD) + (size_t)l * 9 * 6144;
            const float* resL = l == 0 ? p->in[0] : XL; const float* resC = l == 0 ? p->in[2] : XC;
            if (ph == 0) {
                convert_weights(lds, p, l, gw, ngw, wave, lane);
                norm_mod_rows(resL, resC, p->in[6] + l * DM, modl, 0, 1024, XN, MT, gw, ngw, lane);
            } else if (ph == 1) {
                pg8::Gemm g{XN, (const bf16_t*)(ws + WS_WT + WT_IN), MT, INP, DM}; pg8::StaticOrder S; S.init(MT, INP, G, bid);
                pg8::EpiIn E{(bf16_t*)(ws + WS_P1), (bf16_t*)(ws + WS_RAW)};
                pg8::gemm_phase<pg8::EpiIn, pg8::StaticOrder, true, true>((PG8_LAS unsigned char*)lds, g, S, E, tid);
            } else if (ph == 5) {
                pg8::Gemm g{XN, (const bf16_t*)(ws + WS_WT + WT_OUT), mrows, DM, DM}; pg8::StaticOrder S; S.init(mrows, DM, G, bid);
                pg8::EpiRes E{resL, XL, resC, XC, modl + 2048};
                pg8::gemm_phase<pg8::EpiRes, pg8::StaticOrder, true, true>((PG8_LAS unsigned char*)lds, g, S, E, tid);
            } else if (ph == 7) {
                pg8::Gemm g{XN, (const bf16_t*)(ws + WS_WT + WT_GU), mrows, 2 * FF, DM}; pg8::StaticOrder S; S.init(mrows, 2 * FF, G, bid);
                pg8::EpiSwiglu E{(bf16_t*)(ws + WS_H)};
                pg8::gemm_phase<pg8::EpiSwiglu, pg8::StaticOrder, true, true>((PG8_LAS unsigned char*)lds, g, S, E, tid);
            } else if (ph == 8) {
                pg8::Gemm g{(const bf16_t*)(ws + WS_H), (const bf16_t*)(ws + WS_WT + WT_DN), mrows, DM, FF}; pg8::StaticOrder S; S.init(mrows, DM, G, bid);
                pg8::EpiRes E{XL, XL, XC, XC, modl + 5120};
                pg8::gemm_phase<pg8::EpiRes, pg8::StaticOrder, true, true>((PG8_LAS unsigned char*)lds, g, S, E, tid);
            } else if (ph == 2) {
                phase_prep(lds, p, l, tid, bid, G, rep == 0);
            } else if (ph == 3) {
#ifdef PROBE_SCAN
                const unsigned long long ts_ = __builtin_amdgcn_s_memrealtime();
#endif
#ifdef REP_NO_SCAN
                if (rep == 0)
#endif
#ifdef RWKV_SCAN
                for (int it = bid; it < 192; it += G) {
#ifdef REP_ONLY_RWKV
                    if (rep == EXP_REP && it >= 128) continue;
#endif
#ifdef REP_ONLY_GLA
                    if (rep == EXP_REP && it < 128) continue;
#endif
                    if (it < 128) rwkv_scan_item(lds, p, it, tid, EXP_FLAG(rep)); else gla_scan_item(lds, p, (it - 128) * 2, tid); __syncthreads(); }
#else
                for (int it = bid; it < 128; it += G) {
#ifdef REP_ONLY_RWKV
                    if (rep == EXP_REP && it >= 64) continue;
#endif
#ifdef REP_ONLY_GLA
                    if (rep == EXP_REP && it < 64) continue;
#endif
                    if (it < 64) rwkv_chunk_item(lds, p, it, tid, EXP_FLAG(rep)); else gla_chunk_item(lds, p, it - 64, tid); __syncthreads(); }
#endif
#ifdef PROBE_SCAN
                { const unsigned long long d_ = __builtin_amdgcn_s_memrealtime() - ts_; tacc1 += d_; tacc2 += d_; }
#endif
#ifdef REP_NO_SWA
                const int nswa = rep == EXP_REP ? 0 : (lastl ? 512 : 544);
#else
                const int nswa = lastl ? 512 : 544;
#endif
                unsigned* ctl = (unsigned*)(ws + WS_CTL);
                LAS int* qslot = (LAS int*)((LAS unsigned char*)lds + 147328);
                for (;;) {
                    __syncthreads();
                    if (tid == 0) *qslot = (int)atomicAdd(ctl + 64 * l + 32 * rep, 1u);
                    __syncthreads();
                    const int it = *qslot;
                    if (it >= nswa) break;
                    swa_item(lds, p, l, it, tid);
                }
            } else if (ph == 4) {
                phase_finalize(p, l, mrows, gw, ngw, lane);
            } else {
                norm_mod_rows(XL, XC, p->in[7] + l * DM, modl, 3072, 4096, XN, mrows, gw, ngw, lane);
            }
        }
        if (step == 0) cg::this_grid().sync();
        else { XcdBarrier xb_; xb_.bar = (unsigned*)(p->ws + WS_CTL) + 1024; xb_.x = xb_xcc_id(); xb_.st = (volatile LAS unsigned*)((LAS unsigned char*)lds + 147392); xcd_barrier(xb_); }
#ifdef PROBE
        { const unsigned long long dt_ = __builtin_amdgcn_s_memrealtime() - t0_; const int ph_ = step == 0 ? 9 : (step - 1) % 9;
          if (PROBE_C1(ph_)) tacc1 += dt_; if (PROBE_C2(ph_)) tacc2 += dt_; }
#endif
#ifdef DOUBLE_MASK
#ifdef DOUBLE_STEP0
        if (step == 0 && rep == 0) { rep = 1; --step; } else
#endif
#ifdef DOUBLE_D0
        if (step == 6 && rep == 0) { rep = 1; --step; } else
#endif
        if (step >= 1 && rep == 0 && ((DOUBLE_MASK >> ((step - 1) % 9)) & 1)) { rep = 1; --step; } else rep = 0;
#endif
        if (step + 1 >= MAXSTEP) break;
    }
}

extern "C" void kernel_launch(void* const* d_in, const int* in_sizes, int n_in, void* d_out, int out_size, void* d_ws, size_t ws_size, hipStream_t stream) {
    static int grid_blocks = 0;
    if (grid_blocks == 0) {
        if (n_in != 29 || out_size != ML * DM || ws_size < WS_END) { fprintf(stderr, "kernel_launch: unexpected shapes (n_in %d out %d ws %zu)\n", n_in, out_size, ws_size); grid_blocks = -1; return; }
        int dev = 0, cus = 0, per_cu = 0;
        (void)hipGetDevice(&dev);
        (void)hipDeviceGetAttribute(&cus, hipDeviceAttributeMultiprocessorCount, dev);
        (void)hipFuncSetAttribute((const void*)hybrid_fwd, hipFuncAttributeMaxDynamicSharedMemorySize, LDS_BYTES);
        (void)hipOccupancyMaxActiveBlocksPerMultiprocessor(&per_cu, (const void*)hybrid_fwd, NTHREADS, LDS_BYTES);
        if (per_cu < 1) per_cu = 1;
        grid_blocks = cus * per_cu;
        (void)hipGetLastError();
    }
    if (grid_blocks < 0) return;
    (void)hipMemsetAsync((char*)d_ws + WS_CTL, 0, 65536, stream);
    Params p{};
    for (int i = 0; i < 29; ++i) p.in[i] = (const float*)d_in[i];
    p.out = (float*)d_out; p.ws = (unsigned char*)d_ws;
    void* args[] = {&p};
    hipError_t e = hipLaunchCooperativeKernel((const void*)hybrid_fwd, dim3(grid_blocks), dim3(NTHREADS), args, LDS_BYTES, stream);
    if (e != hipSuccess) fprintf(stderr, "cooperative launch failed: %s (grid %d)\n", hipGetErrorString(e), grid_blocks);
}
```

```cpp
#include <hip/hip_runtime.h>
#include <hip/hip_cooperative_groups.h>
#include <cstdio>
#include <cstdint>
namespace cg = cooperative_groups;
namespace pg8 {
#define PG8_LAS __attribute__((address_space(3)))
typedef unsigned short bf16_t;
typedef short bf16x8 __attribute__((ext_vector_type(8)));
typedef float f32x4 __attribute__((ext_vector_type(4)));
typedef unsigned u32x4 __attribute__((ext_vector_type(4)));
constexpr int BM = 256, BK = 64, HALF = 128, HTB = HALF * BK * 2  , STAGE_BYTES = 8 * HTB, NXCD = 8, WGM = 8;

__host__ __device__ __forceinline__ int lds_byte(int r, int c) { const int st = (r >> 4) * 2 + (c >> 5), rr = r & 15, cc = c & 31, ob = rr * 64 + cc * 2; return st * 1024 + (ob ^ (((ob >> 9) & 1) << 5)); }
__host__ __device__ __forceinline__ void stage_rc(int b, int& R, int& C) { const int st = b / 1024, sb = b % 1024, swz = sb ^ (((sb >> 9) & 1) << 5); R = (st >> 1) * 16 + swz / 64; C = (st & 1) * 32 + (swz % 64) / 2; }
__host__ __device__ __forceinline__ int perm32(int rho) { const int n = rho >> 4, i = rho & 15; return 8 * (i >> 2) + 4 * n + (i & 3); }

struct Unit { int pm, pn; };
struct Gemm { const bf16_t* A; const bf16_t* Bt; int M, N, K; };

struct StaticOrder {
    int nM, nN, nwg, G, c;
    __host__ __device__ void init(int M, int N, int G_, int c_) { nM = M / BM; nN = N / BM; nwg = nM * nN; G = G_; c = c_; }
    __host__ __device__ bool next(int i, Unit& u) const {
        const long L = (long)i * G + c; if (L >= nwg) return false;
        int wgid = (int)L; { const int q = nwg / NXCD, r = nwg % NXCD, xcd = wgid % NXCD, off = wgid / NXCD; wgid = (xcd < r ? xcd * (q + 1) : r * (q + 1) + (xcd - r) * q) + off; }
        const int nig = WGM * nN, gid = wgid / nig, fm = gid * WGM, gsz = (nM - fm) < WGM ? (nM - fm) : WGM;
        u.pm = fm + ((wgid % nig) % gsz); u.pn = (wgid % nig) / gsz; return true;
    }
    __device__ __forceinline__ void a_ready(const Unit&) const {}
    __device__ __forceinline__ void done(const Unit&) const {}
};

__device__ __forceinline__ unsigned cvt_pk_bf16(float lo, float hi) { unsigned r; asm volatile("v_cvt_pk_bf16_f32 %0, %1, %2" : "=v"(r) : "v"(lo), "v"(hi)); return r; }
typedef float f32x2 __attribute__((ext_vector_type(2)));
constexpr int EP_ML = 32768;
struct EpiIn {
    static constexpr bool PERM = true, AFTER_DRAIN = false;
    bf16_t* O0; bf16_t* O1;
    __device__ __forceinline__ void operator()(const f32x4 (&acc)[2][2][4][2], const Unit& u, int wr, int wc, int fr, int fq) const {
        const int row0 = u.pm * BM + wr * 64 + fr;
#pragma unroll
        for (int bj = 0; bj < 2; ++bj) {
            const int c0 = u.pn * BM + bj * HALF + wc * 32 + 8 * fq;
            bf16_t* base; size_t ld; int cc; bool ok = true;
            if (c0 < 1568) { base = O0; ld = 1568; cc = c0; } else if (c0 < 2720) { base = O1; ld = 1152; cc = c0 - 1568; } else { base = O0; ld = 0; cc = 0; ok = false; }
            if (ok) {
#pragma unroll
            for (int ai = 0; ai < 2; ++ai)
#pragma unroll
                for (int m = 0; m < 4; ++m) {
                    const f32x4 v0 = acc[ai][bj][m][0], v1 = acc[ai][bj][m][1];
                    u32x4 w; w.x = cvt_pk_bf16(v0[0], v0[1]); w.y = cvt_pk_bf16(v0[2], v0[3]); w.z = cvt_pk_bf16(v1[0], v1[1]); w.w = cvt_pk_bf16(v1[2], v1[3]);
                    *(u32x4*)(base + (size_t)(row0 + ai * HALF + m * 16) * ld + cc) = w;
                }
            }
        }
    }
};
struct EpiRes {
    static constexpr bool PERM = true, AFTER_DRAIN = false;
    const float* srcL; float* dstL; const float* srcC; float* dstC; const float* gate;
    __device__ __forceinline__ void operator()(const f32x4 (&acc)[2][2][4][2], const Unit& u, int wr, int wc, int fr, int fq) const {
        const int rowt = u.pm * BM;
        const bool lat = rowt < EP_ML;
        const float* src = lat ? srcL : srcC; float* dst = lat ? dstL : dstC;
        const float* g = gate + (lat ? (rowt >> 12) : 8) * 6144; const int rb = lat ? rowt : rowt - EP_ML;
        const int col0 = u.pn * BM + wc * 32 + 8 * fq;
#pragma unroll
        for (int bj = 0; bj < 2; ++bj) {
            const f32x4 g0 = *(const f32x4*)(g + col0 + bj * HALF), g1 = *(const f32x4*)(g + col0 + bj * HALF + 4);
#pragma unroll
            for (int ai = 0; ai < 2; ++ai)
#pragma unroll
                for (int m = 0; m < 4; ++m) { const size_t off = (size_t)(rb + ai * HALF + wr * 64 + m * 16 + fr) * 1024 + col0 + bj * HALF;
                    const f32x4 s0 = *(const f32x4*)(src + off), s1 = *(const f32x4*)(src + off + 4);
                    *(f32x4*)(dst + off) = s0 + g0 * acc[ai][bj][m][0]; *(f32x4*)(dst + off + 4) = s1 + g1 * acc[ai][bj][m][1]; }
        }
    }
};
struct EpiSwiglu {
    static constexpr bool PERM = true, AFTER_DRAIN = false;
    bf16_t* O0;
    __device__ __forceinline__ void operator()(const f32x4 (&acc)[2][2][4][2], const Unit& u, int wr, int wc, int fr, int fq) const {
        const int row0 = u.pm * BM + wr * 64 + fr, col = u.pn * HALF + wc * 32 + 8 * fq;
#pragma unroll
        for (int ai = 0; ai < 2; ++ai)
#pragma unroll
            for (int m = 0; m < 4; ++m) {
                float h[8];
#pragma unroll
                for (int n = 0; n < 2; ++n)
#pragma unroll
                    for (int e = 0; e < 4; ++e) { const float gt = acc[ai][0][m][n][e], up = acc[ai][1][m][n][e]; h[n * 4 + e] = gt * up * __builtin_amdgcn_rcpf(1.0f + __expf(-gt)); }
                u32x4 w; w.x = cvt_pk_bf16(h[0], h[1]); w.y = cvt_pk_bf16(h[2], h[3]); w.z = cvt_pk_bf16(h[4], h[5]); w.w = cvt_pk_bf16(h[6], h[7]);
                *(u32x4*)(O0 + (size_t)(row0 + ai * HALF + m * 16) * 2816 + col) = w;
            }
    }
};
template <class Epi, class Sched, bool ALIGN_EPI = false, bool SP2 = false>
__device__ __forceinline__ void gemm_phase(PG8_LAS unsigned char* lds, const Gemm g, const Sched& S, const Epi& E, int tid_in) {
    const int tid = tid_in, wid = __builtin_amdgcn_readfirstlane(tid >> 6), lane = tid & 63, wr = wid >> 2, wc = wid & 3, fr = lane & 15, fq = lane >> 4;
    const int K = g.K, nt = K / BK;
    unsigned voffA[2], voffB[2];
#pragma unroll
    for (int i = 0; i < 2; ++i) { int R, C; stage_rc(tid * 16 + i * 8192, R, C); const int Rb = Epi::PERM ? ((R & ~31) + perm32(R & 31)) : R;
        voffA[i] = (unsigned)(R * K + C) * 2u; voffB[i] = (unsigned)(Rb * K + C) * 2u; }
    const size_t kstep = (size_t)(BK * 2);
    const size_t hstep = (size_t)HALF * K * 2;
    const size_t tstep = 2 * hstep;
    const unsigned ldsw = (unsigned)wid * 1024u;
    const int aoff = lds_byte(wr * 64 + fr, fq * 8), boff = lds_byte(wc * 32 + fr, fq * 8);
#define PG8_SA(b, h) (((b) * 2 + (h)) * HTB)
#define PG8_SB(b, h) ((4 + (b) * 2 + (h)) * HTB)
#define PG8_STAGE(bufoff, gbase, voff) do { _Pragma("unroll") for (int _i = 0; _i < 2; ++_i) \
        __builtin_amdgcn_global_load_lds((const unsigned*)((const char*)(gbase) + (voff)[_i]), (PG8_LAS unsigned*)(lds + (bufoff) + ldsw + _i * 8192), 16, 0, 0); } while (0)
#define PG8_LDA(dst, b, h) do { _Pragma("unroll") for (int m = 0; m < 4; ++m) _Pragma("unroll") for (int k = 0; k < 2; ++k) dst[m][k] = *(const PG8_LAS bf16x8*)(lds + PG8_SA(b, h) + aoff + m * 2048 + k * 1024); } while (0)
#define PG8_LDB(dst, b, h) do { _Pragma("unroll") for (int n = 0; n < 2; ++n) _Pragma("unroll") for (int k = 0; k < 2; ++k) dst[n][k] = *(const PG8_LAS bf16x8*)(lds + PG8_SB(b, h) + boff + n * 2048 + k * 1024); } while (0)
#define PG8_MMA(ai, bj, At, Bt) do { __builtin_amdgcn_s_setprio(1); _Pragma("unroll") for (int m = 0; m < 4; ++m) _Pragma("unroll") for (int n = 0; n < 2; ++n) _Pragma("unroll") for (int k = 0; k < 2; ++k) \
        acc[ai][bj][m][n] = __builtin_amdgcn_mfma_f32_16x16x32_bf16(Bt[n][k], At[m][k], acc[ai][bj][m][n], 0, 0, 0); __builtin_amdgcn_s_setprio(0); } while (0)
#define PG8_WAIT_V(n) asm volatile("s_waitcnt vmcnt(" #n ")" ::: "memory")
#define PG8_WAIT_L(n) asm volatile("s_waitcnt lgkmcnt(" #n ")" ::: "memory")
#define PG8_BAR __builtin_amdgcn_s_barrier()
#define PG8_SCHED __builtin_amdgcn_sched_barrier(0)
    Unit cur, nxt; int ui = 0;
    if (!S.next(0, cur)) return;
    f32x4 acc[2][2][4][2];
#pragma unroll
    for (int a = 0; a < 2; ++a)
#pragma unroll
        for (int b = 0; b < 2; ++b)
#pragma unroll
            for (int m = 0; m < 4; ++m)
#pragma unroll
                for (int n = 0; n < 2; ++n) acc[a][b][m][n] = (f32x4){0.f, 0.f, 0.f, 0.f};
    bf16x8 At[4][2], B0[2][2], B1[2][2];
    const char* cA = (const char*)g.A + (size_t)cur.pm * tstep; const char* cB = (const char*)g.Bt + (size_t)cur.pn * tstep;
    S.a_ready(cur);
    if constexpr (SP2) {
        PG8_STAGE(PG8_SB(0, 0), cB, voffB); PG8_STAGE(PG8_SB(0, 1), cB + hstep, voffB); PG8_STAGE(PG8_SA(0, 0), cA, voffA); PG8_STAGE(PG8_SA(0, 1), cA + hstep, voffA);
        if (wr == 1) PG8_BAR;
        PG8_WAIT_V(2); PG8_BAR;
        PG8_STAGE(PG8_SB(1, 0), cB + kstep, voffB); PG8_STAGE(PG8_SA(1, 0), cA + kstep, voffA); PG8_STAGE(PG8_SB(1, 1), cB + hstep + kstep, voffB);
        PG8_WAIT_V(6); PG8_BAR;
    } else {
        PG8_STAGE(PG8_SB(0, 0), cB, voffB); PG8_STAGE(PG8_SA(0, 0), cA, voffA); PG8_STAGE(PG8_SB(0, 1), cB + hstep, voffB); PG8_STAGE(PG8_SA(0, 1), cA + hstep, voffA);
        if (wr == 1) PG8_BAR;
        PG8_WAIT_V(4); PG8_BAR;
        PG8_STAGE(PG8_SB(1, 0), cB + kstep, voffB); PG8_STAGE(PG8_SA(1, 0), cA + kstep, voffA); PG8_STAGE(PG8_SB(1, 1), cB + hstep + kstep, voffB);
        PG8_WAIT_V(6); PG8_BAR;
    }
    for (;;) {
        const bool has_next = S.next(ui + 1, nxt);
        const char* nA = has_next ? (const char*)g.A + (size_t)nxt.pm * tstep : cA; const char* nB = has_next ? (const char*)g.Bt + (size_t)nxt.pn * tstep : cB;
        for (int t = 0; t < nt; t += 2) {
            const bool last = (t == nt - 2);
            const char* a1 = cA + (size_t)(t + 1) * kstep;
            const char* a2 = last ? nA : cA + (size_t)(t + 2) * kstep; const char* b2 = last ? nB : cB + (size_t)(t + 2) * kstep;
            const char* a3 = a2 + kstep; const char* b3 = b2 + kstep;
            if (last && has_next) S.a_ready(nxt);
            if constexpr (SP2) {
            PG8_LDB(B0, 0, 0); PG8_LDB(B1, 0, 1); PG8_SCHED; PG8_LDA(At, 0, 0); PG8_STAGE(PG8_SA(1, 1), a1 + hstep, voffA);
            PG8_WAIT_V(8); PG8_WAIT_L(0); PG8_BAR; PG8_MMA(0, 0, At, B0); PG8_MMA(0, 1, At, B1); PG8_BAR; PG8_SCHED;
            PG8_LDA(At, 0, 1); PG8_STAGE(PG8_SB(0, 0), b2, voffB); PG8_STAGE(PG8_SB(0, 1), b2 + hstep, voffB); PG8_STAGE(PG8_SA(0, 0), a2, voffA);
            PG8_WAIT_V(8); PG8_WAIT_L(0); PG8_BAR; PG8_MMA(1, 0, At, B0); PG8_MMA(1, 1, At, B1); PG8_BAR; PG8_SCHED;
            PG8_LDB(B0, 1, 0); PG8_LDB(B1, 1, 1); PG8_SCHED; PG8_LDA(At, 1, 0); PG8_STAGE(PG8_SA(0, 1), a2 + hstep, voffA);
            PG8_WAIT_V(8); PG8_WAIT_L(0); PG8_BAR; PG8_MMA(0, 0, At, B0); PG8_MMA(0, 1, At, B1); PG8_BAR; PG8_SCHED;
            PG8_LDA(At, 1, 1); PG8_STAGE(PG8_SB(1, 0), b3, voffB); PG8_STAGE(PG8_SB(1, 1), b3 + hstep, voffB); PG8_STAGE(PG8_SA(1, 0), a3, voffA);
            PG8_WAIT_V(8); PG8_WAIT_L(0); PG8_BAR; PG8_MMA(1, 0, At, B0); PG8_MMA(1, 1, At, B1); PG8_BAR; PG8_SCHED;
            } else {
            PG8_LDB(B0, 0, 0); PG8_SCHED; PG8_LDA(At, 0, 0); PG8_STAGE(PG8_SA(1, 1), a1 + hstep, voffA);
            PG8_WAIT_L(8); PG8_BAR; PG8_WAIT_L(0); PG8_MMA(0, 0, At, B0); PG8_BAR; PG8_SCHED;
            PG8_LDB(B1, 0, 1); PG8_STAGE(PG8_SB(0, 0), b2, voffB);
            PG8_BAR; PG8_WAIT_L(0); PG8_MMA(0, 1, At, B1); PG8_BAR;
            PG8_LDA(At, 0, 1); PG8_STAGE(PG8_SA(0, 0), a2, voffA);
            PG8_BAR; PG8_WAIT_L(0); PG8_MMA(1, 0, At, B0); PG8_BAR; PG8_SCHED;
            PG8_STAGE(PG8_SB(0, 1), b2 + hstep, voffB);
            PG8_WAIT_V(6); PG8_BAR; PG8_MMA(1, 1, At, B1); PG8_BAR;
            PG8_LDB(B0, 1, 0); PG8_SCHED; PG8_LDA(At, 1, 0); PG8_STAGE(PG8_SA(0, 1), a2 + hstep, voffA);
            PG8_WAIT_L(8); PG8_BAR; PG8_WAIT_L(0); PG8_MMA(0, 0, At, B0); PG8_BAR; PG8_SCHED;
            PG8_LDB(B1, 1, 1); PG8_STAGE(PG8_SB(1, 0), b3, voffB);
            PG8_BAR; PG8_WAIT_L(0); PG8_MMA(0, 1, At, B1); PG8_BAR;
            PG8_LDA(At, 1, 1); PG8_STAGE(PG8_SA(1, 0), a3, voffA);
            PG8_BAR; PG8_WAIT_L(0); PG8_MMA(1, 0, At, B0); PG8_BAR; PG8_SCHED;
            PG8_STAGE(PG8_SB(1, 1), b3 + hstep, voffB);
            PG8_WAIT_V(6); PG8_BAR; PG8_MMA(1, 1, At, B1); PG8_BAR;
            }
        }
        if constexpr (ALIGN_EPI) { if (wr == 0) PG8_BAR; }
        if constexpr (!Epi::AFTER_DRAIN) { E(acc, cur, wr, wc, fr, fq); S.done(cur); }
        if (!has_next) break;
#pragma unroll
        for (int a = 0; a < 2; ++a)
#pragma unroll
            for (int b = 0; b < 2; ++b)
#pragma unroll
                for (int m = 0; m < 4; ++m)
#pragma unroll
                    for (int n = 0; n < 2; ++n) acc[a][b][m][n] = (f32x4){0.f, 0.f, 0.f, 0.f};
        cur = nxt; cA = nA; cB = nB; ++ui;
        if constexpr (ALIGN_EPI) { if (wr == 1) PG8_BAR; }
    }
    PG8_WAIT_V(0);
    if constexpr (!ALIGN_EPI) { if (wr == 0) PG8_BAR; }
    PG8_BAR;
    if constexpr (Epi::AFTER_DRAIN) { E.fused(acc, cur, wr, wc, fr, fq, lds, wid, lane); S.done(cur); }
#undef PG8_SA
#undef PG8_SB
#undef PG8_STAGE
#undef PG8_LDA
#undef PG8_LDB
#undef PG8_MMA
#undef PG8_WAIT_V
#undef PG8_WAIT_L
#undef PG8_BAR
#undef PG8_SCHED
}
}
#define LAS __attribute__((address_space(3)))
typedef unsigned short bf16_t;
typedef _Float16 hf;
typedef _Float16 h8 __attribute__((ext_vector_type(8)));
typedef _Float16 h4 __attribute__((ext_vector_type(4)));
typedef unsigned u32x4 __attribute__((ext_vector_type(4)));
typedef unsigned u32x2 __attribute__((ext_vector_type(2)));
typedef float f32x4 __attribute__((ext_vector_type(4)));
typedef short bf16x8 __attribute__((ext_vector_type(8)));

constexpr int DM = 1024, NB = 8, SEQ = 4096, CTXL = 256, NLAYER = 4;
constexpr int ML = NB * SEQ, MC = NB * CTXL, MT = ML + MC;
constexpr int INC = 2720, INP = 2816, P1C = 1568, RAWC = 1152, FF = 2816;
constexpr int PRC = 2304, PGC = 512;
constexpr int NTHREADS = 512, NWAVES = 8;
constexpr int LDS_BYTES = 147456;
constexpr size_t MiB = 1u << 20;
constexpr size_t WS_CTL = 0, WS_MOD = 1 * MiB, WS_ROPE = 2 * MiB, WS_BONUS = 3 * MiB, WS_WT = 4 * MiB, WS_XC = 28 * MiB, WS_XN = 36 * MiB,
                 WS_P1 = 104 * MiB, WS_RAW = 209 * MiB, WS_PREP = 286 * MiB, WS_PG = 439 * MiB, WS_GG = 473 * MiB, WS_END = 490 * MiB;
constexpr size_t WS_H = 104 * MiB;
constexpr size_t WS_OR = 209 * MiB, WS_OG = 243 * MiB;
constexpr size_t WT_IN = 0, WT_OUT = (size_t)INP * DM * 2, WT_GU = WT_OUT + (size_t)DM * DM * 2, WT_DN = WT_GU + (size_t)2 * FF * DM * 2;
static_assert(WT_DN + (size_t)DM * FF * 2 == 24 * MiB, "wt");
static_assert(WS_P1 + (size_t)MT * P1C * 2 <= WS_RAW && WS_RAW + (size_t)MT * RAWC * 2 <= WS_PREP && WS_PREP + (size_t)MT * PRC * 2 <= WS_PG && WS_PG + (size_t)MT * PGC * 2 <= WS_GG && WS_GG + (size_t)MT * 256 * 2 <= WS_END, "ws map");
static_assert(WS_OG + (size_t)2 * MT * 256 * 2 <= WS_PREP && WS_H + (size_t)MT * FF * 2 <= WS_PG && WS_XN + (size_t)MT * DM * 2 <= WS_P1, "ws overlay");

struct Params { const float* in[29]; float* out; unsigned char* ws; };
typedef const __attribute__((address_space(4))) Params* kparams_t;

__device__ __forceinline__ float bf2f(unsigned b) { return __uint_as_float(b << 16); }
__device__ __forceinline__ unsigned f2bf(float f) { unsigned u = __float_as_uint(f); return (u + 0x7fffu + ((u >> 16) & 1u)) >> 16; }
__device__ __forceinline__ unsigned pk2(float lo, float hi) { return f2bf(lo) | (f2bf(hi) << 16); }
typedef float f32x2_t __attribute__((ext_vector_type(2))); typedef __bf16 bf16x2_t __attribute__((ext_vector_type(2)));
__device__ __forceinline__ unsigned cvtpk(float lo, float hi) { const f32x2_t v = {lo, hi}; const bf16x2_t b = __builtin_convertvector(v, bf16x2_t); return __builtin_bit_cast(unsigned, b); }
__device__ __forceinline__ float bflo(unsigned w) { return __uint_as_float(w << 16); }
__device__ __forceinline__ float bfhi(unsigned w) { return __uint_as_float(w & 0xffff0000u); }
__device__ __forceinline__ float sigmoidf_(float x) { return __builtin_amdgcn_rcpf(1.0f + __expf(-x)); }
__device__ __forceinline__ float softplusf_(float x) { return fmaxf(x, 0.f) + __logf(1.0f + __expf(-fabsf(x))); }
template <int CTRL> __device__ __forceinline__ float dpp_add(float x) {
    return x + __int_as_float(__builtin_amdgcn_update_dpp(0, __float_as_int(x), CTRL, 0xF, 0xF, true));
}
__device__ __forceinline__ float reduce4(float x) { x = dpp_add<0xB1>(x); x = dpp_add<0x4E>(x); return x; }
__device__ __forceinline__ float reduce16(float x) { x = dpp_add<0xB1>(x); x = dpp_add<0x4E>(x); x = dpp_add<0x141>(x); x = dpp_add<0x140>(x); return x; }
__device__ __forceinline__ float reduce8(float x) { x = dpp_add<0xB1>(x); x = dpp_add<0x4E>(x); x = dpp_add<0x141>(x); return x; }
__device__ __forceinline__ float wave_sum(float v) {
    v = reduce16(v);
    const int vi = __float_as_int(v);
    const float r0 = __int_as_float(__builtin_amdgcn_readlane(vi, 0)), r1 = __int_as_float(__builtin_amdgcn_readlane(vi, 16)), r2 = __int_as_float(__builtin_amdgcn_readlane(vi, 32)), r3 = __int_as_float(__builtin_amdgcn_readlane(vi, 48));
    return (r0 + r1) + (r2 + r3);
}

__device__ __forceinline__ void phase_mod(unsigned char* lds, kparams_t p, int tid, int bid, int G) {
    float* sc = (float*)lds;
    float* part = (float*)(lds + 36864);
    const float* c = p->in[1]; const float* cctx = p->in[3]; const float* ada_w = p->in[4]; const float* ada_b = p->in[5];
    float* MOD = (float*)(p->ws + WS_MOD);
    for (int i = tid; i < 9 * 1024; i += NTHREADS) { const float x = i < 8192 ? c[i] : cctx[i - 8192]; sc[i] = x * sigmoidf_(x); }
    __syncthreads();
    const int cl = tid & 31, kg = tid >> 5;
    for (int item = bid; item < NLAYER * 192; item += G) {
        const int l = item / 192, cgp = item % 192, col = cgp * 32 + cl;
        float acc[9];
#pragma unroll
        for (int s = 0; s < 9; ++s) acc[s] = 0.f;
        const float* w = ada_w + ((size_t)l * 1024 + kg * 64) * 6144 + col;
#pragma unroll 16
        for (int kk = 0; kk < 64; ++kk) { const float wv = w[(size_t)kk * 6144];
#pragma unroll
            for (int s = 0; s < 9; ++s) acc[s] = fmaf(sc[s * 1024 + kg * 64 + kk], wv, acc[s]); }
#pragma unroll
        for (int s = 0; s < 9; ++s) part[(kg * 9 + s) * 32 + cl] = acc[s];
        __syncthreads();
        if (tid < 288) { const int s = tid >> 5; float a = ada_b[l * 6144 + col];
#pragma unroll
            for (int k2 = 0; k2 < 16; ++k2) a += part[(k2 * 9 + s) * 32 + cl];
            MOD[((size_t)l * 9 + s) * 6144 + col] = a; }
        __syncthreads();
    }
    float* RC = (float*)(p->ws + WS_ROPE); float* RS = RC + 4096 * 32;
    for (int idx = bid * NTHREADS + tid; idx < 4096 * 32; idx += G * NTHREADS) {
        const int t = idx >> 5, j = idx & 31; const float pos = (float)(j < 16 ? (t >> 6) : (t & 63));
        const float inv = exp2f(-(float)(j & 15) * (13.287712379549449f / 16.0f));
        const float ang = pos * inv; const float rev = ang * 0.15915494309189535f; const float fr = rev - floorf(rev);
        const float a2 = fr * 6.283185307179586f;
        RC[idx] = __cosf(a2); RS[idx] = __sinf(a2);
    }
}

__device__ __forceinline__ void transpose_item(const float* W, int K, int N, bf16_t* WT, int k0, int n0, int drow0, LAS float* scr, int lane) {
#pragma unroll 16
    for (int i = 0; i < 32; ++i) { const int kk = 2 * i + (lane >> 5); scr[kk * 33 + (lane & 31)] = W[(size_t)(k0 + kk) * N + n0 + (lane & 31)]; }
    asm volatile("s_waitcnt lgkmcnt(0)" ::: "memory");
    const int c = lane & 7;
#pragma unroll
    for (int j = 0; j < 4; ++j) { const int n = (lane >> 3) + 8 * j; const LAS float* s = scr + (8 * c) * 33 + n;
        u32x4 o; o.x = pk2(s[0 * 33], s[1 * 33]); o.y = pk2(s[2 * 33], s[3 * 33]); o.z = pk2(s[4 * 33], s[5 * 33]); o.w = pk2(s[6 * 33], s[7 * 33]);
        *(u32x4*)(WT + (size_t)(drow0 + n) * K + k0 + 8 * c) = o; }
    asm volatile("s_waitcnt lgkmcnt(0)" ::: "memory");
}
__device__ __forceinline__ void convert_weights(unsigned char* lds, kparams_t p, int l, int gw, int ngw, int wave, int lane) {
    LAS float* scr = (LAS float*)((LAS unsigned char*)lds + wave * 16384);
    unsigned char* wt = p->ws + WS_WT;
    constexpr int I_IN = 16 * 85, I_OUT = 16 * 32, I_G = 16 * 88, I_D = 44 * 32;
    constexpr int NIT = I_IN + I_OUT + 2 * I_G + I_D;
    for (int it = gw; it < NIT; it += ngw) {
        int r = it;
        if (r < I_IN) { const int kb = r / 85, nb = r % 85; transpose_item(p->in[8] + (size_t)l * DM * INC, DM, INC, (bf16_t*)(wt + WT_IN), kb * 64, nb * 32, nb * 32, scr, lane); continue; } r -= I_IN;
        if (r < I_OUT) { const int kb = r / 32, nb = r % 32; transpose_item(p->in[9] + (size_t)l * DM * DM, DM, DM, (bf16_t*)(wt + WT_OUT), kb * 64, nb * 32, nb * 32, scr, lane); continue; } r -= I_OUT;
        if (r < I_G) { const int kb = r / 88, nb = r % 88, n0 = nb * 32; transpose_item(p->in[25] + (size_t)l * DM * FF, DM, FF, (bf16_t*)(wt + WT_GU), kb * 64, n0, (n0 >> 7) * 256 + (n0 & 127), scr, lane); continue; } r -= I_G;
        if (r < I_G) { const int kb = r / 88, nb = r % 88, n0 = nb * 32; transpose_item(p->in[26] + (size_t)l * DM * FF, DM, FF, (bf16_t*)(wt + WT_GU), kb * 64, n0, (n0 >> 7) * 256 + 128 + (n0 & 127), scr, lane); continue; } r -= I_G;
        { const int kb = r / 32, nb = r % 32; transpose_item(p->in[27] + (size_t)l * FF * DM, FF, DM, (bf16_t*)(wt + WT_DN), kb * 64, nb * 32, nb * 32, scr, lane); }
    }
}

__device__ __forceinline__ void norm_mod_rows(const float* srcL, const float* srcC, const float* gamma, const float* modl, int shoff, int scoff, bf16_t* XN, int nrows, int gw, int ngw, int lane) {
    int m = gw; f32x4 v[4];
    if (m < nrows) { const float* xr = m < ML ? srcL + (size_t)m * DM : srcC + (size_t)(m - ML) * DM;
#pragma unroll
        for (int j = 0; j < 4; ++j) v[j] = ((const f32x4*)xr)[lane + 64 * j]; }
    while (m < nrows) {
        const int mn = m + ngw; f32x4 vn[4];
        if (mn < nrows) { const float* xr = mn < ML ? srcL + (size_t)mn * DM : srcC + (size_t)(mn - ML) * DM;
#pragma unroll
            for (int j = 0; j < 4; ++j) vn[j] = ((const f32x4*)xr)[lane + 64 * j]; }
        const int s = m < ML ? (m >> 12) : 8; const float* md = modl + (size_t)s * 6144;
        float ss = 0.f;
#pragma unroll
        for (int j = 0; j < 4; ++j) ss += (v[j].x * v[j].x + v[j].y * v[j].y) + (v[j].z * v[j].z + v[j].w * v[j].w);
        const float rstd = rsqrtf(wave_sum(ss) * (1.0f / DM) + 1e-6f);
#pragma unroll
        for (int j = 0; j < 4; ++j) { const int c4 = lane + 64 * j; const f32x4 g = ((const f32x4*)gamma)[c4], sc = ((const f32x4*)(md + scoff))[c4], sh = ((const f32x4*)(md + shoff))[c4];
            const f32x4 y = (v[j] * rstd * g) * (sc + 1.0f) + sh; u32x2 o; o.x = cvtpk(y.x, y.y); o.y = cvtpk(y.z, y.w);
            ((u32x2*)(XN + (size_t)m * DM))[c4] = o; }
#pragma unroll
        for (int j = 0; j < 4; ++j) v[j] = vn[j];
        m = mn;
    }
}
__device__ __forceinline__ void final_norm_rows(float* x, const float* gamma, int gw, int ngw, int lane) {
    for (int m = gw; m < ML; m += ngw) {
        float* xr = x + (size_t)m * DM; f32x4 v[4]; float ss = 0.f;
#pragma unroll
        for (int j = 0; j < 4; ++j) { v[j] = ((const f32x4*)xr)[lane + 64 * j]; ss += (v[j].x * v[j].x + v[j].y * v[j].y) + (v[j].z * v[j].z + v[j].w * v[j].w); }
        const float rstd = rsqrtf(wave_sum(ss) * (1.0f / DM) + 1e-6f);
#pragma unroll
        for (int j = 0; j < 4; ++j) { const int c4 = lane + 64 * j; ((f32x4*)xr)[c4] = v[j] * rstd * ((const f32x4*)gamma)[c4]; }
    }
}
#define XB_TMO      128
#define XB_XCNT(j)  (256  + 64 * (j))
#define XB_XSUB(j)  (1280 + 64 * (j))
#define XB_XGEN(j)  (2304 + 64 * (j))
#define XB_TOP      3328
#define XB_TOPGEN   3392
#define XCD_BAR_WORDS 3456
#define XB_SPIN_CAP (1u << 18)

__device__ __forceinline__ unsigned xb_ld(unsigned* p)              { return __hip_atomic_load(p, __ATOMIC_RELAXED, __HIP_MEMORY_SCOPE_AGENT); }
__device__ __forceinline__ unsigned xb_add(unsigned* p, unsigned v) { return __hip_atomic_fetch_add(p, v, __ATOMIC_RELAXED, __HIP_MEMORY_SCOPE_AGENT); }
__device__ __forceinline__ unsigned xb_xcc_id() { return (unsigned)__builtin_amdgcn_s_getreg((3 << 11) | 20) & 0xFu; }
#define XB_SPIN(cond, bar) do { unsigned _sp = 0; while (cond) { __builtin_amdgcn_s_sleep(1); \
    if ((++_sp & 255u) == 0u) { if (xb_ld(&(bar)[XB_TMO])) break; if (_sp > XB_SPIN_CAP) { atomicAdd(&(bar)[XB_TMO], 1u); break; } } } } while (0)

struct XcdBarrier {
    unsigned* bar; unsigned x;
    volatile LAS unsigned* st;
};

__device__ __forceinline__ XcdBarrier xcd_barrier_post(unsigned* bar, volatile LAS unsigned* st) {
    XcdBarrier b; b.bar = bar; b.x = xb_xcc_id(); b.st = st;
    if (threadIdx.x == 0) (void)xb_add(&bar[XB_XCNT(b.x)], 1u);
    return b;
}
__device__ __forceinline__ void xcd_barrier_complete(unsigned* bar, unsigned x, unsigned& nloc, unsigned& nx) {
    const unsigned G = gridDim.x * gridDim.y * gridDim.z;
    unsigned sum, cnt, mine, sp = 0u;
    for (;;) {
        sum = 0u; cnt = 0u; mine = 0u;
#pragma unroll
        for (unsigned j = 0; j < 16; ++j) { const unsigned c = xb_ld(&bar[XB_XCNT(j)]); sum += c; cnt += (c > 0u) ? 1u : 0u; mine = (j == x) ? c : mine; }
        if (sum == G) break;
        __builtin_amdgcn_s_sleep(1);
        if ((++sp & 255u) == 0u) { if (xb_ld(&bar[XB_TMO])) break; if (sp > XB_SPIN_CAP) { atomicAdd(&bar[XB_TMO], 1u); break; } }
    }
    nloc = mine > 0u ? mine : 1u; nx = cnt > 0u ? cnt : 1u;
}

__device__ __forceinline__ void xcd_barrier(const XcdBarrier& b) {
    asm volatile("s_waitcnt vmcnt(0)" ::: "memory");
    __syncthreads();
    if (threadIdx.x == 0) {
        unsigned* bar = b.bar;
        __builtin_amdgcn_s_waitcnt(0);
        unsigned nloc = b.st[0], nx = b.st[1];
        if (nloc == 0u) { xcd_barrier_complete(bar, b.x, nloc, nx); b.st[0] = nloc; b.st[1] = nx; }
        const unsigned old = xb_add(&bar[XB_XSUB(b.x)], 1u);
        const unsigned gen = old / nloc;
        if (old + 1u == (gen + 1u) * nloc) {
            __builtin_amdgcn_fence(__ATOMIC_RELEASE, "agent");
            asm volatile("s_waitcnt vmcnt(0)" ::: "memory");
            const unsigned og = xb_add(&bar[XB_TOP], 1u);
            const unsigned tg = og / nx;
            if (og + 1u == (tg + 1u) * nx) xb_add(&bar[XB_TOPGEN], 1u);
            else XB_SPIN(xb_ld(&bar[XB_TOPGEN]) == tg, bar);
            __builtin_amdgcn_fence(__ATOMIC_ACQUIRE, "agent");
            xb_add(&bar[XB_XGEN(b.x)], 1u);
            asm volatile("s_waitcnt vmcnt(0)" ::: "memory");
        } else {
            XB_SPIN(xb_ld(&bar[XB_XGEN(b.x)]) == gen, bar);
            __builtin_amdgcn_fence(__ATOMIC_ACQUIRE, "agent");
            asm volatile("s_waitcnt vmcnt(0)" ::: "memory");
        }
    }
    __syncthreads();
}
__device__ __forceinline__ bf16x8 load_wfrag(const float* W, int k0, int c) {
    u32x4 t; t.x = pk2(W[(k0 + 0) * 256 + c], W[(k0 + 1) * 256 + c]); t.y = pk2(W[(k0 + 2) * 256 + c], W[(k0 + 3) * 256 + c]);
    t.z = pk2(W[(k0 + 4) * 256 + c], W[(k0 + 5) * 256 + c]); t.w = pk2(W[(k0 + 6) * 256 + c], W[(k0 + 7) * 256 + c]);
    return __builtin_bit_cast(bf16x8, t);
}
__device__ __forceinline__ u32x2 pack_h4(float a, float b, float c, float d) {
    const h4 v = {(hf)a, (hf)b, (hf)c, (hf)d}; return __builtin_bit_cast(u32x2, v);
}
__device__ __forceinline__ void phase_prep(unsigned char* ldsg, kparams_t p, int l, int tid, int bid, int G, bool do_rope) {
    LAS unsigned char* lds = (LAS unsigned char*)ldsg;
    LAS float* SH = (LAS float*)lds;
    LAS unsigned char* ACT = lds + 73728;
    LAS float* KK = (LAS float*)(lds + 86272);
    LAS float* GL = (LAS float*)(lds + 102656);
    const int lane = tid & 63, wave = tid >> 6, fr = lane & 15, quad = lane >> 4;
    bf16_t* P1 = (bf16_t*)(p->ws + WS_P1); const bf16_t* RAW = (const bf16_t*)(p->ws + WS_RAW);
    hf* PREP = (hf*)(p->ws + WS_PREP); hf* PG = (hf*)(p->ws + WS_PG); hf* GG = (hf*)(p->ws + WS_GG); float* BONUS = (float*)(p->ws + WS_BONUS);
    const float* RC = (const float*)(p->ws + WS_ROPE); const float* RS = RC + 4096 * 32;
    const float* shw = p->in[14] + (size_t)l * 3 * RAWC;
    const float* w0 = p->in[15] + (size_t)l * 512; const float* w2 = p->in[16] + (size_t)l * 2 * 64 * 256;
    const float* a0 = p->in[17] + (size_t)l * 512; const float* a2 = p->in[18] + (size_t)l * 2 * 64 * 256;
    const float* g2 = p->in[19] + (size_t)l * 128 * 256;
    const float* k_k = p->in[20] + l * 256; const float* k_a = p->in[21] + l * 256; const float* r_k = p->in[22] + l * 256;
    const float* dw = p->in[10] + (size_t)l * 2 * 16 * 128; const float* db = p->in[11] + l * 256;
    bf16x8 Fw[2][2][2], Fa[2][2][2], Fg[2][4];
#pragma unroll
    for (int ct2 = 0; ct2 < 2; ++ct2) { const int c = (wave * 2 + ct2) * 16 + fr;
#pragma unroll
        for (int i = 0; i < 2; ++i)
#pragma unroll
            for (int ks = 0; ks < 2; ++ks) { Fw[i][ct2][ks] = load_wfrag(w2 + (size_t)i * 64 * 256, ks * 32 + quad * 8, c); Fa[i][ct2][ks] = load_wfrag(a2 + (size_t)i * 64 * 256, ks * 32 + quad * 8, c); }
#pragma unroll
        for (int ks = 0; ks < 4; ++ks) Fg[ct2][ks] = load_wfrag(g2, ks * 32 + quad * 8, c); }
    const int cgp = tid % 144, part = tid / 144, c8 = cgp * 8;
    const int tokb = part == 0 ? 0 : (part == 1 ? 6 : 11), toke = part == 0 ? 6 : (part == 1 ? 11 : 16);
    for (int tile = bid; tile < MT / 16; tile += G) {
        const int row0 = tile * 16; const bool lat = row0 < ML;
        const int t0 = lat ? (row0 & 4095) : ((row0 - ML) & 255); const int T = lat ? 4096 : 256;
        if (part < 3) {
            float sw0[8], sw1[8], sw2[8];
#pragma unroll
            for (int e = 0; e < 8; ++e) { sw0[e] = shw[c8 + e]; sw1[e] = shw[RAWC + c8 + e]; sw2[e] = shw[2 * RAWC + c8 + e]; }
            const u32x4 z4 = {0u, 0u, 0u, 0u};
            const bf16_t* rp = RAW + (size_t)(row0 + tokb) * RAWC + c8;
            const int ntok = toke - tokb;
            u32x4 rw[8];
#pragma unroll
            for (int j = 0; j < 8; ++j) { const int tt = t0 + tokb - 1 + j; rw[j] = (j < ntok + 2 && tt >= 0 && tt < T) ? *(const u32x4*)(rp + (ptrdiff_t)(j - 1) * RAWC) : z4; }
#pragma unroll
            for (int j = 0; j < 6; ++j) {
                if (j < ntok) {
                    const int tok = tokb + j; const u32x4 prv = rw[j], cur = rw[j + 1], nxt = rw[j + 2];
                    f32x4 o0, o1;
#pragma unroll
                    for (int e = 0; e < 4; ++e) {
                        const float x0 = sw0[2 * e] * bflo(prv[e]) + sw1[2 * e] * bflo(cur[e]) + sw2[2 * e] * bflo(nxt[e]);
                        const float x1 = sw0[2 * e + 1] * bfhi(prv[e]) + sw1[2 * e + 1] * bfhi(cur[e]) + sw2[2 * e + 1] * bfhi(nxt[e]);
                        if (e < 2) { o0[2 * e] = x0; o0[2 * e + 1] = x1; } else { o1[2 * e - 4] = x0; o1[2 * e - 3] = x1; }
                    }
                    *(LAS f32x4*)(SH + tok * RAWC + c8) = o0; *(LAS f32x4*)(SH + tok * RAWC + c8 + 4) = o1;
                }
            }
        }
        { const int tok = tid >> 5, j = tid & 31; GL[j * 16 + tok] = bf2f(P1[(size_t)(row0 + tok) * P1C + 768 + j]); }
        __syncthreads();
        for (int idx = tid; idx < 16 * 192; idx += NTHREADS) {
            const int tok = idx / 192, j2 = (idx % 192) * 2; const float xa = SH[tok * RAWC + 768 + j2], xb = SH[tok * RAWC + 768 + j2 + 1];
            float ya, yb;
            if (j2 < 128) { ya = 1.0f - 2.0f * __builtin_amdgcn_rcpf(__expf(2.0f * xa) + 1.0f); yb = 1.0f - 2.0f * __builtin_amdgcn_rcpf(__expf(2.0f * xb) + 1.0f); }
            else if (j2 < 256) { ya = xa; yb = xb; }
            else { ya = sigmoidf_(xa); yb = sigmoidf_(xb); }
            *(LAS unsigned*)(ACT + tok * 784 + j2 * 2) = cvtpk(ya, yb);
        }
#pragma unroll 1
        for (int i = 0; i < 8; ++i) {
            const int pair = wave * 8 + i, tok = pair >> 2, h = pair & 3, c = h * 64 + lane; const size_t row = row0 + tok;
            const float r = SH[tok * RAWC + c], k = SH[tok * RAWC + 256 + c], v = SH[tok * RAWC + 512 + c];
            const float val = k * k_k[c]; const float ss = wave_sum(val * val); const float kk = val * rsqrtf(ss + 1e-12f);
            KK[tok * 256 + c] = kk;
            const float bon = wave_sum(r * k * r_k[c]);
            if (lane == 0) BONUS[row * 4 + h] = bon;
            PREP[row * PRC + c] = (hf)r; PREP[row * PRC + 256 + c] = (hf)kk; PREP[row * PRC + 512 + c] = (hf)v;
        }
        __syncthreads();
        {
#define BFRAG(s2) (*(const LAS bf16x8*)(ACT + fr * 784 + ((s2) * 32 + quad * 8) * 2))
            const size_t row = row0 + fr;
#pragma unroll
            for (int ct2 = 0; ct2 < 2; ++ct2) {
                const int c0 = (wave * 2 + ct2) * 16 + quad * 4;
                const f32x4 zf = {0.f, 0.f, 0.f, 0.f};
                const f32x4 k4 = *(const LAS f32x4*)(SH + fr * RAWC + 256 + c0), kk4 = *(const LAS f32x4*)(KK + fr * 256 + c0), ka4 = *(const f32x4*)(k_a + c0);
#pragma unroll
                for (int i = 0; i < 2; ++i) {
                    f32x4 aw = __builtin_amdgcn_mfma_f32_16x16x32_bf16(Fw[i][ct2][0], BFRAG(i * 2), zf, 0, 0, 0); aw = __builtin_amdgcn_mfma_f32_16x16x32_bf16(Fw[i][ct2][1], BFRAG(i * 2 + 1), aw, 0, 0, 0);
                    f32x4 aa = __builtin_amdgcn_mfma_f32_16x16x32_bf16(Fa[i][ct2][0], BFRAG(4 + i * 2), zf, 0, 0, 0); aa = __builtin_amdgcn_mfma_f32_16x16x32_bf16(Fa[i][ct2][1], BFRAG(4 + i * 2 + 1), aa, 0, 0, 0);
                    const f32x4 z = aw + *(const f32x4*)(w0 + i * 256 + c0), az = aa + *(const f32x4*)(a0 + i * 256 + c0);
                    float dec[4], bb[4], kd[4];
#pragma unroll
                    for (int j = 0; j < 4; ++j) { dec[j] = __expf(-__expf(-softplusf_(-z[j]) - 0.5f)); const float a = sigmoidf_(az[j]); bb[j] = -(kk4[j] * a); kd[j] = k4[j] * (1.0f + (a - 1.0f) * ka4[j]); }
                    hf* dst = PREP + row * PRC + 768 + i * 768 + c0;
                    *(u32x2*)dst = pack_h4(dec[0], dec[1], dec[2], dec[3]); *(u32x2*)(dst + 256) = pack_h4(bb[0], bb[1], bb[2], bb[3]); *(u32x2*)(dst + 512) = pack_h4(kd[0], kd[1], kd[2], kd[3]);
                }
                f32x4 ag = __builtin_amdgcn_mfma_f32_16x16x32_bf16(Fg[ct2][0], BFRAG(8), zf, 0, 0, 0);
#pragma unroll
                for (int ks = 1; ks < 4; ++ks) ag = __builtin_amdgcn_mfma_f32_16x16x32_bf16(Fg[ct2][ks], BFRAG(8 + ks), ag, 0, 0, 0);
                *(u32x2*)(GG + row * 256 + c0) = pack_h4(ag[0], ag[1], ag[2], ag[3]);
            }
        }
        {
            const int c = tid & 127, i = (tid >> 7) & 1, th = tid >> 8;
            float acc[8]; const float bb = db[i * 128 + c];
#pragma unroll
            for (int q = 0; q < 8; ++q) acc[q] = bb;
            const float* W = dw + (size_t)i * 16 * 128 + c;
#pragma unroll
            for (int j = 0; j < 16; ++j) { const float wv = W[j * 128]; const f32x4 ta = *(const LAS f32x4*)(GL + (i * 16 + j) * 16 + th * 8), tb = *(const LAS f32x4*)(GL + (i * 16 + j) * 16 + th * 8 + 4);
                acc[0] = fmaf(ta.x, wv, acc[0]); acc[1] = fmaf(ta.y, wv, acc[1]); acc[2] = fmaf(ta.z, wv, acc[2]); acc[3] = fmaf(ta.w, wv, acc[3]);
                acc[4] = fmaf(tb.x, wv, acc[4]); acc[5] = fmaf(tb.y, wv, acc[5]); acc[6] = fmaf(tb.z, wv, acc[6]); acc[7] = fmaf(tb.w, wv, acc[7]); }
#pragma unroll
            for (int q = 0; q < 8; ++q) { const float glog = -softplusf_(-acc[q]) * (1.0f / 16.0f); PG[(size_t)(row0 + th * 8 + q) * PGC + 256 + i * 128 + c] = (hf)__expf(glog); }
            { const int tok = tid >> 5, c8q = (tid & 31) * 8; const u32x4 x = *(const u32x4*)(P1 + (size_t)(row0 + tok) * P1C + c8q); const float sc = c8q < 128 ? 0.17677669529663687f : 1.0f;
              u32x4 o;
#pragma unroll
              for (int e = 0; e < 4; ++e) { const h4 t = {(hf)(bflo(x[e]) * sc), (hf)(bfhi(x[e]) * sc), (hf)0.f, (hf)0.f}; o[e] = __builtin_bit_cast(u32x2, t).x; }
              *(u32x4*)(PG + (size_t)(row0 + tok) * PGC + c8q) = o; }
        }
        if (lat && do_rope) {
            for (int task = tid; task < 640; task += NTHREADS) {
                const int tok = task / 40, r = task % 40, hh = r >> 2, gi = r & 3; const int t = t0 + tok;
                bf16_t* ptr = P1 + (size_t)(row0 + tok) * P1C + 800 + hh * 64 + gi * 8;
                const u32x4 x1 = *(const u32x4*)ptr, x2 = *(const u32x4*)(ptr + 32);
                const f32x4 ca = *(const f32x4*)(RC + t * 32 + gi * 8), cb = *(const f32x4*)(RC + t * 32 + gi * 8 + 4), sa = *(const f32x4*)(RS + t * 32 + gi * 8), sb = *(const f32x4*)(RS + t * 32 + gi * 8 + 4);
                const float cs[8] = {ca.x, ca.y, ca.z, ca.w, cb.x, cb.y, cb.z, cb.w}, sn[8] = {sa.x, sa.y, sa.z, sa.w, sb.x, sb.y, sb.z, sb.w};
                u32x4 o1, o2;
#pragma unroll
                for (int e = 0; e < 4; ++e) {
                    const float a0_ = bflo(x1[e]), a1_ = bfhi(x1[e]), b0_ = bflo(x2[e]), b1_ = bfhi(x2[e]);
                    const float c0_ = cs[2 * e], c1_ = cs[2 * e + 1], s0_ = sn[2 * e], s1_ = sn[2 * e + 1];
                    o1[e] = cvtpk(a0_ * c0_ - b0_ * s0_, a1_ * c1_ - b1_ * s1_); o2[e] = cvtpk(a0_ * s0_ + b0_ * c0_, a1_ * s1_ + b1_ * c1_);
                }
                *(u32x4*)ptr = o1; *(u32x4*)(ptr + 32) = o2;
            }
        }
        __syncthreads();
    }
}
#ifndef NO_MIX
#define MIXLO(d, a, h, c) asm("v_fma_mix_f32 %0, %1, %2, %3 op_sel:[0,0,0] op_sel_hi:[0,1,0]" : "=v"(d) : "v"(a), "v"(h), "v"(c))
#define MIXHI(d, a, h, c) asm("v_fma_mix_f32 %0, %1, %2, %3 op_sel:[0,1,0] op_sel_hi:[0,1,0]" : "=v"(d) : "v"(a), "v"(h), "v"(c))
#else
#define MIXLO(d, a, h, c) d = fmaf(a, (float)__builtin_bit_cast(hf, (unsigned short)((h) & 0xffffu)), c)
#define MIXHI(d, a, h, c) d = fmaf(a, (float)__builtin_bit_cast(hf, (unsigned short)((h) >> 16)), c)
#endif
#define DSR128(dst, addr, OFF) asm volatile("ds_read_b128 %0, %1 offset:" #OFF : "=v"(dst) : "v"(addr))
#define DSR64(dst, addr, OFF) asm volatile("ds_read_b64 %0, %1 offset:" #OFF : "=v"(dst) : "v"(addr))
#define DSR16(dst, addr, OFF) asm volatile("ds_read_u16 %0, %1 offset:" #OFF : "=v"(dst) : "v"(addr))
#define LDS_BAR() do { asm volatile("s_waitcnt lgkmcnt(0)" ::: "memory"); __builtin_amdgcn_s_barrier(); asm volatile("" ::: "memory"); } while (0)
#define REP32(M) M(0) M(1) M(2) M(3) M(4) M(5) M(6) M(7) M(8) M(9) M(10) M(11) M(12) M(13) M(14) M(15) M(16) M(17) M(18) M(19) M(20) M(21) M(22) M(23) M(24) M(25) M(26) M(27) M(28) M(29) M(30) M(31)
__device__ __forceinline__ unsigned lds_addr(LAS unsigned char* p) { return (unsigned)(uintptr_t)p; }

__device__ __forceinline__ int chain_row(int b, int dir, int s) {
    if (s < 256) return ML + b * 256 + (dir ? 255 - s : s);
    const int t = s - 256; return b * 4096 + (dir ? 4095 - t : t);
}
constexpr int NCHUNK = (SEQ + CTXL) / 32;
__device__ __forceinline__ void rwkv_scan_item(unsigned char* ldsg, kparams_t p, int item, int tid, int expflag) {
    LAS unsigned char* lds = (LAS unsigned char*)ldsg;
    constexpr int STEPB = 704, BUFB = 32 * STEPB, NPIECE = 32 * 44;
    LAS unsigned char* obuf = lds + 2 * BUFB;
    const int chain = item >> 1, half_ = item & 1, b = chain >> 3, h = (chain >> 1) & 3, dir = chain & 1;
    const int lane = tid & 63, wave = tid >> 6, kq = lane & 15, rloc = wave * 4 + (lane >> 4);
    const hf* PREP = (const hf*)(p->ws + WS_PREP); hf* OR = (hf*)(p->ws + WS_OR) + (size_t)dir * MT * 256;
    int srcoff[6]; srcoff[0] = h * 64; srcoff[1] = 256 + h * 64; srcoff[2] = 768 + dir * 768 + h * 64; srcoff[3] = srcoff[2] + 256; srcoff[4] = srcoff[2] + 512; srcoff[5] = 512 + h * 64 + half_ * 32;
    float S[4];
#pragma unroll
    for (int i = 0; i < 4; ++i) S[i] = 0.f;
    u32x4 pre[3];
#define RW_ISSUE(cc) do { const bool isctx_ = (cc) < 8; _Pragma("unroll") for (int i_ = 0; i_ < 3; ++i_) { int pp = tid + i_ * NTHREADS; pp = pp < NPIECE ? pp : pp - NTHREADS; const int st = pp / 44, q = pp % 44; \
        const int s_ = (cc) * 32 + st, t_ = s_ - 256; const int row = isctx_ ? (ML + b * 256 + (dir ? 255 - s_ : s_)) : (b * 4096 + (dir ? 4095 - t_ : t_)); \
        const int arr = q >> 3; const int so = arr == 0 ? srcoff[0] : arr == 1 ? srcoff[1] : arr == 2 ? srcoff[2] : arr == 3 ? srcoff[3] : arr == 4 ? srcoff[4] : srcoff[5]; \
        pre[i_] = *(const u32x4*)(PREP + (size_t)row * PRC + so + (q & 7) * 8); } } while (0)
#define RW_COMMIT(cc) do { _Pragma("unroll") for (int i_ = 0; i_ < 3; ++i_) { const int pp = tid + i_ * NTHREADS; if (pp < NPIECE) { const int st = pp / 44, q = pp % 44; \
        *(LAS u32x4*)(lds + ((cc) & 1) * BUFB + st * STEPB + q * 16) = pre[i_]; } } } while (0)
    RW_ISSUE(0); RW_COMMIT(0); RW_ISSUE(1);
    __syncthreads();
    for (int c = 0; c < NCHUNK; ++c) {
        if (expflag != 2) { if (c + 1 < NCHUNK) RW_COMMIT(c + 1);
        if (c + 2 < NCHUNK) RW_ISSUE(c + 2); }
        if (c > 0 && tid < 128) { const int cc = c - 1; const int st = tid >> 2, pc = tid & 3; const int row = chain_row(b, dir, cc * 32 + st);
            *(u32x4*)(OR + (size_t)row * 256 + h * 64 + half_ * 32 + pc * 8) = *(const LAS u32x4*)(obuf + (cc & 1) * 2048 + st * 64 + pc * 16); }
        if (expflag != 1) {
            const unsigned abase = lds_addr(lds + (c & 1) * BUFB) + kq * 8, vbase = lds_addr(lds + (c & 1) * BUFB) + 640 + rloc * 2;
            LAS hf* op = (LAS hf*)(obuf + (c & 1) * 2048 + rloc * 2);
            u32x2 LR[2], LK[2], LW[2], LB[2], LD[2]; unsigned LV[2]; const float zero = 0.f;
#define RW_LOAD(slot, o0, o1, o2, o3, o4) do { DSR64(LR[slot], abase, o0); DSR64(LK[slot], abase, o1); DSR64(LW[slot], abase, o2); DSR64(LB[slot], abase, o3); DSR64(LD[slot], abase, o4); } while (0)
#define RW_COMPUTE(cur, st) do { \
                const float vv = (float)__builtin_bit_cast(hf, (unsigned short)LV[cur]); \
                float sa0 = 0.f, sa1 = 0.f; \
                _Pragma("unroll") for (int i = 0; i < 2; ++i) { MIXLO(sa0, S[2 * i], LK[cur][i], sa0); MIXHI(sa1, S[2 * i + 1], LK[cur][i], sa1); } \
                const float nsa = reduce16(sa0 + sa1); \
                float o0 = 0.f, o1 = 0.f; \
                _Pragma("unroll") for (int i = 0; i < 2; ++i) { float u0, u1; \
                    MIXLO(u0, vv, LD[cur][i], zero); MIXHI(u1, vv, LD[cur][i], zero); \
                    MIXLO(u0, nsa, LB[cur][i], u0); MIXHI(u1, nsa, LB[cur][i], u1); \
                    MIXLO(S[2 * i], S[2 * i], LW[cur][i], u0); MIXHI(S[2 * i + 1], S[2 * i + 1], LW[cur][i], u1); \
                    MIXLO(o0, S[2 * i], LR[cur][i], o0); MIXHI(o1, S[2 * i + 1], LR[cur][i], o1); } \
                const float o = reduce16(o0 + o1); \
                op[(st) * 32] = (hf)o; } while (0)
#define RW_PIN(n, cur) asm volatile("s_waitcnt lgkmcnt(" #n ")" : "+v"(LR[cur]), "+v"(LK[cur]), "+v"(LW[cur]), "+v"(LB[cur]), "+v"(LD[cur]), "+v"(LV[cur]))
            RW_LOAD(0, 0, 128, 256, 384, 512); DSR16(LV[0], vbase, 0);
            RW_LOAD(1, 704, 832, 960, 1088, 1216); DSR16(LV[1], vbase, 704); RW_PIN(6, 0); RW_COMPUTE(0, 0);
            RW_LOAD(0, 1408, 1536, 1664, 1792, 1920); DSR16(LV[0], vbase, 1408); RW_PIN(6, 1); RW_COMPUTE(1, 1);
            RW_LOAD(1, 2112, 2240, 2368, 2496, 2624); DSR16(LV[1], vbase, 2112); RW_PIN(6, 0); RW_COMPUTE(0, 2);
            RW_LOAD(0, 2816, 2944, 3072, 3200, 3328); DSR16(LV[0], vbase, 2816); RW_PIN(6, 1); RW_COMPUTE(1, 3);
            RW_LOAD(1, 3520, 3648, 3776, 3904, 4032); DSR16(LV[1], vbase, 3520); RW_PIN(6, 0); RW_COMPUTE(0, 4);
            RW_LOAD(0, 4224, 4352, 4480, 4608, 4736); DSR16(LV[0], vbase, 4224); RW_PIN(6, 1); RW_COMPUTE(1, 5);
            RW_LOAD(1, 4928, 5056, 5184, 5312, 5440); DSR16(LV[1], vbase, 4928); RW_PIN(6, 0); RW_COMPUTE(0, 6);
            RW_LOAD(0, 5632, 5760, 5888, 6016, 6144); DSR16(LV[0], vbase, 5632); RW_PIN(6, 1); RW_COMPUTE(1, 7);
            RW_LOAD(1, 6336, 6464, 6592, 6720, 6848); DSR16(LV[1], vbase, 6336); RW_PIN(6, 0); RW_COMPUTE(0, 8);
            RW_LOAD(0, 7040, 7168, 7296, 7424, 7552); DSR16(LV[0], vbase, 7040); RW_PIN(6, 1); RW_COMPUTE(1, 9);
            RW_LOAD(1, 7744, 7872, 8000, 8128, 8256); DSR16(LV[1], vbase, 7744); RW_PIN(6, 0); RW_COMPUTE(0, 10);
            RW_LOAD(0, 8448, 8576, 8704, 8832, 8960); DSR16(LV[0], vbase, 8448); RW_PIN(6, 1); RW_COMPUTE(1, 11);
            RW_LOAD(1, 9152, 9280, 9408, 9536, 9664); DSR16(LV[1], vbase, 9152); RW_PIN(6, 0); RW_COMPUTE(0, 12);
            RW_LOAD(0, 9856, 9984, 10112, 10240, 10368); DSR16(LV[0], vbase, 9856); RW_PIN(6, 1); RW_COMPUTE(1, 13);
            RW_LOAD(1, 10560, 10688, 10816, 10944, 11072); DSR16(LV[1], vbase, 10560); RW_PIN(6, 0); RW_COMPUTE(0, 14);
            RW_LOAD(0, 11264, 11392, 11520, 11648, 11776); DSR16(LV[0], vbase, 11264); RW_PIN(6, 1); RW_COMPUTE(1, 15);
            RW_LOAD(1, 11968, 12096, 12224, 12352, 12480); DSR16(LV[1], vbase, 11968); RW_PIN(6, 0); RW_COMPUTE(0, 16);
            RW_LOAD(0, 12672, 12800, 12928, 13056, 13184); DSR16(LV[0], vbase, 12672); RW_PIN(6, 1); RW_COMPUTE(1, 17);
            RW_LOAD(1, 13376, 13504, 13632, 13760, 13888); DSR16(LV[1], vbase, 13376); RW_PIN(6, 0); RW_COMPUTE(0, 18);
            RW_LOAD(0, 14080, 14208, 14336, 14464, 14592); DSR16(LV[0], vbase, 14080); RW_PIN(6, 1); RW_COMPUTE(1, 19);
            RW_LOAD(1, 14784, 14912, 15040, 15168, 15296); DSR16(LV[1], vbase, 14784); RW_PIN(6, 0); RW_COMPUTE(0, 20);
            RW_LOAD(0, 15488, 15616, 15744, 15872, 16000); DSR16(LV[0], vbase, 15488); RW_PIN(6, 1); RW_COMPUTE(1, 21);
            RW_LOAD(1, 16192, 16320, 16448, 16576, 16704); DSR16(LV[1], vbase, 16192); RW_PIN(6, 0); RW_COMPUTE(0, 22);
            RW_LOAD(0, 16896, 17024, 17152, 17280, 17408); DSR16(LV[0], vbase, 16896); RW_PIN(6, 1); RW_COMPUTE(1, 23);
            RW_LOAD(1, 17600, 17728, 17856, 17984, 18112); DSR16(LV[1], vbase, 17600); RW_PIN(6, 0); RW_COMPUTE(0, 24);
            RW_LOAD(0, 18304, 18432, 18560, 18688, 18816); DSR16(LV[0], vbase, 18304); RW_PIN(6, 1); RW_COMPUTE(1, 25);
            RW_LOAD(1, 19008, 19136, 19264, 19392, 19520); DSR16(LV[1], vbase, 19008); RW_PIN(6, 0); RW_COMPUTE(0, 26);
            RW_LOAD(0, 19712, 19840, 19968, 20096, 20224); DSR16(LV[0], vbase, 19712); RW_PIN(6, 1); RW_COMPUTE(1, 27);
            RW_LOAD(1, 20416, 20544, 20672, 20800, 20928); DSR16(LV[1], vbase, 20416); RW_PIN(6, 0); RW_COMPUTE(0, 28);
            RW_LOAD(0, 21120, 21248, 21376, 21504, 21632); DSR16(LV[0], vbase, 21120); RW_PIN(6, 1); RW_COMPUTE(1, 29);
            RW_LOAD(1, 21824, 21952, 22080, 22208, 22336); DSR16(LV[1], vbase, 21824); RW_PIN(6, 0); RW_COMPUTE(0, 30);
            RW_PIN(0, 1); RW_COMPUTE(1, 31);
#undef RW_LOAD
#undef RW_COMPUTE
#undef RW_PIN
        }
        LDS_BAR();
    }
    { const int cc = NCHUNK - 1; if (tid < 128) { const int st = tid >> 2, pc = tid & 3; const int row = chain_row(b, dir, cc * 32 + st);
        *(u32x4*)(OR + (size_t)row * 256 + h * 64 + half_ * 32 + pc * 8) = *(const LAS u32x4*)(obuf + (cc & 1) * 2048 + st * 64 + pc * 16); } }
#undef RW_ISSUE
#undef RW_COMMIT
}
__device__ __forceinline__ void gla_scan_item(unsigned char* ldsg, kparams_t p, int item, int tid) {
    const int chain = item >> 1, half_ = item & 1;
    LAS unsigned char* lds = (LAS unsigned char*)ldsg;
    constexpr int STEPB = 320, BUFB = 32 * STEPB, NPIECE = 32 * 20;
    LAS unsigned char* obuf = lds + 2 * BUFB;
    const int b = chain >> 3, h = (chain >> 1) & 3, dir = chain & 1;
    const int lane = tid & 63, wave = tid >> 6, dq = lane & 7, col = half_ * 32 + (wave & 3) * 8 + (lane >> 3);
    const hf* PG = (const hf*)(p->ws + WS_PG); const bf16_t* P1 = (const bf16_t*)(p->ws + WS_P1); hf* OG = (hf*)(p->ws + WS_OG) + (size_t)dir * MT * 256;
    float S[4];
#pragma unroll
    for (int i = 0; i < 4; ++i) S[i] = 0.f;
    u32x4 pre[3]; const int t4 = tid - 256;
#define GL_ISSUE(cc) do { const bool isctx_ = (cc) < 8; _Pragma("unroll") for (int i_ = 0; i_ < 3; ++i_) { int pp = t4 + i_ * 256; pp = pp < NPIECE ? pp : pp - 256; const int st = pp / 20, q = pp % 20; \
        const int s_ = (cc) * 32 + st, t_ = s_ - 256; const int row = isctx_ ? (ML + b * 256 + (dir ? 255 - s_ : s_)) : (b * 4096 + (dir ? 4095 - t_ : t_)); \
        const int arr = q >> 2; const int so = arr == 0 ? h * 32 : arr == 1 ? 128 + h * 32 : 256 + dir * 128 + h * 32; \
        const unsigned char* sp = q < 12 ? (const unsigned char*)(PG + (size_t)row * PGC + so + (q & 3) * 8) : (const unsigned char*)(P1 + (size_t)row * P1C + 256 + h * 64 + (q - 12) * 8); \
        pre[i_] = *(const u32x4*)sp; } } while (0)
#define GL_COMMIT(cc) do { _Pragma("unroll") for (int i_ = 0; i_ < 3; ++i_) { const int pp = t4 + i_ * 256; if (pp < NPIECE) { const int st = pp / 20, q = pp % 20; \
        *(LAS u32x4*)(lds + ((cc) & 1) * BUFB + st * STEPB + q * 16) = pre[i_]; } } } while (0)
    if (wave >= 4) { GL_ISSUE(0); GL_COMMIT(0); GL_ISSUE(1); }
    __syncthreads();
    for (int c = 0; c < NCHUNK; ++c) {
        if (wave >= 4) {
            if (c + 1 < NCHUNK) GL_COMMIT(c + 1);
            if (c + 2 < NCHUNK) GL_ISSUE(c + 2);
            if (c > 0 && t4 < 128) { const int cc = c - 1; const int st = t4 >> 2, pc = t4 & 3; const int row = chain_row(b, dir, cc * 32 + st);
                *(u32x4*)(OG + (size_t)row * 256 + h * 64 + half_ * 32 + pc * 8) = *(const LAS u32x4*)(obuf + (cc & 1) * 4096 + st * 128 + half_ * 64 + pc * 16); }
        }
        if (wave < 4) {
            const unsigned abase = lds_addr(lds + (c & 1) * BUFB) + dq * 8, vbase = lds_addr(lds + (c & 1) * BUFB) + 192 + col * 2;
            LAS hf* op = (LAS hf*)(obuf + (c & 1) * 4096 + col * 2);
            u32x2 LQ[2], LK[2], LE[2]; unsigned LV[2]; const float zero = 0.f;
#define GL_LOAD(slot, o0, o1, o2) do { DSR64(LQ[slot], abase, o0); DSR64(LK[slot], abase, o1); DSR64(LE[slot], abase, o2); } while (0)
#define GL_COMPUTE(cur, st) do { \
                const float vv = __uint_as_float(LV[cur] << 16); \
                float o0 = 0.f, o1 = 0.f; \
                _Pragma("unroll") for (int i = 0; i < 2; ++i) { float u0, u1; \
                    MIXLO(u0, vv, LK[cur][i], zero); MIXHI(u1, vv, LK[cur][i], zero); \
                    MIXLO(S[2 * i], S[2 * i], LE[cur][i], u0); MIXHI(S[2 * i + 1], S[2 * i + 1], LE[cur][i], u1); \
                    MIXLO(o0, S[2 * i], LQ[cur][i], o0); MIXHI(o1, S[2 * i + 1], LQ[cur][i], o1); } \
                const float o = reduce8(o0 + o1); \
                op[(st) * 64] = (hf)o; } while (0)
#define GL_PIN(n, cur) asm volatile("s_waitcnt lgkmcnt(" #n ")" : "+v"(LQ[cur]), "+v"(LK[cur]), "+v"(LE[cur]), "+v"(LV[cur]))
            GL_LOAD(0, 0, 64, 128); DSR16(LV[0], vbase, 0);
            GL_LOAD(1, 320, 384, 448); DSR16(LV[1], vbase, 320); GL_PIN(4, 0); GL_COMPUTE(0, 0);
            GL_LOAD(0, 640, 704, 768); DSR16(LV[0], vbase, 640); GL_PIN(4, 1); GL_COMPUTE(1, 1);
            GL_LOAD(1, 960, 1024, 1088); DSR16(LV[1], vbase, 960); GL_PIN(4, 0); GL_COMPUTE(0, 2);
            GL_LOAD(0, 1280, 1344, 1408); DSR16(LV[0], vbase, 1280); GL_PIN(4, 1); GL_COMPUTE(1, 3);
            GL_LOAD(1, 1600, 1664, 1728); DSR16(LV[1], vbase, 1600); GL_PIN(4, 0); GL_COMPUTE(0, 4);
            GL_LOAD(0, 1920, 1984, 2048); DSR16(LV[0], vbase, 1920); GL_PIN(4, 1); GL_COMPUTE(1, 5);
            GL_LOAD(1, 2240, 2304, 2368); DSR16(LV[1], vbase, 2240); GL_PIN(4, 0); GL_COMPUTE(0, 6);
            GL_LOAD(0, 2560, 2624, 2688); DSR16(LV[0], vbase, 2560); GL_PIN(4, 1); GL_COMPUTE(1, 7);
            GL_LOAD(1, 2880, 2944, 3008); DSR16(LV[1], vbase, 2880); GL_PIN(4, 0); GL_COMPUTE(0, 8);
            GL_LOAD(0, 3200, 3264, 3328); DSR16(LV[0], vbase, 3200); GL_PIN(4, 1); GL_COMPUTE(1, 9);
            GL_LOAD(1, 3520, 3584, 3648); DSR16(LV[1], vbase, 3520); GL_PIN(4, 0); GL_COMPUTE(0, 10);
            GL_LOAD(0, 3840, 3904, 3968); DSR16(LV[0], vbase, 3840); GL_PIN(4, 1); GL_COMPUTE(1, 11);
            GL_LOAD(1, 4160, 4224, 4288); DSR16(LV[1], vbase, 4160); GL_PIN(4, 0); GL_COMPUTE(0, 12);
            GL_LOAD(0, 4480, 4544, 4608); DSR16(LV[0], vbase, 4480); GL_PIN(4, 1); GL_COMPUTE(1, 13);
            GL_LOAD(1, 4800, 4864, 4928); DSR16(LV[1], vbase, 4800); GL_PIN(4, 0); GL_COMPUTE(0, 14);
            GL_LOAD(0, 5120, 5184, 5248); DSR16(LV[0], vbase, 5120); GL_PIN(4, 1); GL_COMPUTE(1, 15);
            GL_LOAD(1, 5440, 5504, 5568); DSR16(LV[1], vbase, 5440); GL_PIN(4, 0); GL_COMPUTE(0, 16);
            GL_LOAD(0, 5760, 5824, 5888); DSR16(LV[0], vbase, 5760); GL_PIN(4, 1); GL_COMPUTE(1, 17);
            GL_LOAD(1, 6080, 6144, 6208); DSR16(LV[1], vbase, 6080); GL_PIN(4, 0); GL_COMPUTE(0, 18);
            GL_LOAD(0, 6400, 6464, 6528); DSR16(LV[0], vbase, 6400); GL_PIN(4, 1); GL_COMPUTE(1, 19);
            GL_LOAD(1, 6720, 6784, 6848); DSR16(LV[1], vbase, 6720); GL_PIN(4, 0); GL_COMPUTE(0, 20);
            GL_LOAD(0, 7040, 7104, 7168); DSR16(LV[0], vbase, 7040); GL_PIN(4, 1); GL_COMPUTE(1, 21);
            GL_LOAD(1, 7360, 7424, 7488); DSR16(LV[1], vbase, 7360); GL_PIN(4, 0); GL_COMPUTE(0, 22);
            GL_LOAD(0, 7680, 7744, 7808); DSR16(LV[0], vbase, 7680); GL_PIN(4, 1); GL_COMPUTE(1, 23);
            GL_LOAD(1, 8000, 8064, 8128); DSR16(LV[1], vbase, 8000); GL_PIN(4, 0); GL_COMPUTE(0, 24);
            GL_LOAD(0, 8320, 8384, 8448); DSR16(LV[0], vbase, 8320); GL_PIN(4, 1); GL_COMPUTE(1, 25);
            GL_LOAD(1, 8640, 8704, 8768); DSR16(LV[1], vbase, 8640); GL_PIN(4, 0); GL_COMPUTE(0, 26);
            GL_LOAD(0, 8960, 9024, 9088); DSR16(LV[0], vbase, 8960); GL_PIN(4, 1); GL_COMPUTE(1, 27);
            GL_LOAD(1, 9280, 9344, 9408); DSR16(LV[1], vbase, 9280); GL_PIN(4, 0); GL_COMPUTE(0, 28);
            GL_LOAD(0, 9600, 9664, 9728); DSR16(LV[0], vbase, 9600); GL_PIN(4, 1); GL_COMPUTE(1, 29);
            GL_LOAD(1, 9920, 9984, 10048); DSR16(LV[1], vbase, 9920); GL_PIN(4, 0); GL_COMPUTE(0, 30);
            GL_PIN(0, 1); GL_COMPUTE(1, 31);
#undef GL_LOAD
#undef GL_COMPUTE
#undef GL_PIN
        }
        LDS_BAR();
    }
    if (t4 >= 0 && t4 < 128) { const int cc = NCHUNK - 1; const int st = t4 >> 2, pc = t4 & 3; const int row = chain_row(b, dir, cc * 32 + st);
        *(u32x4*)(OG + (size_t)row * 256 + h * 64 + half_ * 32 + pc * 8) = *(const LAS u32x4*)(obuf + (cc & 1) * 4096 + st * 128 + half_ * 64 + pc * 16); }
#undef GL_ISSUE
#undef GL_COMMIT
}
__device__ __forceinline__ bf16x8 mk_op(unsigned a, unsigned b, unsigned c, unsigned d) { const u32x4 t = {a, b, c, d}; return __builtin_bit_cast(bf16x8, t); }
__device__ __forceinline__ void ck_p1_step(const LAS unsigned char* in, LAS unsigned char* KKI, LAS unsigned char* BTI, LAS unsigned char* KDI, LAS unsigned char* RTI, LAS unsigned char* AUP, LAS unsigned char* VTI,
                                           int k, int t, float gprev, float gt, float gC) {
    const float inv = __builtin_amdgcn_rcpf(gt);
    const LAS unsigned char* sp = in + t * 768 + k * 2;
    const float r = (float)*(const LAS hf*)sp, kk = (float)*(const LAS hf*)(sp + 128), nb = (float)*(const LAS hf*)(sp + 384), kd = (float)*(const LAS hf*)(sp + 512), vv = (float)*(const LAS hf*)(sp + 640);
    const float nbi = nb * inv, kdi = kd * inv;
    const unsigned pa = cvtpk(kk * gprev, nbi), pb = cvtpk(kdi, r * gt), pc = cvtpk(nbi * gC, kdi * gC), pd = cvtpk(vv, vv);
    *(LAS unsigned short*)(KKI + t * 144 + k * 2) = (unsigned short)(pa & 0xffffu); *(LAS unsigned short*)(BTI + t * 144 + k * 2) = (unsigned short)(pa >> 16);
    *(LAS unsigned short*)(KDI + t * 144 + k * 2) = (unsigned short)(pb & 0xffffu); *(LAS unsigned short*)(RTI + t * 144 + k * 2) = (unsigned short)(pb >> 16);
    const int slot = (t >> 2) * 8 + (t & 3);
    *(LAS unsigned short*)(AUP + k * 80 + slot * 2) = (unsigned short)(pc & 0xffffu); *(LAS unsigned short*)(AUP + k * 80 + (slot + 4) * 2) = (unsigned short)(pc >> 16);
    *(LAS unsigned short*)(VTI + k * 32 + t * 2) = (unsigned short)(pd & 0xffffu);
}
__device__ __forceinline__ void rwkv_chunk_item(unsigned char* ldsg, kparams_t p, int chain, int tid, int expflag) {
    (void)expflag;
    LAS unsigned char* lds = (LAS unsigned char*)ldsg;
    constexpr int INB = 16 * 768, NPIECE = 16 * 48, NCH = (SEQ + CTXL) / 16, IMGB = 16640;
    LAS unsigned char* IMG0 = lds + 3 * INB;
    LAS unsigned char* SM0 = IMG0 + 3 * IMGB;
    LAS unsigned char* NI = SM0;
    LAS unsigned char* MMI = NI + 4096;
    LAS unsigned char* AOI = MMI + 512;
    LAS unsigned char* OBI = SM0 + 2 * 5632;
    const int b = chain >> 3, h = (chain >> 1) & 3, dir = chain & 1;
    const int lane = tid & 63, wave = __builtin_amdgcn_readfirstlane(tid >> 6), fr = lane & 15, quad = lane >> 4;
    const hf* PREP = (const hf*)(p->ws + WS_PREP); hf* OR = (hf*)(p->ws + WS_OR) + (size_t)dir * MT * 256;
    const int so0 = h * 64, so1 = 256 + h * 64, so2 = 768 + dir * 768 + h * 64, so5 = 512 + h * 64;
    u32x4 pre[2];
    const int pp0_ = tid, pp1_ = tid < 256 ? tid + 512 : tid;
    const int st0_ = pp0_ / 48, q0_ = pp0_ % 48, st1_ = pp1_ / 48, q1_ = pp1_ % 48;
    const int ar0_ = q0_ >> 3, ar1_ = q1_ >> 3;
    const int sof0_ = (ar0_ == 0 ? so0 : ar0_ == 1 ? so1 : ar0_ == 2 ? so2 : ar0_ == 3 ? so2 + 256 : ar0_ == 4 ? so2 + 512 : so5) + (q0_ & 7) * 8;
    const int sof1_ = (ar1_ == 0 ? so0 : ar1_ == 1 ? so1 : ar1_ == 2 ? so2 : ar1_ == 3 ? so2 + 256 : ar1_ == 4 ? so2 + 512 : so5) + (q1_ & 7) * 8;
    const hf* pl0_ = PREP + (size_t)(b * 4096 + (dir ? 4095 - st0_ : st0_)) * PRC + sof0_;
    const hf* pl1_ = PREP + (size_t)(b * 4096 + (dir ? 4095 - st1_ : st1_)) * PRC + sof1_;
    const hf* cur0_ = PREP + (size_t)(ML + b * 256 + (dir ? 255 - st0_ : st0_)) * PRC + sof0_;
    const hf* cur1_ = PREP + (size_t)(ML + b * 256 + (dir ? 255 - st1_ : st1_)) * PRC + sof1_;
    const ptrdiff_t stepH_ = (ptrdiff_t)(dir ? -16 : 16) * PRC;
    const int lo0_ = st0_ * 768 + q0_ * 16, lo1_ = st1_ * 768 + q1_ * 16;
    int icc_ = 0, cbuf_ = 0, wcc_ = 0;
    const int wst_ = (tid & 127) >> 3, wpc_ = tid & 7;
    hf* wcur_ = OR + (size_t)(ML + b * 256 + (dir ? 255 - wst_ : wst_)) * 256 + h * 64 + wpc_ * 8;
    hf* wlat_ = OR + (size_t)(b * 4096 + (dir ? 4095 - wst_ : wst_)) * 256 + h * 64 + wpc_ * 8;
    const ptrdiff_t wstep_ = (ptrdiff_t)(dir ? -16 : 16) * 256;
#define CK_ISSUE(cc) do { if (icc_ == 16) { cur0_ = pl0_; cur1_ = pl1_; } pre[0] = *(const u32x4*)cur0_; pre[1] = *(const u32x4*)cur1_; cur0_ += stepH_; cur1_ += stepH_; ++icc_; } while (0)
#define CK_COMMIT(cc) do { *(LAS u32x4*)(lds + cbuf_ + lo0_) = pre[0]; if (tid < 256) *(LAS u32x4*)(lds + cbuf_ + lo1_) = pre[1]; cbuf_ = (cbuf_ == 2 * INB) ? 0 : cbuf_ + INB; } while (0)
#define CK_WRITEOUT(cc) do { if (wcc_ == 16) wcur_ = wlat_; if (tid < 128) *(u32x4*)wcur_ = *(const LAS u32x4*)(OBI + ((cc) & 1) * 2048 + wst_ * 128 + wpc_ * 16); wcur_ += wstep_; ++wcc_; } while (0)
    float gq0 = 1.f, gq1 = 1.f, gq2 = 1.f, gq3 = 1.f, gq4 = 1.f, gqC = 1.f;
#define CK_P1A(cc) do { const LAS unsigned char* in_ = lds + ((cc) % 3) * INB; LAS unsigned char* im_ = IMG0 + ((cc) % 3) * IMGB; const int wv_ = wave - 4, tb_ = wv_ * 4; \
        float w_[16]; _Pragma("unroll") for (int i_ = 0; i_ < 16; ++i_) w_[i_] = (float)*(const LAS hf*)(in_ + i_ * 768 + 256 + lane * 2); \
        const float G0_ = (w_[0] * w_[1]) * (w_[2] * w_[3]), G1_ = (w_[4] * w_[5]) * (w_[6] * w_[7]), G2_ = (w_[8] * w_[9]) * (w_[10] * w_[11]), G3_ = (w_[12] * w_[13]) * (w_[14] * w_[15]); \
        const float pfx_ = (wv_ > 0 ? G0_ : 1.f) * ((wv_ > 1 ? G1_ : 1.f) * (wv_ > 2 ? G2_ : 1.f)); \
        const float sfx_ = (wv_ < 3 ? G3_ : 1.f) * ((wv_ < 2 ? G2_ : 1.f) * (wv_ < 1 ? G1_ : 1.f)); \
        const LAS unsigned char* ow_ = in_ + tb_ * 768 + 256 + lane * 2; \
        const float o0_ = (float)*(const LAS hf*)ow_, o1_ = (float)*(const LAS hf*)(ow_ + 768), o2_ = (float)*(const LAS hf*)(ow_ + 1536), o3_ = (float)*(const LAS hf*)(ow_ + 2304); \
        gq0 = pfx_; gq1 = gq0 * o0_; gq2 = gq1 * o1_; gq3 = gq2 * o2_; gq4 = gq3 * o3_; gqC = gq4 * sfx_; \
        if (wave == 4) *(LAS float*)(im_ + 14336 + lane * 4) = gqC; \
        ck_p1_step(in_, im_, im_ + 2304, im_ + 4608, im_ + 6912, im_ + 9216, im_ + 14592, lane, tb_, gq0, gq1, gqC); \
        ck_p1_step(in_, im_, im_ + 2304, im_ + 4608, im_ + 6912, im_ + 9216, im_ + 14592, lane, tb_ + 1, gq1, gq2, gqC);  } while (0)
#define CK_P1B(cc) do { const LAS unsigned char* in_ = lds + ((cc) % 3) * INB; LAS unsigned char* im_ = IMG0 + ((cc) % 3) * IMGB; const int tb_ = (wave - 4) * 4; \
        ck_p1_step(in_, im_, im_ + 2304, im_ + 4608, im_ + 6912, im_ + 9216, im_ + 14592, lane, tb_ + 2, gq2, gq3, gqC); \
        ck_p1_step(in_, im_, im_ + 2304, im_ + 4608, im_ + 6912, im_ + 9216, im_ + 14592, lane, tb_ + 3, gq3, gq4, gqC); } while (0)
    f32x4 St[4];
#pragma unroll
    for (int i = 0; i < 4; ++i) St[i] = (f32x4){0.f, 0.f, 0.f, 0.f};
    CK_ISSUE(0); CK_COMMIT(0); CK_ISSUE(1); CK_COMMIT(1); CK_ISSUE(2); CK_COMMIT(2); CK_ISSUE(3);
    __syncthreads();
    if (wave >= 4) { CK_P1A(0); CK_P1B(0); CK_P1A(1); CK_P1B(1); }
    LDS_BAR();
    {   const int c = -1;
        LAS unsigned char* im = IMG0 + ((c + 1) % 3) * IMGB;
        LAS unsigned char* KKI = im; LAS unsigned char* BTI = im + 2304; LAS unsigned char* KDI = im + 4608; LAS unsigned char* RTI = im + 6912;
        LAS unsigned char* NI = SM0 + ((c + 1) & 1) * 5632; LAS unsigned char* MMI = NI + 4096; LAS unsigned char* AOI = MMI + 512;
        (void)NI; (void)MMI; (void)AOI;
        f32x4 accN = (f32x4){0.f, 0.f, 0.f, 0.f}, accNT = (f32x4){0.f, 0.f, 0.f, 0.f};
        if (wave < 4) {
            const LAS unsigned char* X = (wave < 2) ? KKI : RTI; const LAS unsigned char* Y = (wave & 1) ? KDI : BTI;
            f32x4 acc = (f32x4){0.f, 0.f, 0.f, 0.f};
#pragma unroll
            for (int ks = 0; ks < 2; ++ks) { const bf16x8 a = *(const LAS bf16x8*)(X + fr * 144 + (ks * 32 + quad * 8) * 2), bb = *(const LAS bf16x8*)(Y + fr * 144 + (ks * 32 + quad * 8) * 2);
                acc = __builtin_amdgcn_mfma_f32_16x16x32_bf16(a, bb, acc, 0, 0, 0);
                if (wave == 0) accNT = __builtin_amdgcn_mfma_f32_16x16x32_bf16(bb, a, accNT, 0, 0, 0); }
            accN = acc;
#pragma unroll
            for (int j = 0; j < 4; ++j) { const int t = quad * 4 + j, i = fr;
                if (wave == 0) { }
                else if (wave == 1) *(LAS unsigned short*)(MMI + (t * 16 + i) * 2) = (unsigned short)f2bf((i < t) ? acc[j] : 0.f);
                else { const int slot = (i >> 2) * 8 + (i & 3) + (wave == 3 ? 4 : 0); *(LAS unsigned short*)(AOI + (t * 32 + slot) * 2) = (unsigned short)f2bf((i <= t) ? acc[j] : 0.f); } }
        }
        if (wave == 0) {
            f32x4 nv, nT;
#pragma unroll
            for (int j = 0; j < 4; ++j) { nv[j] = (fr < quad * 4 + j) ? accN[j] : 0.f;
                                          nT[j] = (quad * 4 + j < fr) ? accNT[j] : 0.f; }
#pragma unroll
            for (int lv = 0; lv < 4; ++lv) {
                const unsigned n01 = cvtpk(nv[0], nv[1]), n23 = cvtpk(nv[2], nv[3]), t01 = cvtpk(nT[0], nT[1]), t23 = cvtpk(nT[2], nT[3]);
                const u32x2 rowv = {t01, t23};
                *(LAS u32x2*)(NI + lv * 1024 + (fr * 16 + quad * 4) * 2) = rowv;
                if (lv < 3) {
                    const f32x4 zf = {0.f, 0.f, 0.f, 0.f};
                    const bf16x8 opN = mk_op(n01, n23, 0u, 0u), opT = mk_op(t01, t23, 0u, 0u);
                    nv = __builtin_amdgcn_mfma_f32_16x16x32_bf16(opT, opN, zf, 0, 0, 0);
                    nT = __builtin_amdgcn_mfma_f32_16x16x32_bf16(opN, opT, zf, 0, 0, 0);
                }
            }
        }
    }
    LDS_BAR();
#pragma unroll 1
    for (int c = 0; c < NCH; ++c) {
        if (c + 3 < NCH) CK_COMMIT(c + 3);
        if (c + 4 < NCH) CK_ISSUE(c + 4);
        if (c > 0) CK_WRITEOUT(c - 1);
        if (wave >= 4) { if (c + 2 < NCH) { CK_P1A(c + 2); CK_P1B(c + 2); } }
        {
            LAS unsigned char* im = IMG0 + (c % 3) * IMGB;
            LAS unsigned char* KKI = im; LAS unsigned char* RTI = im + 6912; LAS unsigned char* AUP = im + 9216;
            LAS float* GC = (LAS float*)(im + 14336); LAS unsigned char* VTI = im + 14592;
            LAS unsigned char* NI = SM0 + (c & 1) * 5632; LAS unsigned char* MMI = NI + 4096; LAS unsigned char* AOI = MMI + 512;
        if (wave < 4) {
            const int vrow = wave * 16 + fr;
            bf16x8 Sb[2], KKa[2], RTa[2];
#pragma unroll
            for (int p2 = 0; p2 < 2; ++p2) {
                Sb[p2] = mk_op(cvtpk(St[2 * p2][0], St[2 * p2][1]), cvtpk(St[2 * p2][2], St[2 * p2][3]), cvtpk(St[2 * p2 + 1][0], St[2 * p2 + 1][1]), cvtpk(St[2 * p2 + 1][2], St[2 * p2 + 1][3]));
                const u32x2 a0 = *(const LAS u32x2*)(KKI + fr * 144 + ((2 * p2) * 16 + quad * 4) * 2), a1 = *(const LAS u32x2*)(KKI + fr * 144 + ((2 * p2 + 1) * 16 + quad * 4) * 2);
                KKa[p2] = mk_op(a0.x, a0.y, a1.x, a1.y);
                const u32x2 r0 = *(const LAS u32x2*)(RTI + fr * 144 + ((2 * p2) * 16 + quad * 4) * 2), r1 = *(const LAS u32x2*)(RTI + fr * 144 + ((2 * p2 + 1) * 16 + quad * 4) * 2);
                RTa[p2] = mk_op(r0.x, r0.y, r1.x, r1.y);
            }
            const f32x4 zf = {0.f, 0.f, 0.f, 0.f};
            f32x4 rhs = __builtin_amdgcn_mfma_f32_16x16x32_bf16(KKa[0], Sb[0], zf, 0, 0, 0); rhs = __builtin_amdgcn_mfma_f32_16x16x32_bf16(KKa[1], Sb[1], rhs, 0, 0, 0);
            const u32x2 vt = *(const LAS u32x2*)(VTI + vrow * 32 + quad * 8), mm = *(const LAS u32x2*)(MMI + fr * 32 + quad * 8);
            rhs = __builtin_amdgcn_mfma_f32_16x16x32_bf16(mk_op(mm.x, mm.y, 0u, 0u), mk_op(vt.x, vt.y, 0u, 0u), rhs, 0, 0, 0);
            f32x4 ut = rhs;
#pragma unroll
            for (int lv = 3; lv >= 0; --lv) { const u32x2 na = *(const LAS u32x2*)(NI + lv * 1024 + (fr * 16 + quad * 4) * 2);
                ut = __builtin_amdgcn_mfma_f32_16x16x32_bf16(mk_op(na.x, na.y, 0u, 0u), mk_op(cvtpk(ut[0], ut[1]), cvtpk(ut[2], ut[3]), 0u, 0u), ut, 0, 0, 0); }
            const bf16x8 UVb = mk_op(cvtpk(ut[0], ut[1]), cvtpk(ut[2], ut[3]), vt.x, vt.y);
            f32x4 ot = __builtin_amdgcn_mfma_f32_16x16x32_bf16(RTa[0], Sb[0], zf, 0, 0, 0); ot = __builtin_amdgcn_mfma_f32_16x16x32_bf16(RTa[1], Sb[1], ot, 0, 0, 0);
            ot = __builtin_amdgcn_mfma_f32_16x16x32_bf16(*(const LAS bf16x8*)(AOI + fr * 64 + quad * 16), UVb, ot, 0, 0, 0);
#pragma unroll
            for (int j = 0; j < 4; ++j) *(LAS hf*)(OBI + (c & 1) * 2048 + ((quad * 4 + j) * 64 + vrow) * 2) = (hf)ot[j];
#pragma unroll
            for (int kt = 0; kt < 4; ++kt) { const f32x4 gc = *(const LAS f32x4*)(GC + kt * 16 + quad * 4);
                St[kt] = __builtin_amdgcn_mfma_f32_16x16x32_bf16(*(const LAS bf16x8*)(AUP + (kt * 16 + fr) * 80 + quad * 16), UVb, St[kt] * gc, 0, 0, 0); }
        }
        }
        if (c + 1 < NCH) {
            LAS unsigned char* im = IMG0 + ((c + 1) % 3) * IMGB;
            LAS unsigned char* KKI = im; LAS unsigned char* BTI = im + 2304; LAS unsigned char* KDI = im + 4608; LAS unsigned char* RTI = im + 6912;
            LAS unsigned char* NI = SM0 + ((c + 1) & 1) * 5632; LAS unsigned char* MMI = NI + 4096; LAS unsigned char* AOI = MMI + 512;
            (void)NI; (void)MMI; (void)AOI;
        f32x4 accN = (f32x4){0.f, 0.f, 0.f, 0.f}, accNT = (f32x4){0.f, 0.f, 0.f, 0.f};
        if (wave < 4) {
            const LAS unsigned char* X = (wave < 2) ? KKI : RTI; const LAS unsigned char* Y = (wave & 1) ? KDI : BTI;
            f32x4 acc = (f32x4){0.f, 0.f, 0.f, 0.f};
#pragma unroll
            for (int ks = 0; ks < 2; ++ks) { const bf16x8 a = *(const LAS bf16x8*)(X + fr * 144 + (ks * 32 + quad * 8) * 2), bb = *(const LAS bf16x8*)(Y + fr * 144 + (ks * 32 + quad * 8) * 2);
                acc = __builtin_amdgcn_mfma_f32_16x16x32_bf16(a, bb, acc, 0, 0, 0);
                if (wave == 0) accNT = __builtin_amdgcn_mfma_f32_16x16x32_bf16(bb, a, accNT, 0, 0, 0); }
            accN = acc;
#pragma unroll
            for (int j = 0; j < 4; ++j) { const int t = quad * 4 + j, i = fr;
                if (wave == 0) { }
                else if (wave == 1) *(LAS unsigned short*)(MMI + (t * 16 + i) * 2) = (unsigned short)f2bf((i < t) ? acc[j] : 0.f);
                else { const int slot = (i >> 2) * 8 + (i & 3) + (wave == 3 ? 4 : 0); *(LAS unsigned short*)(AOI + (t * 32 + slot) * 2) = (unsigned short)f2bf((i <= t) ? acc[j] : 0.f); } }
        }
        if (wave == 0) {
            f32x4 nv, nT;
#pragma unroll
            for (int j = 0; j < 4; ++j) { nv[j] = (fr < quad * 4 + j) ? accN[j] : 0.f;
                                          nT[j] = (quad * 4 + j < fr) ? accNT[j] : 0.f; }
#pragma unroll
            for (int lv = 0; lv < 4; ++lv) {
                const unsigned n01 = cvtpk(nv[0], nv[1]), n23 = cvtpk(nv[2], nv[3]), t01 = cvtpk(nT[0], nT[1]), t23 = cvtpk(nT[2], nT[3]);
                const u32x2 rowv = {t01, t23};
                *(LAS u32x2*)(NI + lv * 1024 + (fr * 16 + quad * 4) * 2) = rowv;
                if (lv < 3) {
                    const f32x4 zf = {0.f, 0.f, 0.f, 0.f};
                    const bf16x8 opN = mk_op(n01, n23, 0u, 0u), opT = mk_op(t01, t23, 0u, 0u);
                    nv = __builtin_amdgcn_mfma_f32_16x16x32_bf16(opT, opN, zf, 0, 0, 0);
                    nT = __builtin_amdgcn_mfma_f32_16x16x32_bf16(opN, opT, zf, 0, 0, 0);
                }
            }
        }
        }
        LDS_BAR();
    }
    CK_WRITEOUT(NCH - 1);
#undef CK_ISSUE
#undef CK_COMMIT
#undef CK_WRITEOUT
#undef CK_P1A
#undef CK_P1B
}
__device__ __forceinline__ void gla_chunk_item(unsigned char* ldsg, kparams_t p, int chain, int tid) {
    LAS unsigned char* lds = (LAS unsigned char*)ldsg;
    constexpr int INB = 16 * 320, NCH = (SEQ + CTXL) / 16, IMGB = 6400;
    LAS unsigned char* IMG0 = lds + 3 * INB;
    LAS unsigned char* QKI = IMG0 + 2 * IMGB;
    LAS unsigned char* OBI = QKI + 512;
    const int b = chain >> 3, h = (chain >> 1) & 3, dir = chain & 1;
    const int lane = tid & 63, wave = __builtin_amdgcn_readfirstlane(tid >> 6), fr = lane & 15, quad = lane >> 4;
    const hf* PG = (const hf*)(p->ws + WS_PG); const bf16_t* P1 = (const bf16_t*)(p->ws + WS_P1); hf* OG = (hf*)(p->ws + WS_OG) + (size_t)dir * MT * 256;
    const int pp_ = tid < 320 ? tid : 0, st_ = pp_ / 20, q_ = pp_ % 20;
    const size_t crow_ = (size_t)(ML + b * 256 + (dir ? 255 - st_ : st_)), lrow_ = (size_t)(b * 4096 + (dir ? 4095 - st_ : st_));
    const int ar_ = q_ >> 2, sog_ = (ar_ == 0 ? h * 32 : ar_ == 1 ? 128 + h * 32 : 256 + dir * 128 + h * 32) + (q_ & 3) * 8;
    const unsigned char* cur_ = q_ < 12 ? (const unsigned char*)(PG + crow_ * PGC + sog_) : (const unsigned char*)(P1 + crow_ * P1C + 256 + h * 64 + (q_ - 12) * 8);
    const unsigned char* lat_ = q_ < 12 ? (const unsigned char*)(PG + lrow_ * PGC + sog_) : (const unsigned char*)(P1 + lrow_ * P1C + 256 + h * 64 + (q_ - 12) * 8);
    const ptrdiff_t stepB_ = (ptrdiff_t)(dir ? -16 : 16) * (q_ < 12 ? PGC * 2 : P1C * 2);
    const int lo_ = st_ * 320 + q_ * 16;
    int icc_ = 0, cbuf_ = 0, wcc_ = 0;
    const int wst_ = (tid & 127) >> 3, wpc_ = tid & 7;
    hf* wcur_ = OG + (size_t)(ML + b * 256 + (dir ? 255 - wst_ : wst_)) * 256 + h * 64 + wpc_ * 8;
    hf* wlat_ = OG + (size_t)(b * 4096 + (dir ? 4095 - wst_ : wst_)) * 256 + h * 64 + wpc_ * 8;
    const ptrdiff_t wstep_ = (ptrdiff_t)(dir ? -16 : 16) * 256;
    u32x4 pre;
#define GK_ISSUE() do { if (icc_ == 16) cur_ = lat_; pre = *(const u32x4*)cur_; cur_ += stepB_; ++icc_; } while (0)
#define GK_COMMIT() do { if (tid < 320) *(LAS u32x4*)(lds + cbuf_ + lo_) = pre; cbuf_ = (cbuf_ == 2 * INB) ? 0 : cbuf_ + INB; } while (0)
#define GK_WRITEOUT(cc) do { if (wcc_ == 16) wcur_ = wlat_; if (tid < 128) *(u32x4*)wcur_ = *(const LAS u32x4*)(OBI + ((cc) & 1) * 2048 + wst_ * 128 + wpc_ * 16); wcur_ += wstep_; ++wcc_; } while (0)
#define GK_P1(cc) do { const LAS unsigned char* in_ = lds + ((cc) % 3) * INB; LAS unsigned char* im_ = IMG0 + ((cc) & 1) * IMGB; \
        const int k_ = lane & 31, go_ = (wave - 4) * 2 + (lane >> 5), t0_ = go_ * 2; \
        float e_[16]; _Pragma("unroll") for (int i_ = 0; i_ < 16; ++i_) e_[i_] = (float)*(const LAS hf*)(in_ + i_ * 320 + 128 + k_ * 2); \
        float pfx_ = 1.f, sfx_ = 1.f; _Pragma("unroll") for (int g_ = 0; g_ < 8; ++g_) { const float H_ = e_[2 * g_] * e_[2 * g_ + 1]; pfx_ *= (g_ < go_) ? H_ : 1.f; sfx_ *= (g_ > go_) ? H_ : 1.f; } \
        const float ea_ = (float)*(const LAS hf*)(in_ + t0_ * 320 + 128 + k_ * 2), eb_ = (float)*(const LAS hf*)(in_ + (t0_ + 1) * 320 + 128 + k_ * 2); \
        const float ga_ = pfx_ * ea_, gb_ = ga_ * eb_, gC_ = gb_ * sfx_; \
        if (go_ == 0) *(LAS float*)(im_ + 3584 + k_ * 4) = gC_; \
        _Pragma("unroll") for (int e2_ = 0; e2_ < 2; ++e2_) { const int t_ = t0_ + e2_; const float gt_ = e2_ == 0 ? ga_ : gb_; const float inv_ = __builtin_amdgcn_rcpf(gt_); \
            const float qv_ = (float)*(const LAS hf*)(in_ + t_ * 320 + k_ * 2), kv_ = (float)*(const LAS hf*)(in_ + t_ * 320 + 64 + k_ * 2); \
            const unsigned pa_ = cvtpk(qv_ * gt_, kv_ * inv_), pb_ = cvtpk(kv_ * inv_ * gC_, 0.f); \
            *(LAS unsigned short*)(im_ + t_ * 80 + k_ * 2) = (unsigned short)(pa_ & 0xffffu); *(LAS unsigned short*)(im_ + 1280 + t_ * 80 + k_ * 2) = (unsigned short)(pa_ >> 16); \
            *(LAS unsigned short*)(im_ + 2560 + k_ * 32 + t_ * 2) = (unsigned short)(pb_ & 0xffffu); \
              \
            *(LAS unsigned short*)(im_ + 3712 + k_ * 32 + t_ * 2) = *(const LAS unsigned short*)(in_ + t_ * 320 + 192 + k_ * 2); \
            *(LAS unsigned short*)(im_ + 3712 + (k_ + 32) * 32 + t_ * 2) = *(const LAS unsigned short*)(in_ + t_ * 320 + 192 + (k_ + 32) * 2); } } while (0)
    f32x4 St[2];
    St[0] = (f32x4){0.f, 0.f, 0.f, 0.f}; St[1] = St[0];
    GK_ISSUE(); GK_COMMIT(); GK_ISSUE(); GK_COMMIT(); GK_ISSUE();
    __syncthreads();
    if (wave >= 4) GK_P1(0);
    LDS_BAR();
#pragma unroll 1
    for (int c = 0; c < NCH; ++c) {
        LAS unsigned char* im = IMG0 + (c & 1) * IMGB;
        const LAS unsigned char* QI = im; const LAS unsigned char* KI = im + 1280; const LAS unsigned char* AUPG = im + 2560; const LAS float* GC = (const LAS float*)(im + 3584); const LAS unsigned char* VTI = im + 3712;
        if (c + 2 < NCH) GK_COMMIT();
        if (c + 3 < NCH) GK_ISSUE();
        if (c > 0) GK_WRITEOUT(c - 1);
        if (wave >= 4) { if (c + 1 < NCH) GK_P1(c + 1); }
        if (wave == 0) {
            const bf16x8 a = *(const LAS bf16x8*)(QI + fr * 80 + quad * 16), bb = *(const LAS bf16x8*)(KI + fr * 80 + quad * 16);
            const f32x4 zf = {0.f, 0.f, 0.f, 0.f};
            const f32x4 acc = __builtin_amdgcn_mfma_f32_16x16x32_bf16(a, bb, zf, 0, 0, 0);
            const unsigned p01 = cvtpk((fr <= quad * 4 + 0) ? acc[0] : 0.f, (fr <= quad * 4 + 1) ? acc[1] : 0.f), p23 = cvtpk((fr <= quad * 4 + 2) ? acc[2] : 0.f, (fr <= quad * 4 + 3) ? acc[3] : 0.f);
            *(LAS unsigned short*)(QKI + ((quad * 4 + 0) * 16 + fr) * 2) = (unsigned short)(p01 & 0xffffu); *(LAS unsigned short*)(QKI + ((quad * 4 + 1) * 16 + fr) * 2) = (unsigned short)(p01 >> 16);
            *(LAS unsigned short*)(QKI + ((quad * 4 + 2) * 16 + fr) * 2) = (unsigned short)(p23 & 0xffffu); *(LAS unsigned short*)(QKI + ((quad * 4 + 3) * 16 + fr) * 2) = (unsigned short)(p23 >> 16);
        }
        LDS_BAR();
        if (wave < 4) {
            const int vrow = wave * 16 + fr;
            const bf16x8 Sb = mk_op(cvtpk(St[0][0], St[0][1]), cvtpk(St[0][2], St[0][3]), cvtpk(St[1][0], St[1][1]), cvtpk(St[1][2], St[1][3]));
            const u32x2 q0 = *(const LAS u32x2*)(QI + fr * 80 + (quad * 4) * 2), q1 = *(const LAS u32x2*)(QI + fr * 80 + (16 + quad * 4) * 2);
            const u32x2 vt = *(const LAS u32x2*)(VTI + vrow * 32 + quad * 8), qk = *(const LAS u32x2*)(QKI + fr * 32 + quad * 8);
            const bf16x8 Vb = mk_op(vt.x, vt.y, 0u, 0u);
            const f32x4 zf = {0.f, 0.f, 0.f, 0.f};
            f32x4 ot = __builtin_amdgcn_mfma_f32_16x16x32_bf16(mk_op(q0.x, q0.y, q1.x, q1.y), Sb, zf, 0, 0, 0);
            ot = __builtin_amdgcn_mfma_f32_16x16x32_bf16(mk_op(qk.x, qk.y, 0u, 0u), Vb, ot, 0, 0, 0);
#pragma unroll
            for (int j = 0; j < 4; ++j) *(LAS hf*)(OBI + (c & 1) * 2048 + ((quad * 4 + j) * 64 + vrow) * 2) = (hf)ot[j];
#pragma unroll
            for (int kt = 0; kt < 2; ++kt) { const f32x4 gc = *(const LAS f32x4*)(GC + kt * 16 + quad * 4); const u32x2 au = *(const LAS u32x2*)(AUPG + (kt * 16 + fr) * 32 + quad * 8);
                St[kt] = __builtin_amdgcn_mfma_f32_16x16x32_bf16(mk_op(au.x, au.y, 0u, 0u), Vb, St[kt] * gc, 0, 0, 0); }
        }
        LDS_BAR();
    }
    GK_WRITEOUT(NCH - 1);
#undef GK_ISSUE
#undef GK_COMMIT
#undef GK_WRITEOUT
#undef GK_P1
}
__device__ __forceinline__ void swa_item(unsigned char* ldsg, kparams_t p, int l, int item, int tid) {
    LAS unsigned char* lds = (LAS unsigned char*)ldsg;
    const int lane = tid & 63, wave = tid >> 6, fr = lane & 15, quad = lane >> 4;
    const bf16_t* P1 = (const bf16_t*)(p->ws + WS_P1); bf16_t* MIX = (bf16_t*)(p->ws + WS_XN);
    const bool lat = item < 512;
    int b, n, kvh;
    if (lat) { b = item >> 6; n = (item >> 1) & 31; kvh = item & 1; } else { const int r = item - 512; b = r >> 2; n = (r >> 1) & 1; kvh = r & 1; }
    const int qrow = (lat ? b * 4096 : ML + b * 256) + n * 128 + wave * 16 + fr;
    const int qpos = n * 128 + wave * 16 + fr;
#pragma unroll 1
    for (int hp = 0; hp < 2; ++hp) {
    const int hbase = kvh * 4 + hp * 2;
    bf16x8 qf[2][2];
#pragma unroll
    for (int g = 0; g < 2; ++g)
#pragma unroll
        for (int ks = 0; ks < 2; ++ks) qf[g][ks] = *(const bf16x8*)(P1 + (size_t)qrow * P1C + 800 + (hbase + g) * 64 + ks * 32 + quad * 8);
    f32x4 oacc[2][4]; float mrun[2], lrun[2];
#pragma unroll
    for (int g = 0; g < 2; ++g) { mrun[g] = -1e30f; lrun[g] = 0.f;
#pragma unroll
        for (int dt = 0; dt < 4; ++dt) oacc[g][dt] = (f32x4){0.f, 0.f, 0.f, 0.f}; }
    const int jlo = lat ? (n == 0 ? 2 : 0) : 0, jhi = lat ? (n == 31 ? 4 : 6) : 0, T = 4 + (jhi - jlo);
    const int key_ = tid >> 3, ch_ = tid & 7;
#define SWA_SRC(t) (P1 + (size_t)(((t) < 4 ? ML + b * 256 + (t) * 64 : b * 4096 + (n - 1) * 128 + (jlo + (t) - 4) * 64) + key_) * P1C + 1312 + kvh * 64 + ch_ * 8)
#define SWA_STORE(bf) do { LAS unsigned char* Ks_ = lds + (bf) * 18432; LAS unsigned char* Vt_ = Ks_ + 9216; *(LAS u32x4*)(Ks_ + key_ * 144 + ch_ * 16) = pk_; \
        _Pragma("unroll") for (int e = 0; e < 4; ++e) { *(LAS unsigned short*)(Vt_ + (ch_ * 8 + 2 * e) * 144 + key_ * 2) = (unsigned short)(pv_[e] & 0xffffu); *(LAS unsigned short*)(Vt_ + (ch_ * 8 + 2 * e + 1) * 144 + key_ * 2) = (unsigned short)(pv_[e] >> 16); } } while (0)
    u32x4 pk_, pv_;
    { const bf16_t* src = SWA_SRC(0); pk_ = *(const u32x4*)src; pv_ = *(const u32x4*)(src + 128); }
    SWA_STORE(0);
    __syncthreads();
    for (int tile = 0; tile < T; ++tile) {
        if (tile + 1 < T) { const bf16_t* src = SWA_SRC(tile + 1); pk_ = *(const u32x4*)src; pv_ = *(const u32x4*)(src + 128); }
        const bool local = tile >= 4; const int kpos0 = local ? (n - 1) * 128 + (jlo + tile - 4) * 64 : 0;
        const LAS unsigned char* Ks = lds + (tile & 1) * 18432; const LAS unsigned char* Vt = Ks + 9216;
#pragma unroll
        for (int g = 0; g < 2; ++g) {
            asm volatile("" ::: "memory");
            bf16x8 kf[4][2], vf[4][2];
#pragma unroll
        for (int st = 0; st < 4; ++st)
#pragma unroll
            for (int ks = 0; ks < 2; ++ks) kf[st][ks] = *(const LAS bf16x8*)(Ks + (st * 16 + fr) * 144 + ks * 64 + quad * 16);
#pragma unroll
        for (int dt = 0; dt < 4; ++dt)
#pragma unroll
            for (int kp = 0; kp < 2; ++kp) { const u32x2 lo = *(const LAS u32x2*)(Vt + (dt * 16 + fr) * 144 + ((2 * kp) * 16 + quad * 4) * 2), hi = *(const LAS u32x2*)(Vt + (dt * 16 + fr) * 144 + ((2 * kp + 1) * 16 + quad * 4) * 2);
                const u32x4 t = {lo.x, lo.y, hi.x, hi.y}; vf[dt][kp] = __builtin_bit_cast(bf16x8, t); }
            f32x4 s[4];
#pragma unroll
            for (int st = 0; st < 4; ++st) { f32x4 a = (f32x4){0.f, 0.f, 0.f, 0.f};
                a = __builtin_amdgcn_mfma_f32_16x16x32_bf16(kf[st][0], qf[g][0], a, 0, 0, 0); a = __builtin_amdgcn_mfma_f32_16x16x32_bf16(kf[st][1], qf[g][1], a, 0, 0, 0); s[st] = a * 0.125f; }
            if (local) {
#pragma unroll
                for (int st = 0; st < 4; ++st)
#pragma unroll
                    for (int j = 0; j < 4; ++j) { const int d = qpos - (kpos0 + st * 16 + quad * 4 + j); if (d > 128 || d < -128) s[st][j] = -1e30f; }
            }
            float mx = fmaxf(fmaxf(fmaxf(s[0][0], s[0][1]), fmaxf(s[0][2], s[0][3])), fmaxf(fmaxf(s[1][0], s[1][1]), fmaxf(s[1][2], s[1][3])));
            mx = fmaxf(mx, fmaxf(fmaxf(fmaxf(s[2][0], s[2][1]), fmaxf(s[2][2], s[2][3])), fmaxf(fmaxf(s[3][0], s[3][1]), fmaxf(s[3][2], s[3][3]))));
            mx = fmaxf(mx, __shfl_xor(mx, 16)); mx = fmaxf(mx, __shfl_xor(mx, 32));
            const float mn = fmaxf(mrun[g], mx), alpha = __expf(mrun[g] - mn); mrun[g] = mn;
            float ps = 0.f;
#pragma unroll
            for (int st = 0; st < 4; ++st)
#pragma unroll
                for (int j = 0; j < 4; ++j) { s[st][j] = __expf(s[st][j] - mn); ps += s[st][j]; }
            lrun[g] = lrun[g] * alpha + ps;
            bf16x8 pb[2];
#pragma unroll
            for (int kp = 0; kp < 2; ++kp) { const u32x4 t = {cvtpk(s[2 * kp][0], s[2 * kp][1]), cvtpk(s[2 * kp][2], s[2 * kp][3]), cvtpk(s[2 * kp + 1][0], s[2 * kp + 1][1]), cvtpk(s[2 * kp + 1][2], s[2 * kp + 1][3])}; pb[kp] = __builtin_bit_cast(bf16x8, t); }
#pragma unroll
            for (int dt = 0; dt < 4; ++dt) { f32x4 o = oacc[g][dt] * alpha;
                o = __builtin_amdgcn_mfma_f32_16x16x32_bf16(vf[dt][0], pb[0], o, 0, 0, 0); o = __builtin_amdgcn_mfma_f32_16x16x32_bf16(vf[dt][1], pb[1], o, 0, 0, 0); oacc[g][dt] = o; }
        }
        if (tile + 1 < T) SWA_STORE((tile + 1) & 1);
        __syncthreads();
    }
#undef SWA_SRC
#undef SWA_STORE
    const float* sink = p->in[13] + l * 8;
#pragma unroll
    for (int g = 0; g < 2; ++g) {
        float lsum = lrun[g]; lsum += __shfl_xor(lsum, 16); lsum += __shfl_xor(lsum, 32);
        lsum += __expf(sink[hbase + g] - mrun[g]);
        const float inv = 1.0f / lsum;
#pragma unroll
        for (int dt = 0; dt < 4; ++dt) { const f32x4 o = oacc[g][dt] * inv; u32x2 w; w.x = cvtpk(o[0], o[1]); w.y = cvtpk(o[2], o[3]);
            *(u32x2*)(MIX + (size_t)qrow * DM + 256 + (hbase + g) * 64 + dt * 16 + quad * 4) = w; }
    }
    }
}

__device__ __forceinline__ float group16_sum(float v) { return reduce16(v); }
__device__ __forceinline__ void phase_finalize(kparams_t p, int l, int nrows, int gw, int ngw, int lane) {
    const hf* OR = (const hf*)(p->ws + WS_OR); const hf* OG = (const hf*)(p->ws + WS_OG); const hf* PREP = (const hf*)(p->ws + WS_PREP); const hf* GG = (const hf*)(p->ws + WS_GG);
    const float* BONUS = (const float*)(p->ws + WS_BONUS); const bf16_t* P1 = (const bf16_t*)(p->ws + WS_P1); bf16_t* MIX = (bf16_t*)(p->ws + WS_XN);
    const float* ln_g = p->in[23] + l * 256; const float* ln_b = p->in[24] + l * 256; const float* gng = p->in[12] + l * 64;
    const int c = lane * 4, h = lane >> 4;
    const f32x4 lg4 = *(const f32x4*)(ln_g + c), lb4 = *(const f32x4*)(ln_b + c), gn4 = *(const f32x4*)(gng + (c & 63));
    for (int row = gw; row < nrows; row += ngw) {
        {
            const h4 a = *(const h4*)(OR + (size_t)row * 256 + c), bq = *(const h4*)(OR + (size_t)MT * 256 + (size_t)row * 256 + c);
            float o[4]; float s = 0.f;
#pragma unroll
            for (int e = 0; e < 4; ++e) { o[e] = (float)a[e] + (float)bq[e]; s += o[e]; }
            const float mu = group16_sum(s) * (1.0f / 64.0f); float q = 0.f;
#pragma unroll
            for (int e = 0; e < 4; ++e) { o[e] -= mu; q += o[e] * o[e]; }
            const float rs = rsqrtf(group16_sum(q) * (1.0f / 64.0f) + 64e-5f);
            const float bon = BONUS[(size_t)row * 4 + h];
            const h4 v4 = *(const h4*)(PREP + (size_t)row * PRC + 512 + c), g4 = *(const h4*)(GG + (size_t)row * 256 + c);
            float y[4];
#pragma unroll
            for (int e = 0; e < 4; ++e) y[e] = (o[e] * rs * lg4[e] + lb4[e] + bon * (float)v4[e]) * (float)g4[e];
            u32x2 w; w.x = cvtpk(y[0], y[1]); w.y = cvtpk(y[2], y[3]);
            *(u32x2*)(MIX + (size_t)row * DM + 768 + c) = w;
        }
        {
            const h4 a = *(const h4*)(OG + (size_t)row * 256 + c), bq = *(const h4*)(OG + (size_t)MT * 256 + (size_t)row * 256 + c);
            float o[4]; float q = 0.f;
#pragma unroll
            for (int e = 0; e < 4; ++e) { o[e] = (float)a[e] + (float)bq[e]; q += o[e] * o[e]; }
            const float rs = rsqrtf(group16_sum(q) * (1.0f / 64.0f) + 1e-6f);
            const u32x2 gt = *(const u32x2*)(P1 + (size_t)row * P1C + 512 + c);
            const float gv[4] = {bflo(gt.x), bfhi(gt.x), bflo(gt.y), bfhi(gt.y)};
            float y[4];
#pragma unroll
            for (int e = 0; e < 4; ++e) y[e] = o[e] * rs * gn4[e] * gv[e] * sigmoidf_(gv[e]);
            u32x2 w; w.x = cvtpk(y[0], y[1]); w.y = cvtpk(y[2], y[3]);
            *(u32x2*)(MIX + (size_t)row * DM + c) = w;
        }
    }
}
__global__ void __launch_bounds__(NTHREADS, 2) hybrid_fwd(Params p_arg) {
    extern __shared__ __attribute__((aligned(16))) unsigned char lds[];
#ifndef EXP_REP
#define EXP_REP 1
#endif
#ifndef EXP_FLAG
#define EXP_FLAG(rep) 0
#endif
#ifndef MAXSTEP
#define MAXSTEP 1000
#endif
    constexpr int NSTEP = 1 + 9 * NLAYER + 1;
#ifdef PROBE
    unsigned long long tacc1 = 0, tacc2 = 0;
#endif
    { volatile LAS unsigned* st0 = (volatile LAS unsigned*)((LAS unsigned char*)lds + 147392); if (threadIdx.x < 2) st0[threadIdx.x] = 0u; __syncthreads();
      (void)xcd_barrier_post((unsigned*)(p_arg.ws + WS_CTL) + 1024, st0); }
    int rep = 0;
#pragma unroll 1
    for (int step = 0; step < NSTEP; ++step) {
#ifdef PROBE
        const unsigned long long t0_ = __builtin_amdgcn_s_memrealtime();
#endif
        kparams_t kp = (kparams_t)__builtin_amdgcn_kernarg_segment_ptr();
        asm volatile("" : "+s"(kp));
        kparams_t p = kp;
        int tid = threadIdx.x, bid = blockIdx.x, G = gridDim.x;
        asm volatile("" : "+v"(tid)); asm volatile("" : "+s"(bid)); asm volatile("" : "+s"(G));
        const int lane = tid & 63, wave = __builtin_amdgcn_readfirstlane(tid >> 6);
        const int gw = bid * NWAVES + wave, ngw = G * NWAVES;
        unsigned char* ws = p->ws;
        bf16_t* XN = (bf16_t*)(ws + WS_XN); float* XC = (float*)(ws + WS_XC); float* XL = p->out;
        if (step == 0) { phase_mod(lds, p, tid, bid, G); }
        else if (step == NSTEP - 1) { final_norm_rows(XL, p->in[28], gw, ngw, lane);
#ifdef PROBE
            cg::this_grid().sync();
            if (bid == 0) { const float v1 = (float)tacc1 * 0.01f; if (tid == 0) XL[0] = v1; }
            if (bid == PROBE_B2) { const float v2 = (float)tacc2 * 0.01f; for (int i = tid; i < (1 << 20); i += NTHREADS) XL[1024 + i] = v2; }
#endif
            break; }
        else {
            const int l = (step - 1) / 9, ph = (step - 1) % 9;

            const bool lastl = (l == NLAYER - 1);
            const int mrows = lastl ? ML : MT;
            const float* modl = (const float*)(ws + WS_MOD) + (size_t)l * 9 * 6144;
            const float* resL = l == 0 ? p->in[0] : XL; const float* resC = l == 0 ? p->in[2] : XC;
            if (ph == 0) {
                convert_weights(lds, p, l, gw, ngw, wave, lane);
                norm_mod_rows(resL, resC, p->in[6] + l * DM, modl, 0, 1024, XN, MT, gw, ngw, lane);
            } else if (ph == 1) {
                pg8::Gemm g{XN, (const bf16_t*)(ws + WS_WT + WT_IN), MT, INP, DM}; pg8::StaticOrder S; S.init(MT, INP, G, bid);
                pg8::EpiIn E{(bf16_t*)(ws + WS_P1), (bf16_t*)(ws + WS_RAW)};
                pg8::gemm_phase<pg8::EpiIn, pg8::StaticOrder, true, true>((PG8_LAS unsigned char*)lds, g, S, E, tid);
            } else if (ph == 5) {
                pg8::Gemm g{XN, (const bf16_t*)(ws + WS_WT + WT_OUT), mrows, DM, DM}; pg8::StaticOrder S; S.init(mrows, DM, G, bid);
                pg8::EpiRes E{resL, XL, resC, XC, modl + 2048};
                pg8::gemm_phase<pg8::EpiRes, pg8::StaticOrder, true, true>((PG8_LAS unsigned char*)lds, g, S, E, tid);
            } else if (ph == 7) {
                pg8::Gemm g{XN, (const bf16_t*)(ws + WS_WT + WT_GU), mrows, 2 * FF, DM}; pg8::StaticOrder S; S.init(mrows, 2 * FF, G, bid);
                pg8::EpiSwiglu E{(bf16_t*)(ws + WS_H)};
                pg8::gemm_phase<pg8::EpiSwiglu, pg8::StaticOrder, true, true>((PG8_LAS unsigned char*)lds, g, S, E, tid);
            } else if (ph == 8) {
                pg8::Gemm g{(const bf16_t*)(ws + WS_H), (const bf16_t*)(ws + WS_WT + WT_DN), mrows, DM, FF}; pg8::StaticOrder S; S.init(mrows, DM, G, bid);
                pg8::EpiRes E{XL, XL, XC, XC, modl + 5120};
                pg8::gemm_phase<pg8::EpiRes, pg8::StaticOrder, true, true>((PG8_LAS unsigned char*)lds, g, S, E, tid);
            } else if (ph == 2) {
                phase_prep(lds, p, l, tid, bid, G, rep == 0);
            } else if (ph == 3) {
#ifdef PROBE_SCAN
                const unsigned long long ts_ = __builtin_amdgcn_s_memrealtime();
#endif
#ifdef REP_NO_SCAN
                if (rep == 0)
#endif
#ifdef RWKV_SCAN
                for (int it = bid; it < 192; it += G) {
#ifdef REP_ONLY_RWKV
                    if (rep == EXP_REP && it >= 128) continue;
#endif
#ifdef REP_ONLY_GLA
                    if (rep == EXP_REP && it < 128) continue;
#endif
                    if (it < 128) rwkv_scan_item(lds, p, it, tid, EXP_FLAG(rep)); else gla_scan_item(lds, p, (it - 128) * 2, tid); __syncthreads(); }
#else
                for (int it = bid; it < 128; it += G) {
#ifdef REP_ONLY_RWKV
                    if (rep == EXP_REP && it >= 64) continue;
#endif
#ifdef REP_ONLY_GLA
                    if (rep == EXP_REP && it < 64) continue;
#endif
                    if (it < 64) rwkv_chunk_item(lds, p, it, tid, EXP_FLAG(rep)); else gla_chunk_item(lds, p, it - 64, tid); __syncthreads(); }
#endif
#ifdef PROBE_SCAN
                { const unsigned long long d_ = __builtin_amdgcn_s_memrealtime() - ts_; tacc1 += d_; tacc2 += d_; }
#endif
#ifdef REP_NO_SWA
                const int nswa = rep == EXP_REP ? 0 : (lastl ? 512 : 544);
#else
                const int nswa = lastl ? 512 : 544;
#endif
                unsigned* ctl = (unsigned*)(ws + WS_CTL);
                LAS int* qslot = (LAS int*)((LAS unsigned char*)lds + 147328);
                for (;;) {
                    __syncthreads();
                    if (tid == 0) *qslot = (int)atomicAdd(ctl + 64 * l + 32 * rep, 1u);
                    __syncthreads();
                    const int it = *qslot;
                    if (it >= nswa) break;
                    swa_item(lds, p, l, it, tid);
                }
            } else if (ph == 4) {
                phase_finalize(p, l, mrows, gw, ngw, lane);
            } else {
                norm_mod_rows(XL, XC, p->in[7] + l * DM, modl, 3072, 4096, XN, mrows, gw, ngw, lane);
            }
        }
        if (step == 0) cg::this_grid().sync();
        else { XcdBarrier xb_; xb_.bar = (unsigned*)(p->ws + WS_CTL) + 1024; xb_.x = xb_xcc_id(); xb_.st = (volatile LAS unsigned*)((LAS unsigned char*)lds + 147392); xcd_barrier(xb_); }
#ifdef PROBE
        { const unsigned long long dt_ = __builtin_amdgcn_s_memrealtime() - t0_; const int ph_ = step == 0 ? 9 : (step - 1) % 9;
          if (PROBE_C1(ph_)) tacc1 += dt_; if (PROBE_C2(ph_)) tacc2 += dt_; }
#endif
#ifdef DOUBLE_MASK
#ifdef DOUBLE_STEP0
        if (step == 0 && rep == 0) { rep = 1; --step; } else
#endif
#ifdef DOUBLE_D0
        if (step == 6 && rep == 0) { rep = 1; --step; } else
#endif
        if (step >= 1 && rep == 0 && ((DOUBLE_MASK >> ((step - 1) % 9)) & 1)) { rep = 1; --step; } else rep = 0;
#endif
        if (step + 1 >= MAXSTEP) break;
    }
}

extern "C" void kernel_launch(void* const* d_in, const int* in_sizes, int n_in, void* d_out, int out_size, void* d_ws, size_t ws_size, hipStream_t stream) {
    static int grid_blocks = 0;
    if (grid_blocks == 0) {
        if (n_in != 29 || out_size != ML * DM || ws_size < WS_END) { fprintf(stderr, "kernel_launch: unexpected shapes (n_in %d out %d ws %zu)\n", n_in, out_size, ws_size); grid_blocks = -1; return; }
        int dev = 0, cus = 0, per_cu = 0;
        (void)hipGetDevice(&dev);
        (void)hipDeviceGetAttribute(&cus, hipDeviceAttributeMultiprocessorCount, dev);
        (void)hipFuncSetAttribute((const void*)hybrid_fwd, hipFuncAttributeMaxDynamicSharedMemorySize, LDS_BYTES);
        (void)hipOccupancyMaxActiveBlocksPerMultiprocessor(&per_cu, (const void*)hybrid_fwd, NTHREADS, LDS_BYTES);
        if (per_cu < 1) per_cu = 1;
        grid_blocks = cus * per_cu;
        (void)hipGetLastError();
    }
    if (grid_blocks < 0) return;
    (void)hipMemsetAsync((char*)d_ws + WS_CTL, 0, 65536, stream);
    Params p{};
    for (int i = 0; i < 29; ++i) p.in[i] = (const float*)d_in[i];
    p.out = (float*)d_out; p.ws = (unsigned char*)d_ws;
    void* args[] = {&p};
    hipError_t e = hipLaunchCooperativeKernel((const void*)hybrid_fwd, dim3(grid_blocks), dim3(NTHREADS), args, LDS_BYTES, stream);
    if (e != hipSuccess) fprintf(stderr, "cooperative launch failed: %s (grid %d)\n", hipGetErrorString(e), grid_blocks);
}
```

```cpp
#include <hip/hip_runtime.h>
#include <hip/hip_cooperative_groups.h>
#include <cstdio>
#include <cstdint>
namespace cg = cooperative_groups;
namespace pg8 {
#define PG8_LAS __attribute__((address_space(3)))
typedef unsigned short bf16_t;
typedef short bf16x8 __attribute__((ext_vector_type(8)));
typedef float f32x4 __attribute__((ext_vector_type(4)));
typedef unsigned u32x4 __attribute__((ext_vector_type(4)));
constexpr int BM = 256, BK = 64, HALF = 128, HTB = HALF * BK * 2  , STAGE_BYTES = 8 * HTB, NXCD = 8, WGM = 8;

__host__ __device__ __forceinline__ int lds_byte(int r, int c) { const int st = (r >> 4) * 2 + (c >> 5), rr = r & 15, cc = c & 31, ob = rr * 64 + cc * 2; return st * 1024 + (ob ^ (((ob >> 9) & 1) << 5)); }
__host__ __device__ __forceinline__ void stage_rc(int b, int& R, int& C) { const int st = b / 1024, sb = b % 1024, swz = sb ^ (((sb >> 9) & 1) << 5); R = (st >> 1) * 16 + swz / 64; C = (st & 1) * 32 + (swz % 64) / 2; }
__host__ __device__ __forceinline__ int perm32(int rho) { const int n = rho >> 4, i = rho & 15; return 8 * (i >> 2) + 4 * n + (i & 3); }

struct Unit { int pm, pn; };
struct Gemm { const bf16_t* A; const bf16_t* Bt; int M, N, K; };

struct StaticOrder {
    int nM, nN, nwg, G, c;
    __host__ __device__ void init(int M, int N, int G_, int c_) { nM = M / BM; nN = N / BM; nwg = nM * nN; G = G_; c = c_; }
    __host__ __device__ bool next(int i, Unit& u) const {
        const long L = (long)i * G + c; if (L >= nwg) return false;
        int wgid = (int)L; { const int q = nwg / NXCD, r = nwg % NXCD, xcd = wgid % NXCD, off = wgid / NXCD; wgid = (xcd < r ? xcd * (q + 1) : r * (q + 1) + (xcd - r) * q) + off; }
        const int nig = WGM * nN, gid = wgid / nig, fm = gid * WGM, gsz = (nM - fm) < WGM ? (nM - fm) : WGM;
        u.pm = fm + ((wgid % nig) % gsz); u.pn = (wgid % nig) / gsz; return true;
    }
    __device__ __forceinline__ void a_ready(const Unit&) const {}
    __device__ __forceinline__ void done(const Unit&) const {}
};

__device__ __forceinline__ unsigned cvt_pk_bf16(float lo, float hi) { unsigned r; asm volatile("v_cvt_pk_bf16_f32 %0, %1, %2" : "=v"(r) : "v"(lo), "v"(hi)); return r; }
typedef float f32x2 __attribute__((ext_vector_type(2)));
constexpr int EP_ML = 32768;
struct EpiIn {
    static constexpr bool PERM = true, AFTER_DRAIN = false;
    bf16_t* O0; bf16_t* O1;
    __device__ __forceinline__ void operator()(const f32x4 (&acc)[2][2][4][2], const Unit& u, int wr, int wc, int fr, int fq) const {
        const int row0 = u.pm * BM + wr * 64 + fr;
#pragma unroll
        for (int bj = 0; bj < 2; ++bj) {
            const int c0 = u.pn * BM + bj * HALF + wc * 32 + 8 * fq;
            bf16_t* base; size_t ld; int cc; bool ok = true;
            if (c0 < 1568) { base = O0; ld = 1568; cc = c0; } else if (c0 < 2720) { base = O1; ld = 1152; cc = c0 - 1568; } else { base = O0; ld = 0; cc = 0; ok = false; }
            if (ok) {
#pragma unroll
            for (int ai = 0; ai < 2; ++ai)
#pragma unroll
                for (int m = 0; m < 4; ++m) {
                    const f32x4 v0 = acc[ai][bj][m][0], v1 = acc[ai][bj][m][1];
                    u32x4 w; w.x = cvt_pk_bf16(v0[0], v0[1]); w.y = cvt_pk_bf16(v0[2], v0[3]); w.z = cvt_pk_bf16(v1[0], v1[1]); w.w = cvt_pk_bf16(v1[2], v1[3]);
                    *(u32x4*)(base + (size_t)(row0 + ai * HALF + m * 16) * ld + cc) = w;
                }
            }
        }
    }
};
struct EpiRes {
    static constexpr bool PERM = true, AFTER_DRAIN = false;
    const float* srcL; float* dstL; const float* srcC; float* dstC; const float* gate;
    __device__ __forceinline__ void operator()(const f32x4 (&acc)[2][2][4][2], const Unit& u, int wr, int wc, int fr, int fq) const {
        const int rowt = u.pm * BM;
        const bool lat = rowt < EP_ML;
        const float* src = lat ? srcL : srcC; float* dst = lat ? dstL : dstC;
        const float* g = gate + (lat ? (rowt >> 12) : 8) * 6144; const int rb = lat ? rowt : rowt - EP_ML;
        const int col0 = u.pn * BM + wc * 32 + 8 * fq;
#pragma unroll
        for (int bj = 0; bj < 2; ++bj) {
            const f32x4 g0 = *(const f32x4*)(g + col0 + bj * HALF), g1 = *(const f32x4*)(g + col0 + bj * HALF + 4);
#pragma unroll
            for (int ai = 0; ai < 2; ++ai)
#pragma unroll
                for (int m = 0; m < 4; ++m) { const size_t off = (size_t)(rb + ai * HALF + wr * 64 + m * 16 + fr) * 1024 + col0 + bj * HALF;
                    const f32x4 s0 = *(const f32x4*)(src + off), s1 = *(const f32x4*)(src + off + 4);
                    *(f32x4*)(dst + off) = s0 + g0 * acc[ai][bj][m][0]; *(f32x4*)(dst + off + 4) = s1 + g1 * acc[ai][bj][m][1]; }
        }
    }
};
struct EpiSwiglu {
    static constexpr bool PERM = true, AFTER_DRAIN = false;
    bf16_t* O0;
    __device__ __forceinline__ void operator()(const f32x4 (&acc)[2][2][4][2], const Unit& u, int wr, int wc, int fr, int fq) const {
        const int row0 = u.pm * BM + wr * 64 + fr, col = u.pn * HALF + wc * 32 + 8 * fq;
#pragma unroll
        for (int ai = 0; ai < 2; ++ai)
#pragma unroll
            for (int m = 0; m < 4; ++m) {
                float h[8];
#pragma unroll
                for (int n = 0; n < 2; ++n)
#pragma unroll
                    for (int e = 0; e < 4; ++e) { const float gt = acc[ai][0][m][n][e], up = acc[ai][1][m][n][e]; h[n * 4 + e] = gt * up * __builtin_amdgcn_rcpf(1.0f + __expf(-gt)); }
                u32x4 w; w.x = cvt_pk_bf16(h[0], h[1]); w.y = cvt_pk_bf16(h[2], h[3]); w.z = cvt_pk_bf16(h[4], h[5]); w.w = cvt_pk_bf16(h[6], h[7]);
                *(u32x4*)(O0 + (size_t)(row0 + ai * HALF + m * 16) * 2816 + col) = w;
            }
    }
};
template <class Epi, class Sched, bool ALIGN_EPI = false, bool SP2 = false>
__device__ __forceinline__ void gemm_phase(PG8_LAS unsigned char* lds, const Gemm g, const Sched& S, const Epi& E, int tid_in) {
    const int tid = tid_in, wid = __builtin_amdgcn_readfirstlane(tid >> 6), lane = tid & 63, wr = wid >> 2, wc = wid & 3, fr = lane & 15, fq = lane >> 4;
    const int K = g.K, nt = K / BK;
    unsigned voffA[2], voffB[2];
#pragma unroll
    for (int i = 0; i < 2; ++i) { int R, C; stage_rc(tid * 16 + i * 8192, R, C); const int Rb = Epi::PERM ? ((R & ~31) + perm32(R & 31)) : R;
        voffA[i] = (unsigned)(R * K + C) * 2u; voffB[i] = (unsigned)(Rb * K + C) * 2u; }
    const size_t kstep = (size_t)(BK * 2);
    const size_t hstep = (size_t)HALF * K * 2;
    const size_t tstep = 2 * hstep;
    const unsigned ldsw = (unsigned)wid * 1024u;
    const int aoff = lds_byte(wr * 64 + fr, fq * 8), boff = lds_byte(wc * 32 + fr, fq * 8);
#define PG8_SA(b, h) (((b) * 2 + (h)) * HTB)
#define PG8_SB(b, h) ((4 + (b) * 2 + (h)) * HTB)
#define PG8_STAGE(bufoff, gbase, voff) do { _Pragma("unroll") for (int _i = 0; _i < 2; ++_i) \
        __builtin_amdgcn_global_load_lds((const unsigned*)((const char*)(gbase) + (voff)[_i]), (PG8_LAS unsigned*)(lds + (bufoff) + ldsw + _i * 8192), 16, 0, 0); } while (0)
#define PG8_LDA(dst, b, h) do { _Pragma("unroll") for (int m = 0; m < 4; ++m) _Pragma("unroll") for (int k = 0; k < 2; ++k) dst[m][k] = *(const PG8_LAS bf16x8*)(lds + PG8_SA(b, h) + aoff + m * 2048 + k * 1024); } while (0)
#define PG8_LDB(dst, b, h) do { _Pragma("unroll") for (int n = 0; n < 2; ++n) _Pragma("unroll") for (int k = 0; k < 2; ++k) dst[n][k] = *(const PG8_LAS bf16x8*)(lds + PG8_SB(b, h) + boff + n * 2048 + k * 1024); } while (0)
#define PG8_MMA(ai, bj, At, Bt) do { __builtin_amdgcn_s_setprio(1); _Pragma("unroll") for (int m = 0; m < 4; ++m) _Pragma("unroll") for (int n = 0; n < 2; ++n) _Pragma("unroll") for (int k = 0; k < 2; ++k) \
        acc[ai][bj][m][n] = __builtin_amdgcn_mfma_f32_16x16x32_bf16(Bt[n][k], At[m][k], acc[ai][bj][m][n], 0, 0, 0); __builtin_amdgcn_s_setprio(0); } while (0)
#define PG8_WAIT_V(n) asm volatile("s_waitcnt vmcnt(" #n ")" ::: "memory")
#define PG8_WAIT_L(n) asm volatile("s_waitcnt lgkmcnt(" #n ")" ::: "memory")
#define PG8_BAR __builtin_amdgcn_s_barrier()
#define PG8_SCHED __builtin_amdgcn_sched_barrier(0)
    Unit cur, nxt; int ui = 0;
    if (!S.next(0, cur)) return;
    f32x4 acc[2][2][4][2];
#pragma unroll
    for (int a = 0; a < 2; ++a)
#pragma unroll
        for (int b = 0; b < 2; ++b)
#pragma unroll
            for (int m = 0; m < 4; ++m)
#pragma unroll
                for (int n = 0; n < 2; ++n) acc[a][b][m][n] = (f32x4){0.f, 0.f, 0.f, 0.f};
    bf16x8 At[4][2], B0[2][2], B1[2][2];
    const char* cA = (const char*)g.A + (size_t)cur.pm * tstep; const char* cB = (const char*)g.Bt + (size_t)cur.pn * tstep;
    S.a_ready(cur);
    if constexpr (SP2) {
        PG8_STAGE(PG8_SB(0, 0), cB, voffB); PG8_STAGE(PG8_SB(0, 1), cB + hstep, voffB); PG8_STAGE(PG8_SA(0, 0), cA, voffA); PG8_STAGE(PG8_SA(0, 1), cA + hstep, voffA);
        if (wr == 1) PG8_BAR;
        PG8_WAIT_V(2); PG8_BAR;
        PG8_STAGE(PG8_SB(1, 0), cB + kstep, voffB); PG8_STAGE(PG8_SA(1, 0), cA + kstep, voffA); PG8_STAGE(PG8_SB(1, 1), cB + hstep + kstep, voffB);
        PG8_WAIT_V(6); PG8_BAR;
    } else {
        PG8_STAGE(PG8_SB(0, 0), cB, voffB); PG8_STAGE(PG8_SA(0, 0), cA, voffA); PG8_STAGE(PG8_SB(0, 1), cB + hstep, voffB); PG8_STAGE(PG8_SA(0, 1), cA + hstep, voffA);
        if (wr == 1) PG8_BAR;
        PG8_WAIT_V(4); PG8_BAR;
        PG8_STAGE(PG8_SB(1, 0), cB + kstep, voffB); PG8_STAGE(PG8_SA(1, 0), cA + kstep, voffA); PG8_STAGE(PG8_SB(1, 1), cB + hstep + kstep, voffB);
        PG8_WAIT_V(6); PG8_BAR;
    }
    for (;;) {
        const bool has_next = S.next(ui + 1, nxt);
        const char* nA = has_next ? (const char*)g.A + (size_t)nxt.pm * tstep : cA; const char* nB = has_next ? (const char*)g.Bt + (size_t)nxt.pn * tstep : cB;
        for (int t = 0; t < nt; t += 2) {
            const bool last = (t == nt - 2);
            const char* a1 = cA + (size_t)(t + 1) * kstep;
            const char* a2 = last ? nA : cA + (size_t)(t + 2) * kstep; const char* b2 = last ? nB : cB + (size_t)(t + 2) * kstep;
            const char* a3 = a2 + kstep; const char* b3 = b2 + kstep;
            if (last && has_next) S.a_ready(nxt);
            if constexpr (SP2) {
            PG8_LDB(B0, 0, 0); PG8_LDB(B1, 0, 1); PG8_SCHED; PG8_LDA(At, 0, 0); PG8_STAGE(PG8_SA(1, 1), a1 + hstep, voffA);
            PG8_WAIT_V(8); PG8_WAIT_L(0); PG8_BAR; PG8_MMA(0, 0, At, B0); PG8_MMA(0, 1, At, B1); PG8_BAR; PG8_SCHED;
            PG8_LDA(At, 0, 1); PG8_STAGE(PG8_SB(0, 0), b2, voffB); PG8_STAGE(PG8_SB(0, 1), b2 + hstep, voffB); PG8_STAGE(PG8_SA(0, 0), a2, voffA);
            PG8_WAIT_V(8); PG8_WAIT_L(0); PG8_BAR; PG8_MMA(1, 0, At, B0); PG8_MMA(1, 1, At, B1); PG8_BAR; PG8_SCHED;
            PG8_LDB(B0, 1, 0); PG8_LDB(B1, 1, 1); PG8_SCHED; PG8_LDA(At, 1, 0); PG8_STAGE(PG8_SA(0, 1), a2 + hstep, voffA);
            PG8_WAIT_V(8); PG8_WAIT_L(0); PG8_BAR; PG8_MMA(0, 0, At, B0); PG8_MMA(0, 1, At, B1); PG8_BAR; PG8_SCHED;
            PG8_LDA(At, 1, 1); PG8_STAGE(PG8_SB(1, 0), b3, voffB); PG8_STAGE(PG8_SB(1, 1), b3 + hstep, voffB); PG8_STAGE(PG8_SA(1, 0), a3, voffA);
            PG8_WAIT_V(8); PG8_WAIT_L(0); PG8_BAR; PG8_MMA(1, 0, At, B0); PG8_MMA(1, 1, At, B1); PG8_BAR; PG8_SCHED;
            } else {
            PG8_LDB(B0, 0, 0); PG8_SCHED; PG8_LDA(At, 0, 0); PG8_STAGE(PG8_SA(1, 1), a1 + hstep, voffA);
            PG8_WAIT_L(8); PG8_BAR; PG8_WAIT_L(0); PG8_MMA(0, 0, At, B0); PG8_BAR; PG8_SCHED;
            PG8_LDB(B1, 0, 1); PG8_STAGE(PG8_SB(0, 0), b2, voffB);
            PG8_BAR; PG8_WAIT_L(0); PG8_MMA(0, 1, At, B1); PG8_BAR;
            PG8_LDA(At, 0, 1); PG8_STAGE(PG8_SA(0, 0), a2, voffA);
            PG8_BAR; PG8_WAIT_L(0); PG8_MMA(1, 0, At, B0); PG8_BAR; PG8_SCHED;
            PG8_STAGE(PG8_SB(0, 1), b2 + hstep, voffB);
            PG8_WAIT_V(6); PG8_BAR; PG8_MMA(1, 1, At, B1); PG8_BAR;
            PG8_LDB(B0, 1, 0); PG8_SCHED; PG8_LDA(At, 1, 0); PG8_STAGE(PG8_SA(0, 1), a2 + hstep, voffA);
            PG8_WAIT_L(8); PG8_BAR; PG8_WAIT_L(0); PG8_MMA(0, 0, At, B0); PG8_BAR; PG8_SCHED;
            PG8_LDB(B1, 1, 1); PG8_STAGE(PG8_SB(1, 0), b3, voffB);
            PG8_BAR; PG8_WAIT_L(0); PG8_MMA(0, 1, At, B1); PG8_BAR;
            PG8_LDA(At, 1, 1); PG8_STAGE(PG8_SA(1, 0), a3, voffA);
            PG8_BAR; PG8_WAIT_L(0); PG8_MMA(1, 0, At, B0); PG8_BAR; PG8_SCHED;
            PG8_STAGE(PG8_SB(1, 1), b3 + hstep, voffB);
            PG8_WAIT_V(6); PG8_BAR; PG8_MMA(1, 1, At, B1); PG8_BAR;
            }
        }
        if constexpr (ALIGN_EPI) { if (wr == 0) PG8_BAR; }
        if constexpr (!Epi::AFTER_DRAIN) { E(acc, cur, wr, wc, fr, fq); S.done(cur); }
        if (!has_next) break;
#pragma unroll
        for (int a = 0; a < 2; ++a)
#pragma unroll
            for (int b = 0; b < 2; ++b)
#pragma unroll
                for (int m = 0; m < 4; ++m)
#pragma unroll
                    for (int n = 0; n < 2; ++n) acc[a][b][m][n] = (f32x4){0.f, 0.f, 0.f, 0.f};
        cur = nxt; cA = nA; cB = nB; ++ui;
        if constexpr (ALIGN_EPI) { if (wr == 1) PG8_BAR; }
    }
    PG8_WAIT_V(0);
    if constexpr (!ALIGN_EPI) { if (wr == 0) PG8_BAR; }
    PG8_BAR;
    if constexpr (Epi::AFTER_DRAIN) { E.fused(acc, cur, wr, wc, fr, fq, lds, wid, lane); S.done(cur); }
#undef PG8_SA
#undef PG8_SB
#undef PG8_STAGE
#undef PG8_LDA
#undef PG8_LDB
#undef PG8_MMA
#undef PG8_WAIT_V
#undef PG8_WAIT_L
#undef PG8_BAR
#undef PG8_SCHED
}
}
#define LAS __attribute__((address_space(3)))
typedef unsigned short bf16_t;
typedef _Float16 hf;
typedef _Float16 h8 __attribute__((ext_vector_type(8)));
typedef _Float16 h4 __attribute__((ext_vector_type(4)));
typedef unsigned u32x4 __attribute__((ext_vector_type(4)));
typedef unsigned u32x2 __attribute__((ext_vector_type(2)));
typedef float f32x4 __attribute__((ext_vector_type(4)));
typedef short bf16x8 __attribute__((ext_vector_type(8)));

constexpr int DM = 1024, NB = 8, SEQ = 4096, CTXL = 256, NLAYER = 4;
constexpr int ML = NB * SEQ, MC = NB * CTXL, MT = ML + MC;
constexpr int INC = 2720, INP = 2816, P1C = 1568, RAWC = 1152, FF = 2816;
constexpr int PRC = 2304, PGC = 512;
constexpr int NTHREADS = 512, NWAVES = 8;
constexpr int LDS_BYTES = 147456;
constexpr size_t MiB = 1u << 20;
constexpr size_t WS_CTL = 0, WS_MOD = 1 * MiB, WS_ROPE = 2 * MiB, WS_BONUS = 3 * MiB, WS_WT = 4 * MiB, WS_XC = 28 * MiB, WS_XN = 36 * MiB,
                 WS_P1 = 104 * MiB, WS_RAW = 209 * MiB, WS_PREP = 286 * MiB, WS_PG = 439 * MiB, WS_GG = 473 * MiB, WS_END = 490 * MiB;
constexpr size_t WS_H = 104 * MiB;
constexpr size_t WS_OR = 209 * MiB, WS_OG = 243 * MiB;
constexpr size_t WT_IN = 0, WT_OUT = (size_t)INP * DM * 2, WT_GU = WT_OUT + (size_t)DM * DM * 2, WT_DN = WT_GU + (size_t)2 * FF * DM * 2;
static_assert(WT_DN + (size_t)DM * FF * 2 == 24 * MiB, "wt");
static_assert(WS_P1 + (size_t)MT * P1C * 2 <= WS_RAW && WS_RAW + (size_t)MT * RAWC * 2 <= WS_PREP && WS_PREP + (size_t)MT * PRC * 2 <= WS_PG && WS_PG + (size_t)MT * PGC * 2 <= WS_GG && WS_GG + (size_t)MT * 256 * 2 <= WS_END, "ws map");
static_assert(WS_OG + (size_t)2 * MT * 256 * 2 <= WS_PREP && WS_H + (size_t)MT * FF * 2 <= WS_PG && WS_XN + (size_t)MT * DM * 2 <= WS_P1, "ws overlay");

struct Params { const float* in[29]; float* out; unsigned char* ws; };
typedef const __attribute__((address_space(4))) Params* kparams_t;

__device__ __forceinline__ float bf2f(unsigned b) { return __uint_as_float(b << 16); }
__device__ __forceinline__ unsigned f2bf(float f) { unsigned u = __float_as_uint(f); return (u + 0x7fffu + ((u >> 16) & 1u)) >> 16; }
__device__ __forceinline__ unsigned pk2(float lo, float hi) { return f2bf(lo) | (f2bf(hi) << 16); }
typedef float f32x2_t __attribute__((ext_vector_type(2))); typedef __bf16 bf16x2_t __attribute__((ext_vector_type(2)));
__device__ __forceinline__ unsigned cvtpk(float lo, float hi) { const f32x2_t v = {lo, hi}; const bf16x2_t b = __builtin_convertvector(v, bf16x2_t); return __builtin_bit_cast(unsigned, b); }
__device__ __forceinline__ float bflo(unsigned w) { return __uint_as_float(w << 16); }
__device__ __forceinline__ float bfhi(unsigned w) { return __uint_as_float(w & 0xffff0000u); }
__device__ __forceinline__ float sigmoidf_(float x) { return __builtin_amdgcn_rcpf(1.0f + __expf(-x)); }
__device__ __forceinline__ float softplusf_(float x) { return fmaxf(x, 0.f) + __logf(1.0f + __expf(-fabsf(x))); }
template <int CTRL> __device__ __forceinline__ float dpp_add(float x) {
    return x + __int_as_float(__builtin_amdgcn_update_dpp(0, __float_as_int(x), CTRL, 0xF, 0xF, true));
}
__device__ __forceinline__ float reduce4(float x) { x = dpp_add<0xB1>(x); x = dpp_add<0x4E>(x); return x; }
__device__ __forceinline__ float reduce16(float x) { x = dpp_add<0xB1>(x); x = dpp_add<0x4E>(x); x = dpp_add<0x141>(x); x = dpp_add<0x140>(x); return x; }
__device__ __forceinline__ float reduce8(float x) { x = dpp_add<0xB1>(x); x = dpp_add<0x4E>(x); x = dpp_add<0x141>(x); return x; }
__device__ __forceinline__ float wave_sum(float v) {
    v = reduce16(v);
    const int vi = __float_as_int(v);
    const float r0 = __int_as_float(__builtin_amdgcn_readlane(vi, 0)), r1 = __int_as_float(__builtin_amdgcn_readlane(vi, 16)), r2 = __int_as_float(__builtin_amdgcn_readlane(vi, 32)), r3 = __int_as_float(__builtin_amdgcn_readlane(vi, 48));
    return (r0 + r1) + (r2 + r3);
}

__device__ __forceinline__ void phase_mod(unsigned char* lds, kparams_t p, int tid, int bid, int G) {
    float* sc = (float*)lds;
    float* part = (float*)(lds + 36864);
    const float* c = p->in[1]; const float* cctx = p->in[3]; const float* ada_w = p->in[4]; const float* ada_b = p->in[5];
    float* MOD = (float*)(p->ws + WS_MOD);
    for (int i = tid; i < 9 * 1024; i += NTHREADS) { const float x = i < 8192 ? c[i] : cctx[i - 8192]; sc[i] = x * sigmoidf_(x); }
    __syncthreads();
    const int cl = tid & 31, kg = tid >> 5;
    for (int item = bid; item < NLAYER * 192; item += G) {
        const int l = item / 192, cgp = item % 192, col = cgp * 32 + cl;
        float acc[9];
#pragma unroll
        for (int s = 0; s < 9; ++s) acc[s] = 0.f;
        const float* w = ada_w + ((size_t)l * 1024 + kg * 64) * 6144 + col;
#pragma unroll 16
        for (int kk = 0; kk < 64; ++kk) { const float wv = w[(size_t)kk * 6144];
#pragma unroll
            for (int s = 0; s < 9; ++s) acc[s] = fmaf(sc[s * 1024 + kg * 64 + kk], wv, acc[s]); }
#pragma unroll
        for (int s = 0; s < 9; ++s) part[(kg * 9 + s) * 32 + cl] = acc[s];
        __syncthreads();
        if (tid < 288) { const int s = tid >> 5; float a = ada_b[l * 6144 + col];
#pragma unroll
            for (int k2 = 0; k2 < 16; ++k2) a += part[(k2 * 9 + s) * 32 + cl];
            MOD[((size_t)l * 9 + s) * 6144 + col] = a; }
        __syncthreads();
    }
    float* RC = (float*)(p->ws + WS_ROPE); float* RS = RC + 4096 * 32;
    for (int idx = bid * NTHREADS + tid; idx < 4096 * 32; idx += G * NTHREADS) {
        const int t = idx >> 5, j = idx & 31; const float pos = (float)(j < 16 ? (t >> 6) : (t & 63));
        const float inv = exp2f(-(float)(j & 15) * (13.287712379549449f / 16.0f));
        const float ang = pos * inv; const float rev = ang * 0.15915494309189535f; const float fr = rev - floorf(rev);
        const float a2 = fr * 6.283185307179586f;
        RC[idx] = __cosf(a2); RS[idx] = __sinf(a2);
    }
}

__device__ __forceinline__ void transpose_item(const float* W, int K, int N, bf16_t* WT, int k0, int n0, int drow0, LAS float* scr, int lane) {
#pragma unroll 16
    for (int i = 0; i < 32; ++i) { const int kk = 2 * i + (lane >> 5); scr[kk * 33 + (lane & 31)] = W[(size_t)(k0 + kk) * N + n0 + (lane & 31)]; }
    asm volatile("s_waitcnt lgkmcnt(0)" ::: "memory");
    const int c = lane & 7;
#pragma unroll
    for (int j = 0; j < 4; ++j) { const int n = (lane >> 3) + 8 * j; const LAS float* s = scr + (8 * c) * 33 + n;
        u32x4 o; o.x = pk2(s[0 * 33], s[1 * 33]); o.y = pk2(s[2 * 33], s[3 * 33]); o.z = pk2(s[4 * 33], s[5 * 33]); o.w = pk2(s[6 * 33], s[7 * 33]);
        *(u32x4*)(WT + (size_t)(drow0 + n) * K + k0 + 8 * c) = o; }
    asm volatile("s_waitcnt lgkmcnt(0)" ::: "memory");
}
__device__ __forceinline__ void convert_weights(unsigned char* lds, kparams_t p, int l, int gw, int ngw, int wave, int lane) {
    LAS float* scr = (LAS float*)((LAS unsigned char*)lds + wave * 16384);
    unsigned char* wt = p->ws + WS_WT;
    constexpr int I_IN = 16 * 85, I_OUT = 16 * 32, I_G = 16 * 88, I_D = 44 * 32;
    constexpr int NIT = I_IN + I_OUT + 2 * I_G + I_D;
    for (int it = gw; it < NIT; it += ngw) {
        int r = it;
        if (r < I_IN) { const int kb = r / 85, nb = r % 85; transpose_item(p->in[8] + (size_t)l * DM * INC, DM, INC, (bf16_t*)(wt + WT_IN), kb * 64, nb * 32, nb * 32, scr, lane); continue; } r -= I_IN;
        if (r < I_OUT) { const int kb = r / 32, nb = r % 32; transpose_item(p->in[9] + (size_t)l * DM * DM, DM, DM, (bf16_t*)(wt + WT_OUT), kb * 64, nb * 32, nb * 32, scr, lane); continue; } r -= I_OUT;
        if (r < I_G) { const int kb = r / 88, nb = r % 88, n0 = nb * 32; transpose_item(p->in[25] + (size_t)l * DM * FF, DM, FF, (bf16_t*)(wt + WT_GU), kb * 64, n0, (n0 >> 7) * 256 + (n0 & 127), scr, lane); continue; } r -= I_G;
        if (r < I_G) { const int kb = r / 88, nb = r % 88, n0 = nb * 32; transpose_item(p->in[26] + (size_t)l * DM * FF, DM, FF, (bf16_t*)(wt + WT_GU), kb * 64, n0, (n0 >> 7) * 256 + 128 + (n0 & 127), scr, lane); continue; } r -= I_G;
        { const int kb = r / 32, nb = r % 32; transpose_item(p->in[27] + (size_t)l * FF * DM, FF, DM, (bf16_t*)(wt + WT_DN), kb * 64, nb * 32, nb * 32, scr, lane); }
    }
}

__device__ __forceinline__ void norm_mod_rows(const float* srcL, const float* srcC, const float* gamma, const float* modl, int shoff, int scoff, bf16_t* XN, int nrows, int gw, int ngw, int lane) {
    int m = gw; f32x4 v[4];
    if (m < nrows) { const float* xr = m < ML ? srcL + (size_t)m * DM : srcC + (size_t)(m - ML) * DM;
#pragma unroll
        for (int j = 0; j < 4; ++j) v[j] = ((const f32x4*)xr)[lane + 64 * j]; }
    while (m < nrows) {
        const int mn = m + ngw; f32x4 vn[4];
        if (mn < nrows) { const float* xr = mn < ML ? srcL + (size_t)mn * DM : srcC + (size_t)(mn - ML) * DM;
#pragma unroll
            for (int j = 0; j < 4; ++j) vn[j] = ((const f32x4*)xr)[lane + 64 * j]; }
        const int s = m < ML ? (m >> 12) : 8; const float* md = modl + (size_t)s * 6144;
        float ss = 0.f;
#pragma unroll
        for (int j = 0; j < 4; ++j) ss += (v[j].x * v[j].x + v[j].y * v[j].y) + (v[j].z * v[j].z + v[j].w * v[j].w);
        const float rstd = rsqrtf(wave_sum(ss) * (1.0f / DM) + 1e-6f);
#pragma unroll
        for (int j = 0; j < 4; ++j) { const int c4 = lane + 64 * j; const f32x4 g = ((const f32x4*)gamma)[c4], sc = ((const f32x4*)(md + scoff))[c4], sh = ((const f32x4*)(md + shoff))[c4];
            const f32x4 y = (v[j] * rstd * g) * (sc + 1.0f) + sh; u32x2 o; o.x = cvtpk(y.x, y.y); o.y = cvtpk(y.z, y.w);
            ((u32x2*)(XN + (size_t)m * DM))[c4] = o; }
#pragma unroll
        for (int j = 0; j < 4; ++j) v[j] = vn[j];
        m = mn;
    }
}
__device__ __forceinline__ void final_norm_rows(float* x, const float* gamma, int gw, int ngw, int lane) {
    for (int m = gw; m < ML; m += ngw) {
        float* xr = x + (size_t)m * DM; f32x4 v[4]; float ss = 0.f;
#pragma unroll
        for (int j = 0; j < 4; ++j) { v[j] = ((const f32x4*)xr)[lane + 64 * j]; ss += (v[j].x * v[j].x + v[j].y * v[j].y) + (v[j].z * v[j].z + v[j].w * v[j].w); }
        const float rstd = rsqrtf(wave_sum(ss) * (1.0f / DM) + 1e-6f);
#pragma unroll
        for (int j = 0; j < 4; ++j) { const int c4 = lane + 64 * j; ((f32x4*)xr)[c4] = v[j] * rstd * ((const f32x4*)gamma)[c4]; }
    }
}
#define XB_TMO      128
#define XB_XCNT(j)  (256  + 64 * (j))
#define XB_XSUB(j)  (1280 + 64 * (j))
#define XB_XGEN(j)  (2304 + 64 * (j))
#define XB_TOP      3328
#define XB_TOPGEN   3392
#define XCD_BAR_WORDS 3456
#define XB_SPIN_CAP (1u << 18)

__device__ __forceinline__ unsigned xb_ld(unsigned* p)              { return __hip_atomic_load(p, __ATOMIC_RELAXED, __HIP_MEMORY_SCOPE_AGENT); }
__device__ __forceinline__ unsigned xb_add(unsigned* p, unsigned v) { return __hip_atomic_fetch_add(p, v, __ATOMIC_RELAXED, __HIP_MEMORY_SCOPE_AGENT); }
__device__ __forceinline__ unsigned xb_xcc_id() { return (unsigned)__builtin_amdgcn_s_getreg((3 << 11) | 20) & 0xFu; }
#define XB_SPIN(cond, bar) do { unsigned _sp = 0; while (cond) { __builtin_amdgcn_s_sleep(1); \
    if ((++_sp & 255u) == 0u) { if (xb_ld(&(bar)[XB_TMO])) break; if (_sp > XB_SPIN_CAP) { atomicAdd(&(bar)[XB_TMO], 1u); break; } } } } while (0)

struct XcdBarrier {
    unsigned* bar; unsigned x;
    volatile LAS unsigned* st;
};

__device__ __forceinline__ XcdBarrier xcd_barrier_post(unsigned* bar, volatile LAS unsigned* st) {
    XcdBarrier b; b.bar = bar; b.x = xb_xcc_id(); b.st = st;
    if (threadIdx.x == 0) (void)xb_add(&bar[XB_XCNT(b.x)], 1u);
    return b;
}
__device__ __forceinline__ void xcd_barrier_complete(unsigned* bar, unsigned x, unsigned& nloc, unsigned& nx) {
    const unsigned G = gridDim.x * gridDim.y * gridDim.z;
    unsigned sum, cnt, mine, sp = 0u;
    for (;;) {
        sum = 0u; cnt = 0u; mine = 0u;
#pragma unroll
        for (unsigned j = 0; j < 16; ++j) { const unsigned c = xb_ld(&bar[XB_XCNT(j)]); sum += c; cnt += (c > 0u) ? 1u : 0u; mine = (j == x) ? c : mine; }
        if (sum == G) break;
        __builtin_amdgcn_s_sleep(1);
        if ((++sp & 255u) == 0u) { if (xb_ld(&bar[XB_TMO])) break; if (sp > XB_SPIN_CAP) { atomicAdd(&bar[XB_TMO], 1u); break; } }
    }
    nloc = mine > 0u ? mine : 1u; nx = cnt > 0u ? cnt : 1u;
}

__device__ __forceinline__ void xcd_barrier(const XcdBarrier& b) {
    asm volatile("s_waitcnt vmcnt(0)" ::: "memory");
    __syncthreads();
    if (threadIdx.x == 0) {
        unsigned* bar = b.bar;
        __builtin_amdgcn_s_waitcnt(0);
        unsigned nloc = b.st[0], nx = b.st[1];
        if (nloc == 0u) { xcd_barrier_complete(bar, b.x, nloc, nx); b.st[0] = nloc; b.st[1] = nx; }
        const unsigned old = xb_add(&bar[XB_XSUB(b.x)], 1u);
        const unsigned gen = old / nloc;
        if (old + 1u == (gen + 1u) * nloc) {
            __builtin_amdgcn_fence(__ATOMIC_RELEASE, "agent");
            asm volatile("s_waitcnt vmcnt(0)" ::: "memory");
            const unsigned og = xb_add(&bar[XB_TOP], 1u);
            const unsigned tg = og / nx;
            if (og + 1u == (tg + 1u) * nx) xb_add(&bar[XB_TOPGEN], 1u);
            else XB_SPIN(xb_ld(&bar[XB_TOPGEN]) == tg, bar);
            __builtin_amdgcn_fence(__ATOMIC_ACQUIRE, "agent");
            xb_add(&bar[XB_XGEN(b.x)], 1u);
            asm volatile("s_waitcnt vmcnt(0)" ::: "memory");
        } else {
            XB_SPIN(xb_ld(&bar[XB_XGEN(b.x)]) == gen, bar);
            __builtin_amdgcn_fence(__ATOMIC_ACQUIRE, "agent");
            asm volatile("s_waitcnt vmcnt(0)" ::: "memory");
        }
    }
    __syncthreads();
}
__device__ __forceinline__ bf16x8 load_wfrag(const float* W, int k0, int c) {
    u32x4 t; t.x = pk2(W[(k0 + 0) * 256 + c], W[(k0 + 1) * 256 + c]); t.y = pk2(W[(k0 + 2) * 256 + c], W[(k0 + 3) * 256 + c]);
    t.z = pk2(W[(k0 + 4) * 256 + c], W[(k0 + 5) * 256 + c]); t.w = pk2(W[(k0 + 6) * 256 + c], W[(k0 + 7) * 256 + c]);
    return __builtin_bit_cast(bf16x8, t);
}
__device__ __forceinline__ u32x2 pack_h4(float a, float b, float c, float d) {
    const h4 v = {(hf)a, (hf)b, (hf)c, (hf)d}; return __builtin_bit_cast(u32x2, v);
}
__device__ __forceinline__ void phase_prep(unsigned char* ldsg, kparams_t p, int l, int tid, int bid, int G, bool do_rope) {
    LAS unsigned char* lds = (LAS unsigned char*)ldsg;
    LAS float* SH = (LAS float*)lds;
    LAS unsigned char* ACT = lds + 73728;
    LAS float* KK = (LAS float*)(lds + 86272);
    LAS float* GL = (LAS float*)(lds + 102656);
    const int lane = tid & 63, wave = tid >> 6, fr = lane & 15, quad = lane >> 4;
    bf16_t* P1 = (bf16_t*)(p->ws + WS_P1); const bf16_t* RAW = (const bf16_t*)(p->ws + WS_RAW);
    hf* PREP = (hf*)(p->ws + WS_PREP); hf* PG = (hf*)(p->ws + WS_PG); hf* GG = (hf*)(p->ws + WS_GG); float* BONUS = (float*)(p->ws + WS_BONUS);
    const float* RC = (const float*)(p->ws + WS_ROPE); const float* RS = RC + 4096 * 32;
    const float* shw = p->in[14] + (size_t)l * 3 * RAWC;
    const float* w0 = p->in[15] + (size_t)l * 512; const float* w2 = p->in[16] + (size_t)l * 2 * 64 * 256;
    const float* a0 = p->in[17] + (size_t)l * 512; const float* a2 = p->in[18] + (size_t)l * 2 * 64 * 256;
    const float* g2 = p->in[19] + (size_t)l * 128 * 256;
    const float* k_k = p->in[20] + l * 256; const float* k_a = p->in[21] + l * 256; const float* r_k = p->in[22] + l * 256;
    const float* dw = p->in[10] + (size_t)l * 2 * 16 * 128; const float* db = p->in[11] + l * 256;
    bf16x8 Fw[2][2][2], Fa[2][2][2], Fg[2][4];
#pragma unroll
    for (int ct2 = 0; ct2 < 2; ++ct2) { const int c = (wave * 2 + ct2) * 16 + fr;
#pragma unroll
        for (int i = 0; i < 2; ++i)
#pragma unroll
            for (int ks = 0; ks < 2; ++ks) { Fw[i][ct2][ks] = load_wfrag(w2 + (size_t)i * 64 * 256, ks * 32 + quad * 8, c); Fa[i][ct2][ks] = load_wfrag(a2 + (size_t)i * 64 * 256, ks * 32 + quad * 8, c); }
#pragma unroll
        for (int ks = 0; ks < 4; ++ks) Fg[ct2][ks] = load_wfrag(g2, ks * 32 + quad * 8, c); }
    const int cgp = tid % 144, part = tid / 144, c8 = cgp * 8;
    const int tokb = part == 0 ? 0 : (part == 1 ? 6 : 11), toke = part == 0 ? 6 : (part == 1 ? 11 : 16);
    for (int tile = bid; tile < MT / 16; tile += G) {
        const int row0 = tile * 16; const bool lat = row0 < ML;
        const int t0 = lat ? (row0 & 4095) : ((row0 - ML) & 255); const int T = lat ? 4096 : 256;
        if (part < 3) {
            float sw0[8], sw1[8], sw2[8];
#pragma unroll
            for (int e = 0; e < 8; ++e) { sw0[e] = shw[c8 + e]; sw1[e] = shw[RAWC + c8 + e]; sw2[e] = shw[2 * RAWC + c8 + e]; }
            const u32x4 z4 = {0u, 0u, 0u, 0u};
            const bf16_t* rp = RAW + (size_t)(row0 + tokb) * RAWC + c8;
            const int ntok = toke - tokb;
            u32x4 rw[8];
#pragma unroll
            for (int j = 0; j < 8; ++j) { const int tt = t0 + tokb - 1 + j; rw[j] = (j < ntok + 2 && tt >= 0 && tt < T) ? *(const u32x4*)(rp + (ptrdiff_t)(j - 1) * RAWC) : z4; }
#pragma unroll
            for (int j = 0; j < 6; ++j) {
                if (j < ntok) {
                    const int tok = tokb + j; const u32x4 prv = rw[j], cur = rw[j + 1], nxt = rw[j + 2];
                    f32x4 o0, o1;
#pragma unroll
                    for (int e = 0; e < 4; ++e) {
                        const float x0 = sw0[2 * e] * bflo(prv[e]) + sw1[2 * e] * bflo(cur[e]) + sw2[2 * e] * bflo(nxt[e]);
                        const float x1 = sw0[2 * e + 1] * bfhi(prv[e]) + sw1[2 * e + 1] * bfhi(cur[e]) + sw2[2 * e + 1] * bfhi(nxt[e]);
                        if (e < 2) { o0[2 * e] = x0; o0[2 * e + 1] = x1; } else { o1[2 * e - 4] = x0; o1[2 * e - 3] = x1; }
                    }
                    *(LAS f32x4*)(SH + tok * RAWC + c8) = o0; *(LAS f32x4*)(SH + tok * RAWC + c8 + 4) = o1;
                }
            }
        }
        { const int tok = tid >> 5, j = tid & 31; GL[j * 16 + tok] = bf2f(P1[(size_t)(row0 + tok) * P1C + 768 + j]); }
        __syncthreads();
        for (int idx = tid; idx < 16 * 192; idx += NTHREADS) {
            const int tok = idx / 192, j2 = (idx % 192) * 2; const float xa = SH[tok * RAWC + 768 + j2], xb = SH[tok * RAWC + 768 + j2 + 1];
            float ya, yb;
            if (j2 < 128) { ya = 1.0f - 2.0f * __builtin_amdgcn_rcpf(__expf(2.0f * xa) + 1.0f); yb = 1.0f - 2.0f * __builtin_amdgcn_rcpf(__expf(2.0f * xb) + 1.0f); }
            else if (j2 < 256) { ya = xa; yb = xb; }
            else { ya = sigmoidf_(xa); yb = sigmoidf_(xb); }
            *(LAS unsigned*)(ACT + tok * 784 + j2 * 2) = cvtpk(ya, yb);
        }
#pragma unroll 1
        for (int i = 0; i < 8; ++i) {
            const int pair = wave * 8 + i, tok = pair >> 2, h = pair & 3, c = h * 64 + lane; const size_t row = row0 + tok;
            const float r = SH[tok * RAWC + c], k = SH[tok * RAWC + 256 + c], v = SH[tok * RAWC + 512 + c];
            const float val = k * k_k[c]; const float ss = wave_sum(val * val); const float kk = val * rsqrtf(ss + 1e-12f);
            KK[tok * 256 + c] = kk;
            const float bon = wave_sum(r * k * r_k[c]);
            if (lane == 0) BONUS[row * 4 + h] = bon;
            PREP[row * PRC + c] = (hf)r; PREP[row * PRC + 256 + c] = (hf)kk; PREP[row * PRC + 512 + c] = (hf)v;
        }
        __syncthreads();
        {
#define BFRAG(s2) (*(const LAS bf16x8*)(ACT + fr * 784 + ((s2) * 32 + quad * 8) * 2))
            const size_t row = row0 + fr;
#pragma unroll
            for (int ct2 = 0; ct2 < 2; ++ct2) {
                const int c0 = (wave * 2 + ct2) * 16 + quad * 4;
                const f32x4 zf = {0.f, 0.f, 0.f, 0.f};
                const f32x4 k4 = *(const LAS f32x4*)(SH + fr * RAWC + 256 + c0), kk4 = *(const LAS f32x4*)(KK + fr * 256 + c0), ka4 = *(const f32x4*)(k_a + c0);
#pragma unroll
                for (int i = 0; i < 2; ++i) {
                    f32x4 aw = __builtin_amdgcn_mfma_f32_16x16x32_bf16(Fw[i][ct2][0], BFRAG(i * 2), zf, 0, 0, 0); aw = __builtin_amdgcn_mfma_f32_16x16x32_bf16(Fw[i][ct2][1], BFRAG(i * 2 + 1), aw, 0, 0, 0);
                    f32x4 aa = __builtin_amdgcn_mfma_f32_16x16x32_bf16(Fa[i][ct2][0], BFRAG(4 + i * 2), zf, 0, 0, 0); aa = __builtin_amdgcn_mfma_f32_16x16x32_bf16(Fa[i][ct2][1], BFRAG(4 + i * 2 + 1), aa, 0, 0, 0);
                    const f32x4 z = aw + *(const f32x4*)(w0 + i * 256 + c0), az = aa + *(const f32x4*)(a0 + i * 256 + c0);
                    float dec[4], bb[4], kd[4];
#pragma unroll
                    for (int j = 0; j < 4; ++j) { dec[j] = __expf(-__expf(-softplusf_(-z[j]) - 0.5f)); const float a = sigmoidf_(az[j]); bb[j] = -(kk4[j] * a); kd[j] = k4[j] * (1.0f + (a - 1.0f) * ka4[j]); }
                    hf* dst = PREP + row * PRC + 768 + i * 768 + c0;
                    *(u32x2*)dst = pack_h4(dec[0], dec[1], dec[2], dec[3]); *(u32x2*)(dst + 256) = pack_h4(bb[0], bb[1], bb[2], bb[3]); *(u32x2*)(dst + 512) = pack_h4(kd[0], kd[1], kd[2], kd[3]);
                }
                f32x4 ag = __builtin_amdgcn_mfma_f32_16x16x32_bf16(Fg[ct2][0], BFRAG(8), zf, 0, 0, 0);
#pragma unroll
                for (int ks = 1; ks < 4; ++ks) ag = __builtin_amdgcn_mfma_f32_16x16x32_bf16(Fg[ct2][ks], BFRAG(8 + ks), ag, 0, 0, 0);
                *(u32x2*)(GG + row * 256 + c0) = pack_h4(ag[0], ag[1], ag[2], ag[3]);
            }
        }
        {
            const int c = tid & 127, i = (tid >> 7) & 1, th = tid >> 8;
            float acc[8]; const float bb = db[i * 128 + c];
#pragma unroll
            for (int q = 0; q < 8; ++q) acc[q] = bb;
            const float* W = dw + (size_t)i * 16 * 128 + c;
#pragma unroll
            for (int j = 0; j < 16; ++j) { const float wv = W[j * 128]; const f32x4 ta = *(const LAS f32x4*)(GL + (i * 16 + j) * 16 + th * 8), tb = *(const LAS f32x4*)(GL + (i * 16 + j) * 16 + th * 8 + 4);
                acc[0] = fmaf(ta.x, wv, acc[0]); acc[1] = fmaf(ta.y, wv, acc[1]); acc[2] = fmaf(ta.z, wv, acc[2]); acc[3] = fmaf(ta.w, wv, acc[3]);
                acc[4] = fmaf(tb.x, wv, acc[4]); acc[5] = fmaf(tb.y, wv, acc[5]); acc[6] = fmaf(tb.z, wv, acc[6]); acc[7] = fmaf(tb.w, wv, acc[7]); }
#pragma unroll
            for (int q = 0; q < 8; ++q) { const float glog = -softplusf_(-acc[q]) * (1.0f / 16.0f); PG[(size_t)(row0 + th * 8 + q) * PGC + 256 + i * 128 + c] = (hf)__expf(glog); }
            { const int tok = tid >> 5, c8q = (tid & 31) * 8; const u32x4 x = *(const u32x4*)(P1 + (size_t)(row0 + tok) * P1C + c8q); const float sc = c8q < 128 ? 0.17677669529663687f : 1.0f;
              u32x4 o;
#pragma unroll
              for (int e = 0; e < 4; ++e) { const h4 t = {(hf)(bflo(x[e]) * sc), (hf)(bfhi(x[e]) * sc), (hf)0.f, (hf)0.f}; o[e] = __builtin_bit_cast(u32x2, t).x; }
              *(u32x4*)(PG + (size_t)(row0 + tok) * PGC + c8q) = o; }
        }
        if (lat && do_rope) {
            for (int task = tid; task < 640; task += NTHREADS) {
                const int tok = task / 40, r = task % 40, hh = r >> 2, gi = r & 3; const int t = t0 + tok;
                bf16_t* ptr = P1 + (size_t)(row0 + tok) * P1C + 800 + hh * 64 + gi * 8;
                const u32x4 x1 = *(const u32x4*)ptr, x2 = *(const u32x4*)(ptr + 32);
                const f32x4 ca = *(const f32x4*)(RC + t * 32 + gi * 8), cb = *(const f32x4*)(RC + t * 32 + gi * 8 + 4), sa = *(const f32x4*)(RS + t * 32 + gi * 8), sb = *(const f32x4*)(RS + t * 32 + gi * 8 + 4);
                const float cs[8] = {ca.x, ca.y, ca.z, ca.w, cb.x, cb.y, cb.z, cb.w}, sn[8] = {sa.x, sa.y, sa.z, sa.w, sb.x, sb.y, sb.z, sb.w};
                u32x4 o1, o2;
#pragma unroll
                for (int e = 0; e < 4; ++e) {
                    const float a0_ = bflo(x1[e]), a1_ = bfhi(x1[e]), b0_ = bflo(x2[e]), b1_ = bfhi(x2[e]);
                    const float c0_ = cs[2 * e], c1_ = cs[2 * e + 1], s0_ = sn[2 * e], s1_ = sn[2 * e + 1];
                    o1[e] = cvtpk(a0_ * c0_ - b0_ * s0_, a1_ * c1_ - b1_ * s1_); o2[e] = cvtpk(a0_ * s0_ + b0_ * c0_, a1_ * s1_ + b1_ * c1_);
                }
                *(u32x4*)ptr = o1; *(u32x4*)(ptr + 32) = o2;
            }
        }
        __syncthreads();
    }
}
#ifndef NO_MIX
#define MIXLO(d, a, h, c) asm("v_fma_mix_f32 %0, %1, %2, %3 op_sel:[0,0,0] op_sel_hi:[0,1,0]" : "=v"(d) : "v"(a), "v"(h), "v"(c))
#define MIXHI(d, a, h, c) asm("v_fma_mix_f32 %0, %1, %2, %3 op_sel:[0,1,0] op_sel_hi:[0,1,0]" : "=v"(d) : "v"(a), "v"(h), "v"(c))
#else
#define MIXLO(d, a, h, c) d = fmaf(a, (float)__builtin_bit_cast(hf, (unsigned short)((h) & 0xffffu)), c)
#define MIXHI(d, a, h, c) d = fmaf(a, (float)__builtin_bit_cast(hf, (unsigned short)((h) >> 16)), c)
#endif
#define DSR128(dst, addr, OFF) asm volatile("ds_read_b128 %0, %1 offset:" #OFF : "=v"(dst) : "v"(addr))
#define DSR64(dst, addr, OFF) asm volatile("ds_read_b64 %0, %1 offset:" #OFF : "=v"(dst) : "v"(addr))
#define DSR16(dst, addr, OFF) asm volatile("ds_read_u16 %0, %1 offset:" #OFF : "=v"(dst) : "v"(addr))
#define LDS_BAR() do { asm volatile("s_waitcnt lgkmcnt(0)" ::: "memory"); __builtin_amdgcn_s_barrier(); asm volatile("" ::: "memory"); } while (0)
#define REP32(M) M(0) M(1) M(2) M(3) M(4) M(5) M(6) M(7) M(8) M(9) M(10) M(11) M(12) M(13) M(14) M(15) M(16) M(17) M(18) M(19) M(20) M(21) M(22) M(23) M(24) M(25) M(26) M(27) M(28) M(29) M(30) M(31)
__device__ __forceinline__ unsigned lds_addr(LAS unsigned char* p) { return (unsigned)(uintptr_t)p; }

__device__ __forceinline__ int chain_row(int b, int dir, int s) {
    if (s < 256) return ML + b * 256 + (dir ? 255 - s : s);
    const int t = s - 256; return b * 4096 + (dir ? 4095 - t : t);
}
constexpr int NCHUNK = (SEQ + CTXL) / 32;
__device__ __forceinline__ void rwkv_scan_item(unsigned char* ldsg, kparams_t p, int item, int tid, int expflag) {
    LAS unsigned char* lds = (LAS unsigned char*)ldsg;
    constexpr int STEPB = 704, BUFB = 32 * STEPB, NPIECE = 32 * 44;
    LAS unsigned char* obuf = lds + 2 * BUFB;
    const int chain = item >> 1, half_ = item & 1, b = chain >> 3, h = (chain >> 1) & 3, dir = chain & 1;
    const int lane = tid & 63, wave = tid >> 6, kq = lane & 15, rloc = wave * 4 + (lane >> 4);
    const hf* PREP = (const hf*)(p->ws + WS_PREP); hf* OR = (hf*)(p->ws + WS_OR) + (size_t)dir * MT * 256;
    int srcoff[6]; srcoff[0] = h * 64; srcoff[1] = 256 + h * 64; srcoff[2] = 768 + dir * 768 + h * 64; srcoff[3] = srcoff[2] + 256; srcoff[4] = srcoff[2] + 512; srcoff[5] = 512 + h * 64 + half_ * 32;
    float S[4];
#pragma unroll
    for (int i = 0; i < 4; ++i) S[i] = 0.f;
    u32x4 pre[3];
#define RW_ISSUE(cc) do { const bool isctx_ = (cc) < 8; _Pragma("unroll") for (int i_ = 0; i_ < 3; ++i_) { int pp = tid + i_ * NTHREADS; pp = pp < NPIECE ? pp : pp - NTHREADS; const int st = pp / 44, q = pp % 44; \
        const int s_ = (cc) * 32 + st, t_ = s_ - 256; const int row = isctx_ ? (ML + b * 256 + (dir ? 255 - s_ : s_)) : (b * 4096 + (dir ? 4095 - t_ : t_)); \
        const int arr = q >> 3; const int so = arr == 0 ? srcoff[0] : arr == 1 ? srcoff[1] : arr == 2 ? srcoff[2] : arr == 3 ? srcoff[3] : arr == 4 ? srcoff[4] : srcoff[5]; \
        pre[i_] = *(const u32x4*)(PREP + (size_t)row * PRC + so + (q & 7) * 8); } } while (0)
#define RW_COMMIT(cc) do { _Pragma("unroll") for (int i_ = 0; i_ < 3; ++i_) { const int pp = tid + i_ * NTHREADS; if (pp < NPIECE) { const int st = pp / 44, q = pp % 44; \
        *(LAS u32x4*)(lds + ((cc) & 1) * BUFB + st * STEPB + q * 16) = pre[i_]; } } } while (0)
    RW_ISSUE(0); RW_COMMIT(0); RW_ISSUE(1);
    __syncthreads();
    for (int c = 0; c < NCHUNK; ++c) {
        if (expflag != 2) { if (c + 1 < NCHUNK) RW_COMMIT(c + 1);
        if (c + 2 < NCHUNK) RW_ISSUE(c + 2); }
        if (c > 0 && tid < 128) { const int cc = c - 1; const int st = tid >> 2, pc = tid & 3; const int row = chain_row(b, dir, cc * 32 + st);
            *(u32x4*)(OR + (size_t)row * 256 + h * 64 + half_ * 32 + pc * 8) = *(const LAS u32x4*)(obuf + (cc & 1) * 2048 + st * 64 + pc * 16); }
        if (expflag != 1) {
            const unsigned abase = lds_addr(lds + (c & 1) * BUFB) + kq * 8, vbase = lds_addr(lds + (c & 1) * BUFB) + 640 + rloc * 2;
            LAS hf* op = (LAS hf*)(obuf + (c & 1) * 2048 + rloc * 2);
            u32x2 LR[2], LK[2], LW[2], LB[2], LD[2]; unsigned LV[2]; const float zero = 0.f;
#define RW_LOAD(slot, o0, o1, o2, o3, o4) do { DSR64(LR[slot], abase, o0); DSR64(LK[slot], abase, o1); DSR64(LW[slot], abase, o2); DSR64(LB[slot], abase, o3); DSR64(LD[slot], abase, o4); } while (0)
#define RW_COMPUTE(cur, st) do { \
                const float vv = (float)__builtin_bit_cast(hf, (unsigned short)LV[cur]); \
                float sa0 = 0.f, sa1 = 0.f; \
                _Pragma("unroll") for (int i = 0; i < 2; ++i) { MIXLO(sa0, S[2 * i], LK[cur][i], sa0); MIXHI(sa1, S[2 * i + 1], LK[cur][i], sa1); } \
                const float nsa = reduce16(sa0 + sa1); \
                float o0 = 0.f, o1 = 0.f; \
                _Pragma("unroll") for (int i = 0; i < 2; ++i) { float u0, u1; \
                    MIXLO(u0, vv, LD[cur][i], zero); MIXHI(u1, vv, LD[cur][i], zero); \
                    MIXLO(u0, nsa, LB[cur][i], u0); MIXHI(u1, nsa, LB[cur][i], u1); \
                    MIXLO(S[2 * i], S[2 * i], LW[cur][i], u0); MIXHI(S[2 * i + 1], S[2 * i + 1], LW[cur][i], u1); \
                    MIXLO(o0, S[2 * i], LR[cur][i], o0); MIXHI(o1, S[2 * i + 1], LR[cur][i], o1); } \
                const float o = reduce16(o0 + o1); \
                op[(st) * 32] = (hf)o; } while (0)
#define RW_PIN(n, cur) asm volatile("s_waitcnt lgkmcnt(" #n ")" : "+v"(LR[cur]), "+v"(LK[cur]), "+v"(LW[cur]), "+v"(LB[cur]), "+v"(LD[cur]), "+v"(LV[cur]))
            RW_LOAD(0, 0, 128, 256, 384, 512); DSR16(LV[0], vbase, 0);
            RW_LOAD(1, 704, 832, 960, 1088, 1216); DSR16(LV[1], vbase, 704); RW_PIN(6, 0); RW_COMPUTE(0, 0);
            RW_LOAD(0, 1408, 1536, 1664, 1792, 1920); DSR16(LV[0], vbase, 1408); RW_PIN(6, 1); RW_COMPUTE(1, 1);
            RW_LOAD(1, 2112, 2240, 2368, 2496, 2624); DSR16(LV[1], vbase, 2112); RW_PIN(6, 0); RW_COMPUTE(0, 2);
            RW_LOAD(0, 2816, 2944, 3072, 3200, 3328); DSR16(LV[0], vbase, 2816); RW_PIN(6, 1); RW_COMPUTE(1, 3);
            RW_LOAD(1, 3520, 3648, 3776, 3904, 4032); DSR16(LV[1], vbase, 3520); RW_PIN(6, 0); RW_COMPUTE(0, 4);
            RW_LOAD(0, 4224, 4352, 4480, 4608, 4736); DSR16(LV[0], vbase, 4224); RW_PIN(6, 1); RW_COMPUTE(1, 5);
            RW_LOAD(1, 4928, 5056, 5184, 5312, 5440); DSR16(LV[1], vbase, 4928); RW_PIN(6, 0); RW_COMPUTE(0, 6);
            RW_LOAD(0, 5632, 5760, 5888, 6016, 6144); DSR16(LV[0], vbase, 5632); RW_PIN(6, 1); RW_COMPUTE(1, 7);
            RW_LOAD(1, 6336, 6464, 6592, 6720, 6848); DSR16(LV[1], vbase, 6336); RW_PIN(6, 0); RW_COMPUTE(0, 8);
            RW_LOAD(0, 7040, 7168, 7296, 7424, 7552); DSR16(LV[0], vbase, 7040); RW_PIN(6, 1); RW_COMPUTE(1, 9);
            RW_LOAD(1, 7744, 7872, 8000, 8128, 8256); DSR16(LV[1], vbase, 7744); RW_PIN(6, 0); RW_COMPUTE(0, 10);
            RW_LOAD(0, 8448, 8576, 8704, 8832, 8960); DSR16(LV[0], vbase, 8448); RW_PIN(6, 1); RW_COMPUTE(1, 11);
            RW_LOAD(1, 9152, 9280, 9408, 9536, 9664); DSR16(LV[1], vbase, 9152); RW_PIN(6, 0); RW_COMPUTE(0, 12);
            RW_LOAD(0, 9856, 9984, 10112, 10240, 10368); DSR16(LV[0], vbase, 9856); RW_PIN(6, 1); RW_COMPUTE(1, 13);
            RW_LOAD(1, 10560, 10688, 10816, 10944, 11072); DSR16(LV[1], vbase, 10560); RW_PIN(6, 0); RW_COMPUTE(0, 14);
            RW_LOAD(0, 11264, 11392, 11520, 11648, 11776); DSR16(LV[0], vbase, 11264); RW_PIN(6, 1); RW_COMPUTE(1, 15);
            RW_LOAD(1, 11968, 12096, 12224, 12352, 12480); DSR16(LV[1], vbase, 11968); RW_PIN(6, 0); RW_COMPUTE(0, 16);
            RW_LOAD(0, 12672, 12800, 12928, 13056, 13184); DSR16(LV[0], vbase, 12672); RW_PIN(6, 1); RW_COMPUTE(1, 17);
            RW_LOAD(1, 13376, 13504, 13632, 13760, 13888); DSR16(LV[1], vbase, 13376); RW_PIN(6, 0); RW_COMPUTE(0, 18);
            RW_LOAD(0, 14080, 14208, 14336, 14464, 14592); DSR16(LV[0], vbase, 14080); RW_PIN(6, 1); RW_COMPUTE(1, 19);
            RW_LOAD(1, 14784, 14912, 15040, 15168, 15296); DSR16(LV[1], vbase, 14784); RW_PIN(6, 0); RW_COMPUTE(0, 20);
            RW_LOAD(0, 15488, 15616, 15744, 15872, 16000); DSR16(LV[0], vbase, 15488); RW_PIN(6, 1); RW_COMPUTE(1, 21);
            RW_LOAD(1, 16192, 16320, 16448, 16576, 16704); DSR16(LV[1], vbase, 16192); RW_PIN(6, 0); RW_COMPUTE(0, 22);
            RW_LOAD(0, 16896, 17024, 17152, 17280, 17408); DSR16(LV[0], vbase, 16896); RW_PIN(6, 1); RW_COMPUTE(1, 23);
            RW_LOAD(1, 17600, 17728, 17856, 17984, 18112); DSR16(LV[1], vbase, 17600); RW_PIN(6, 0); RW_COMPUTE(0, 24);
            RW_LOAD(0, 18304, 18432, 18560, 18688, 18816); DSR16(LV[0], vbase, 18304); RW_PIN(6, 1); RW_COMPUTE(1, 25);
            RW_LOAD(1, 19008, 19136, 19264, 19392, 19520); DSR16(LV[1], vbase, 19008); RW_PIN(6, 0); RW_COMPUTE(0, 26);
            RW_LOAD(0, 19712, 19840, 19968, 20096, 20224); DSR16(LV[0], vbase, 19712); RW_PIN(6, 1); RW_COMPUTE(1, 27);
            RW_LOAD(1, 20416, 20544, 20672, 20800, 20928); DSR16(LV[1], vbase, 20416); RW_PIN(6, 0); RW_COMPUTE(0, 28);
            RW_LOAD(0, 21120, 21248, 21376, 21504, 21632); DSR16(LV[0], vbase, 21120); RW_PIN(6, 1); RW_COMPUTE(1, 29);
            RW_LOAD(1, 21824, 21952, 22080, 22208, 22336); DSR16(LV[1], vbase, 21824); RW_PIN(6, 0); RW_COMPUTE(0, 30);
            RW_PIN(0, 1); RW_COMPUTE(1, 31);
#undef RW_LOAD
#undef RW_COMPUTE
#undef RW_PIN
        }
        LDS_BAR();
    }
    { const int cc = NCHUNK - 1; if (tid < 128) { const int st = tid >> 2, pc = tid & 3; const int row = chain_row(b, dir, cc * 32 + st);
        *(u32x4*)(OR + (size_t)row * 256 + h * 64 + half_ * 32 + pc * 8) = *(const LAS u32x4*)(obuf + (cc & 1) * 2048 + st * 64 + pc * 16); } }
#undef RW_ISSUE
#undef RW_COMMIT
}
__device__ __forceinline__ void gla_scan_item(unsigned char* ldsg, kparams_t p, int item, int tid) {
    const int chain = item >> 1, half_ = item & 1;
    LAS unsigned char* lds = (LAS unsigned char*)ldsg;
    constexpr int STEPB = 320, BUFB = 32 * STEPB, NPIECE = 32 * 20;
    LAS unsigned char* obuf = lds + 2 * BUFB;
    const int b = chain >> 3, h = (chain >> 1) & 3, dir = chain & 1;
    const int lane = tid & 63, wave = tid >> 6, dq = lane & 7, col = half_ * 32 + (wave & 3) * 8 + (lane >> 3);
    const hf* PG = (const hf*)(p->ws + WS_PG); const bf16_t* P1 = (const bf16_t*)(p->ws + WS_P1); hf* OG = (hf*)(p->ws + WS_OG) + (size_t)dir * MT * 256;
    float S[4];
#pragma unroll
    for (int i = 0; i < 4; ++i) S[i] = 0.f;
    u32x4 pre[3]; const int t4 = tid - 256;
#define GL_ISSUE(cc) do { const bool isctx_ = (cc) < 8; _Pragma("unroll") for (int i_ = 0; i_ < 3; ++i_) { int pp = t4 + i_ * 256; pp = pp < NPIECE ? pp : pp - 256; const int st = pp / 20, q = pp % 20; \
        const int s_ = (cc) * 32 + st, t_ = s_ - 256; const int row = isctx_ ? (ML + b * 256 + (dir ? 255 - s_ : s_)) : (b * 4096 + (dir ? 4095 - t_ : t_)); \
        const int arr = q >> 2; const int so = arr == 0 ? h * 32 : arr == 1 ? 128 + h * 32 : 256 + dir * 128 + h * 32; \
        const unsigned char* sp = q < 12 ? (const unsigned char*)(PG + (size_t)row * PGC + so + (q & 3) * 8) : (const unsigned char*)(P1 + (size_t)row * P1C + 256 + h * 64 + (q - 12) * 8); \
        pre[i_] = *(const u32x4*)sp; } } while (0)
#define GL_COMMIT(cc) do { _Pragma("unroll") for (int i_ = 0; i_ < 3; ++i_) { const int pp = t4 + i_ * 256; if (pp < NPIECE) { const int st = pp / 20, q = pp % 20; \
        *(LAS u32x4*)(lds + ((cc) & 1) * BUFB + st * STEPB + q * 16) = pre[i_]; } } } while (0)
    if (wave >= 4) { GL_ISSUE(0); GL_COMMIT(0); GL_ISSUE(1); }
    __syncthreads();
    for (int c = 0; c < NCHUNK; ++c) {
        if (wave >= 4) {
            if (c + 1 < NCHUNK) GL_COMMIT(c + 1);
            if (c + 2 < NCHUNK) GL_ISSUE(c + 2);
            if (c > 0 && t4 < 128) { const int cc = c - 1; const int st = t4 >> 2, pc = t4 & 3; const int row = chain_row(b, dir, cc * 32 + st);
                *(u32x4*)(OG + (size_t)row * 256 + h * 64 + half_ * 32 + pc * 8) = *(const LAS u32x4*)(obuf + (cc & 1) * 4096 + st * 128 + half_ * 64 + pc * 16); }
        }
        if (wave < 4) {
            const unsigned abase = lds_addr(lds + (c & 1) * BUFB) + dq * 8, vbase = lds_addr(lds + (c & 1) * BUFB) + 192 + col * 2;
            LAS hf* op = (LAS hf*)(obuf + (c & 1) * 4096 + col * 2);
            u32x2 LQ[2], LK[2], LE[2]; unsigned LV[2]; const float zero = 0.f;
#define GL_LOAD(slot, o0, o1, o2) do { DSR64(LQ[slot], abase, o0); DSR64(LK[slot], abase, o1); DSR64(LE[slot], abase, o2); } while (0)
#define GL_COMPUTE(cur, st) do { \
                const float vv = __uint_as_float(LV[cur] << 16); \
                float o0 = 0.f, o1 = 0.f; \
                _Pragma("unroll") for (int i = 0; i < 2; ++i) { float u0, u1; \
                    MIXLO(u0, vv, LK[cur][i], zero); MIXHI(u1, vv, LK[cur][i], zero); \
                    MIXLO(S[2 * i], S[2 * i], LE[cur][i], u0); MIXHI(S[2 * i + 1], S[2 * i + 1], LE[cur][i], u1); \
                    MIXLO(o0, S[2 * i], LQ[cur][i], o0); MIXHI(o1, S[2 * i + 1], LQ[cur][i], o1); } \
                const float o = reduce8(o0 + o1); \
                op[(st) * 64] = (hf)o; } while (0)
#define GL_PIN(n, cur) asm volatile("s_waitcnt lgkmcnt(" #n ")" : "+v"(LQ[cur]), "+v"(LK[cur]), "+v"(LE[cur]), "+v"(LV[cur]))
            GL_LOAD(0, 0, 64, 128); DSR16(LV[0], vbase, 0);
            GL_LOAD(1, 320, 384, 448); DSR16(LV[1], vbase, 320); GL_PIN(4, 0); GL_COMPUTE(0, 0);
            GL_LOAD(0, 640, 704, 768); DSR16(LV[0], vbase, 640); GL_PIN(4, 1); GL_COMPUTE(1, 1);
            GL_LOAD(1, 960, 1024, 1088); DSR16(LV[1], vbase, 960); GL_PIN(4, 0); GL_COMPUTE(0, 2);
            GL_LOAD(0, 1280, 1344, 1408); DSR16(LV[0], vbase, 1280); GL_PIN(4, 1); GL_COMPUTE(1, 3);
            GL_LOAD(1, 1600, 1664, 1728); DSR16(LV[1], vbase, 1600); GL_PIN(4, 0); GL_COMPUTE(0, 4);
            GL_LOAD(0, 1920, 1984, 2048); DSR16(LV[0], vbase, 1920); GL_PIN(4, 1); GL_COMPUTE(1, 5);
            GL_LOAD(1, 2240, 2304, 2368); DSR16(LV[1], vbase, 2240); GL_PIN(4, 0); GL_COMPUTE(0, 6);
            GL_LOAD(0, 2560, 2624, 2688); DSR16(LV[0], vbase, 2560); GL_PIN(4, 1); GL_COMPUTE(1, 7);
            GL_LOAD(1, 2880, 2944, 3008); DSR16(LV[1], vbase, 2880); GL_PIN(4, 0); GL_COMPUTE(0, 8);
            GL_LOAD(0, 3200, 3264, 3328); DSR16(LV[0], vbase, 3200); GL_PIN(4, 1); GL_COMPUTE(1, 9);
            GL_LOAD(1, 3520, 3584, 3648); DSR16(LV[1], vbase, 3520); GL_PIN(4, 0); GL_COMPUTE(0, 10);
            GL_LOAD(0, 3840, 3904, 3968); DSR16(LV[0], vbase, 3840); GL_PIN(4, 1); GL_COMPUTE(1, 11);
            GL_LOAD(1, 4160, 4224, 4288); DSR16(LV[1], vbase, 4160); GL_PIN(4, 0); GL_COMPUTE(0, 12);
            GL_LOAD(0, 4480, 4544, 4608); DSR16(LV[0], vbase, 4480); GL_PIN(4, 1); GL_COMPUTE(1, 13);
            GL_LOAD(1, 4800, 4864, 4928); DSR16(LV[1], vbase, 4800); GL_PIN(4, 0); GL_COMPUTE(0, 14);
            GL_LOAD(0, 5120, 5184, 5248); DSR16(LV[0], vbase, 5120); GL_PIN(4, 1); GL_COMPUTE(1, 15);
            GL_LOAD(1, 5440, 5504, 5568); DSR16(LV[1], vbase, 5440); GL_PIN(4, 0); GL_COMPUTE(0, 16);
            GL_LOAD(0, 5760, 5824, 5888); DSR16(LV[0], vbase, 5760); GL_PIN(4, 1); GL_COMPUTE(1, 17);
            GL_LOAD(1, 6080, 6144, 6208); DSR16(LV[1], vbase, 6080); GL_PIN(4, 0); GL_COMPUTE(0, 18);
            GL_LOAD(0, 6400, 6464, 6528); DSR16(LV[0], vbase, 6400); GL_PIN(4, 1); GL_COMPUTE(1, 19);
            GL_LOAD(1, 6720, 6784, 6848); DSR16(LV[1], vbase, 6720); GL_PIN(4, 0); GL_COMPUTE(0, 20);
            GL_LOAD(0, 7040, 7104, 7168); DSR16(LV[0], vbase, 7040); GL_PIN(4, 1); GL_COMPUTE(1, 21);
            GL_LOAD(1, 7360, 7424, 7488); DSR16(LV[1], vbase, 7360); GL_PIN(4, 0); GL_COMPUTE(0, 22);
            GL_LOAD(0, 7680, 7744, 7808); DSR16(LV[0], vbase, 7680); GL_PIN(4, 1); GL_COMPUTE(1, 23);
            GL_LOAD(1, 8000, 8064, 8128); DSR16(LV[1], vbase, 8000); GL_PIN(4, 0); GL_COMPUTE(0, 24);
            GL_LOAD(0, 8320, 8384, 8448); DSR16(LV[0], vbase, 8320); GL_PIN(4, 1); GL_COMPUTE(1, 25);
            GL_LOAD(1, 8640, 8704, 8768); DSR16(LV[1], vbase, 8640); GL_PIN(4, 0); GL_COMPUTE(0, 26);
            GL_LOAD(0, 8960, 9024, 9088); DSR16(LV[0], vbase, 8960); GL_PIN(4, 1); GL_COMPUTE(1, 27);
            GL_LOAD(1, 9280, 9344, 9408); DSR16(LV[1], vbase, 9280); GL_PIN(4, 0); GL_COMPUTE(0, 28);
            GL_LOAD(0, 9600, 9664, 9728); DSR16(LV[0], vbase, 9600); GL_PIN(4, 1); GL_COMPUTE(1, 29);
            GL_LOAD(1, 9920, 9984, 10048); DSR16(LV[1], vbase, 9920); GL_PIN(4, 0); GL_COMPUTE(0, 30);
            GL_PIN(0, 1); GL_COMPUTE(1, 31);
#undef GL_LOAD
#undef GL_COMPUTE
#undef GL_PIN
        }
        LDS_BAR();
    }
    if (t4 >= 0 && t4 < 128) { const int cc = NCHUNK - 1; const int st = t4 >> 2, pc = t4 & 3; const int row = chain_row(b, dir, cc * 32 + st);
        *(u32x4*)(OG + (size_t)row * 256 + h * 64 + half_ * 32 + pc * 8) = *(const LAS u32x4*)(obuf + (cc & 1) * 4096 + st * 128 + half_ * 64 + pc * 16); }
#undef GL_ISSUE
#undef GL_COMMIT
}
__device__ __forceinline__ bf16x8 mk_op(unsigned a, unsigned b, unsigned c, unsigned d) { const u32x4 t = {a, b, c, d}; return __builtin_bit_cast(bf16x8, t); }
__device__ __forceinline__ void ck_p1_step(const LAS unsigned char* in, LAS unsigned char* KKI, LAS unsigned char* BTI, LAS unsigned char* KDI, LAS unsigned char* RTI, LAS unsigned char* AUP, LAS unsigned char* VTI,
                                           int k, int t, float gprev, float gt, float gC) {
    const float inv = __builtin_amdgcn_rcpf(gt);
    const LAS unsigned char* sp = in + t * 768 + k * 2;
    const float r = (float)*(const LAS hf*)sp, kk = (float)*(const LAS hf*)(sp + 128), nb = (float)*(const LAS hf*)(sp + 384), kd = (float)*(const LAS hf*)(sp + 512), vv = (float)*(const LAS hf*)(sp + 640);
    const float nbi = nb * inv, kdi = kd * inv;
    const unsigned pa = cvtpk(kk * gprev, nbi), pb = cvtpk(kdi, r * gt), pc = cvtpk(nbi * gC, kdi * gC), pd = cvtpk(vv, vv);
    *(LAS unsigned short*)(KKI + t * 144 + k * 2) = (unsigned short)(pa & 0xffffu); *(LAS unsigned short*)(BTI + t * 144 + k * 2) = (unsigned short)(pa >> 16);
    *(LAS unsigned short*)(KDI + t * 144 + k * 2) = (unsigned short)(pb & 0xffffu); *(LAS unsigned short*)(RTI + t * 144 + k * 2) = (unsigned short)(pb >> 16);
    const int slot = (t >> 2) * 8 + (t & 3);
    *(LAS unsigned short*)(AUP + k * 80 + slot * 2) = (unsigned short)(pc & 0xffffu); *(LAS unsigned short*)(AUP + k * 80 + (slot + 4) * 2) = (unsigned short)(pc >> 16);
    *(LAS unsigned short*)(VTI + k * 32 + t * 2) = (unsigned short)(pd & 0xffffu);
}
__device__ __forceinline__ void rwkv_chunk_item(unsigned char* ldsg, kparams_t p, int chain, int tid, int expflag) {
    (void)expflag;
    LAS unsigned char* lds = (LAS unsigned char*)ldsg;
    constexpr int INB = 16 * 768, NPIECE = 16 * 48, NCH = (SEQ + CTXL) / 16, IMGB = 16640;
    LAS unsigned char* IMG0 = lds + 3 * INB;
    LAS unsigned char* SM0 = IMG0 + 3 * IMGB;
    LAS unsigned char* NI = SM0;
    LAS unsigned char* MMI = NI + 4096;
    LAS unsigned char* AOI = MMI + 512;
    LAS unsigned char* OBI = SM0 + 2 * 5632;
    const int b = chain >> 3, h = (chain >> 1) & 3, dir = chain & 1;
    const int lane = tid & 63, wave = __builtin_amdgcn_readfirstlane(tid >> 6), fr = lane & 15, quad = lane >> 4;
    const hf* PREP = (const hf*)(p->ws + WS_PREP); hf* OR = (hf*)(p->ws + WS_OR) + (size_t)dir * MT * 256;
    const int so0 = h * 64, so1 = 256 + h * 64, so2 = 768 + dir * 768 + h * 64, so5 = 512 + h * 64;
    u32x4 pre[2];
    const int pp0_ = tid, pp1_ = tid < 256 ? tid + 512 : tid;
    const int st0_ = pp0_ / 48, q0_ = pp0_ % 48, st1_ = pp1_ / 48, q1_ = pp1_ % 48;
    const int ar0_ = q0_ >> 3, ar1_ = q1_ >> 3;
    const int sof0_ = (ar0_ == 0 ? so0 : ar0_ == 1 ? so1 : ar0_ == 2 ? so2 : ar0_ == 3 ? so2 + 256 : ar0_ == 4 ? so2 + 512 : so5) + (q0_ & 7) * 8;
    const int sof1_ = (ar1_ == 0 ? so0 : ar1_ == 1 ? so1 : ar1_ == 2 ? so2 : ar1_ == 3 ? so2 + 256 : ar1_ == 4 ? so2 + 512 : so5) + (q1_ & 7) * 8;
    const hf* pl0_ = PREP + (size_t)(b * 4096 + (dir ? 4095 - st0_ : st0_)) * PRC + sof0_;
    const hf* pl1_ = PREP + (size_t)(b * 4096 + (dir ? 4095 - st1_ : st1_)) * PRC + sof1_;
    const hf* cur0_ = PREP + (size_t)(ML + b * 256 + (dir ? 255 - st0_ : st0_)) * PRC + sof0_;
    const hf* cur1_ = PREP + (size_t)(ML + b * 256 + (dir ? 255 - st1_ : st1_)) * PRC + sof1_;
    const ptrdiff_t stepH_ = (ptrdiff_t)(dir ? -16 : 16) * PRC;
    const int lo0_ = st0_ * 768 + q0_ * 16, lo1_ = st1_ * 768 + q1_ * 16;
    int icc_ = 0, cbuf_ = 0, wcc_ = 0;
    const int wst_ = (tid & 127) >> 3, wpc_ = tid & 7;
    hf* wcur_ = OR + (size_t)(ML + b * 256 + (dir ? 255 - wst_ : wst_)) * 256 + h * 64 + wpc_ * 8;
    hf* wlat_ = OR + (size_t)(b * 4096 + (dir ? 4095 - wst_ : wst_)) * 256 + h * 64 + wpc_ * 8;
    const ptrdiff_t wstep_ = (ptrdiff_t)(dir ? -16 : 16) * 256;
#define CK_ISSUE(cc) do { if (icc_ == 16) { cur0_ = pl0_; cur1_ = pl1_; } pre[0] = *(const u32x4*)cur0_; pre[1] = *(const u32x4*)cur1_; cur0_ += stepH_; cur1_ += stepH_; ++icc_; } while (0)
#define CK_COMMIT(cc) do { *(LAS u32x4*)(lds + cbuf_ + lo0_) = pre[0]; if (tid < 256) *(LAS u32x4*)(lds + cbuf_ + lo1_) = pre[1]; cbuf_ = (cbuf_ == 2 * INB) ? 0 : cbuf_ + INB; } while (0)
#define CK_WRITEOUT(cc) do { if (wcc_ == 16) wcur_ = wlat_; if (tid < 128) *(u32x4*)wcur_ = *(const LAS u32x4*)(OBI + ((cc) & 1) * 2048 + wst_ * 128 + wpc_ * 16); wcur_ += wstep_; ++wcc_; } while (0)
    float gq0 = 1.f, gq1 = 1.f, gq2 = 1.f, gq3 = 1.f, gq4 = 1.f, gqC = 1.f;
#define CK_P1A(cc) do { const LAS unsigned char* in_ = lds + ((cc) % 3) * INB; LAS unsigned char* im_ = IMG0 + ((cc) % 3) * IMGB; const int wv_ = wave - 4, tb_ = wv_ * 4; \
        float w_[16]; _Pragma("unroll") for (int i_ = 0; i_ < 16; ++i_) w_[i_] = (float)*(const LAS hf*)(in_ + i_ * 768 + 256 + lane * 2); \
        const float G0_ = (w_[0] * w_[1]) * (w_[2] * w_[3]), G1_ = (w_[4] * w_[5]) * (w_[6] * w_[7]), G2_ = (w_[8] * w_[9]) * (w_[10] * w_[11]), G3_ = (w_[12] * w_[13]) * (w_[14] * w_[15]); \
        const float pfx_ = (wv_ > 0 ? G0_ : 1.f) * ((wv_ > 1 ? G1_ : 1.f) * (wv_ > 2 ? G2_ : 1.f)); \
        const float sfx_ = (wv_ < 3 ? G3_ : 1.f) * ((wv_ < 2 ? G2_ : 1.f) * (wv_ < 1 ? G1_ : 1.f)); \
        const LAS unsigned char* ow_ = in_ + tb_ * 768 + 256 + lane * 2; \
        const float o0_ = (float)*(const LAS hf*)ow_, o1_ = (float)*(const LAS hf*)(ow_ + 768), o2_ = (float)*(const LAS hf*)(ow_ + 1536), o3_ = (float)*(const LAS hf*)(ow_ + 2304); \
        gq0 = pfx_; gq1 = gq0 * o0_; gq2 = gq1 * o1_; gq3 = gq2 * o2_; gq4 = gq3 * o3_; gqC = gq4 * sfx_; \
        if (wave == 4) *(LAS float*)(im_ + 14336 + lane * 4) = gqC; \
        ck_p1_step(in_, im_, im_ + 2304, im_ + 4608, im_ + 6912, im_ + 9216, im_ + 14592, lane, tb_, gq0, gq1, gqC); \
        ck_p1_step(in_, im_, im_ + 2304, im_ + 4608, im_ + 6912, im_ + 9216, im_ + 14592, lane, tb_ + 1, gq1, gq2, gqC);  } while (0)
#define CK_P1B(cc) do { const LAS unsigned char* in_ = lds + ((cc) % 3) * INB; LAS unsigned char* im_ = IMG0 + ((cc) % 3) * IMGB; const int tb_ = (wave - 4) * 4; \
        ck_p1_step(in_, im_, im_ + 2304, im_ + 4608, im_ + 6912, im_ + 9216, im_ + 14592, lane, tb_ + 2, gq2, gq3, gqC); \
        ck_p1_step(in_, im_, im_ + 2304, im_ + 4608, im_ + 6912, im_ + 9216, im_ + 14592, lane, tb_ + 3, gq3, gq4, gqC); } while (0)
    f32x4 St[4];
#pragma unroll
    for (int i = 0; i < 4; ++i) St[i] = (f32x4){0.f, 0.f, 0.f, 0.f};
    CK_ISSUE(0); CK_COMMIT(0); CK_ISSUE(1); CK_COMMIT(1); CK_ISSUE(2); CK_COMMIT(2); CK_ISSUE(3);
    __syncthreads();
    if (wave >= 4) { CK_P1A(0); CK_P1B(0); CK_P1A(1); CK_P1B(1); }
    LDS_BAR();
    {   const int c = -1;
        LAS unsigned char* im = IMG0 + ((c + 1) % 3) * IMGB;
        LAS unsigned char* KKI = im; LAS unsigned char* BTI = im + 2304; LAS unsigned char* KDI = im + 4608; LAS unsigned char* RTI = im + 6912;
        LAS unsigned char* NI = SM0 + ((c + 1) & 1) * 5632; LAS unsigned char* MMI = NI + 4096; LAS unsigned char* AOI = MMI + 512;
        (void)NI; (void)MMI; (void)AOI;
        f32x4 accN = (f32x4){0.f, 0.f, 0.f, 0.f}, accNT = (f32x4){0.f, 0.f, 0.f, 0.f};
        if (wave < 4) {
            const LAS unsigned char* X = (wave < 2) ? KKI : RTI; const LAS unsigned char* Y = (wave & 1) ? KDI : BTI;
            f32x4 acc = (f32x4){0.f, 0.f, 0.f, 0.f};
#pragma unroll
            for (int ks = 0; ks < 2; ++ks) { const bf16x8 a = *(const LAS bf16x8*)(X + fr * 144 + (ks * 32 + quad * 8) * 2), bb = *(const LAS bf16x8*)(Y + fr * 144 + (ks * 32 + quad * 8) * 2);
                acc = __builtin_amdgcn_mfma_f32_16x16x32_bf16(a, bb, acc, 0, 0, 0);
                if (wave == 0) accNT = __builtin_amdgcn_mfma_f32_16x16x32_bf16(bb, a, accNT, 0, 0, 0); }
            accN = acc;
#pragma unroll
            for (int j = 0; j < 4; ++j) { const int t = quad * 4 + j, i = fr;
                if (wave == 0) { }
                else if (wave == 1) *(LAS unsigned short*)(MMI + (t * 16 + i) * 2) = (unsigned short)f2bf((i < t) ? acc[j] : 0.f);
                else { const int slot = (i >> 2) * 8 + (i & 3) + (wave == 3 ? 4 : 0); *(LAS unsigned short*)(AOI + (t * 32 + slot) * 2) = (unsigned short)f2bf((i <= t) ? acc[j] : 0.f); } }
        }
        if (wave == 0) {
            f32x4 nv, nT;
#pragma unroll
            for (int j = 0; j < 4; ++j) { nv[j] = (fr < quad * 4 + j) ? accN[j] : 0.f;
                                          nT[j] = (quad * 4 + j < fr) ? accNT[j] : 0.f; }
#pragma unroll
            for (int lv = 0; lv < 4; ++lv) {
                const unsigned n01 = cvtpk(nv[0], nv[1]), n23 = cvtpk(nv[2], nv[3]), t01 = cvtpk(nT[0], nT[1]), t23 = cvtpk(nT[2], nT[3]);
                const u32x2 rowv = {t01, t23};
                *(LAS u32x2*)(NI + lv * 1024 + (fr * 16 + quad * 4) * 2) = rowv;
                if (lv < 3) {
                    const f32x4 zf = {0.f, 0.f, 0.f, 0.f};
                    const bf16x8 opN = mk_op(n01, n23, 0u, 0u), opT = mk_op(t01, t23, 0u, 0u);
                    nv = __builtin_amdgcn_mfma_f32_16x16x32_bf16(opT, opN, zf, 0, 0, 0);
                    nT = __builtin_amdgcn_mfma_f32_16x16x32_bf16(opN, opT, zf, 0, 0, 0);
                }
            }
        }
    }
    LDS_BAR();
#pragma unroll 1
    for (int c = 0; c < NCH; ++c) {
        if (c + 3 < NCH) CK_COMMIT(c + 3);
        if (c + 4 < NCH) CK_ISSUE(c + 4);
        if (c > 0) CK_WRITEOUT(c - 1);
        if (wave >= 4) { if (c + 2 < NCH) { CK_P1A(c + 2); CK_P1B(c + 2); } }
        {
            LAS unsigned char* im = IMG0 + (c % 3) * IMGB;
            LAS unsigned char* KKI = im; LAS unsigned char* RTI = im + 6912; LAS unsigned char* AUP = im + 9216;
            LAS float* GC = (LAS float*)(im + 14336); LAS unsigned char* VTI = im + 14592;
            LAS unsigned char* NI = SM0 + (c & 1) * 5632; LAS unsigned char* MMI = NI + 4096; LAS unsigned char* AOI = MMI + 512;
        if (wave < 4) {
            const int vrow = wave * 16 + fr;
            bf16x8 Sb[2], KKa[2], RTa[2];
#pragma unroll
            for (int p2 = 0; p2 < 2; ++p2) {
                Sb[p2] = mk_op(cvtpk(St[2 * p2][0], St[2 * p2][1]), cvtpk(St[2 * p2][2], St[2 * p2][3]), cvtpk(St[2 * p2 + 1][0], St[2 * p2 + 1][1]), cvtpk(St[2 * p2 + 1][2], St[2 * p2 + 1][3]));
                const u32x2 a0 = *(const LAS u32x2*)(KKI + fr * 144 + ((2 * p2) * 16 + quad * 4) * 2), a1 = *(const LAS u32x2*)(KKI + fr * 144 + ((2 * p2 + 1) * 16 + quad * 4) * 2);
                KKa[p2] = mk_op(a0.x, a0.y, a1.x, a1.y);
                const u32x2 r0 = *(const LAS u32x2*)(RTI + fr * 144 + ((2 * p2) * 16 + quad * 4) * 2), r1 = *(const LAS u32x2*)(RTI + fr * 144 + ((2 * p2 + 1) * 16 + quad * 4) * 2);
                RTa[p2] = mk_op(r0.x, r0.y, r1.x, r1.y);
            }
            const f32x4 zf = {0.f, 0.f, 0.f, 0.f};
            f32x4 rhs = __builtin_amdgcn_mfma_f32_16x16x32_bf16(KKa[0], Sb[0], zf, 0, 0, 0); rhs = __builtin_amdgcn_mfma_f32_16x16x32_bf16(KKa[1], Sb[1], rhs, 0, 0, 0);
            const u32x2 vt = *(const LAS u32x2*)(VTI + vrow * 32 + quad * 8), mm = *(const LAS u32x2*)(MMI + fr * 32 + quad * 8);
            rhs = __builtin_amdgcn_mfma_f32_16x16x32_bf16(mk_op(mm.x, mm.y, 0u, 0u), mk_op(vt.x, vt.y, 0u, 0u), rhs, 0, 0, 0);
            f32x4 ut = rhs;
#pragma unroll
            for (int lv = 3; lv >= 0; --lv) { const u32x2 na = *(const LAS u32x2*)(NI + lv * 1024 + (fr * 16 + quad * 4) * 2);
                ut = __builtin_amdgcn_mfma_f32_16x16x32_bf16(mk_op(na.x, na.y, 0u, 0u), mk_op(cvtpk(ut[0], ut[1]), cvtpk(ut[2], ut[3]), 0u, 0u), ut, 0, 0, 0); }
            const bf16x8 UVb = mk_op(cvtpk(ut[0], ut[1]), cvtpk(ut[2], ut[3]), vt.x, vt.y);
            f32x4 ot = __builtin_amdgcn_mfma_f32_16x16x32_bf16(RTa[0], Sb[0], zf, 0, 0, 0); ot = __builtin_amdgcn_mfma_f32_16x16x32_bf16(RTa[1], Sb[1], ot, 0, 0, 0);
            ot = __builtin_amdgcn_mfma_f32_16x16x32_bf16(*(const LAS bf16x8*)(AOI + fr * 64 + quad * 16), UVb, ot, 0, 0, 0);
#pragma unroll
            for (int j = 0; j < 4; ++j) *(LAS hf*)(OBI + (c & 1) * 2048 + ((quad * 4 + j) * 64 + vrow) * 2) = (hf)ot[j];
#pragma unroll
            for (int kt = 0; kt < 4; ++kt) { const f32x4 gc = *(const LAS f32x4*)(GC + kt * 16 + quad * 4);
                St[kt] = __builtin_amdgcn_mfma_f32_16x16x32_bf16(*(const LAS bf16x8*)(AUP + (kt * 16 + fr) * 80 + quad * 16), UVb, St[kt] * gc, 0, 0, 0); }
        }
        }
        if (c + 1 < NCH) {
            LAS unsigned char* im = IMG0 + ((c + 1) % 3) * IMGB;
            LAS unsigned char* KKI = im; LAS unsigned char* BTI = im + 2304; LAS unsigned char* KDI = im + 4608; LAS unsigned char* RTI = im + 6912;
            LAS unsigned char* NI = SM0 + ((c + 1) & 1) * 5632; LAS unsigned char* MMI = NI + 4096; LAS unsigned char* AOI = MMI + 512;
            (void)NI; (void)MMI; (void)AOI;
        f32x4 accN = (f32x4){0.f, 0.f, 0.f, 0.f}, accNT = (f32x4){0.f, 0.f, 0.f, 0.f};
        if (wave < 4) {
            const LAS unsigned char* X = (wave < 2) ? KKI : RTI; const LAS unsigned char* Y = (wave & 1) ? KDI : BTI;
            f32x4 acc = (f32x4){0.f, 0.f, 0.f, 0.f};
#pragma unroll
            for (int ks = 0; ks < 2; ++ks) { const bf16x8 a = *(const LAS bf16x8*)(X + fr * 144 + (ks * 32 + quad * 8) * 2), bb = *(const LAS bf16x8*)(Y + fr * 144 + (ks * 32 + quad * 8) * 2);
                acc = __builtin_amdgcn_mfma_f32_16x16x32_bf16(a, bb, acc, 0, 0, 0);
                if (wave == 0) accNT = __builtin_amdgcn_mfma_f32_16x16x32_bf16(bb, a, accNT, 0, 0, 0); }
            accN = acc;
#pragma unroll
            for (int j = 0; j < 4; ++j) { const int t = quad * 4 + j, i = fr;
                if (wave == 0) { }
                else if (wave == 1) *(LAS unsigned short*)(MMI + (t * 16 + i) * 2) = (unsigned short)f2bf((i < t) ? acc[j] : 0.f);
                else { const int slot = (i >> 2) * 8 + (i & 3) + (wave == 3 ? 4 : 0); *(LAS unsigned short*)(AOI + (t * 32 + slot) * 2) = (unsigned short)f2bf((i <= t) ? acc[j] : 0.f); } }
        }
        if (wave == 0) {
            f32x4 nv, nT;
#pragma unroll
            for (int j = 0; j < 4; ++j) { nv[j] = (fr < quad * 4 + j) ? accN[j] : 0.f;
                                          nT[j] = (quad * 4 + j < fr) ? accNT[j] : 0.f; }
#pragma unroll
            for (int lv = 0; lv < 4; ++lv) {
                const unsigned n01 = cvtpk(nv[0], nv[1]), n23 = cvtpk(nv[2], nv[3]), t01 = cvtpk(nT[0], nT[1]), t23 = cvtpk(nT[2], nT[3]);
                const u32x2 rowv = {t01, t23};
                *(LAS u32x2*)(NI + lv * 1024 + (fr * 16 + quad * 4) * 2) = rowv;
                if (lv < 3) {
                    const f32x4 zf = {0.f, 0.f, 0.f, 0.f};
                    const bf16x8 opN = mk_op(n01, n23, 0u, 0u), opT = mk_op(t01, t23, 0u, 0u);
                    nv = __builtin_amdgcn_mfma_f32_16x16x32_bf16(opT, opN, zf, 0, 0, 0);
                    nT = __builtin_amdgcn_mfma_f32_16x16x32_bf16(opN, opT, zf, 0, 0, 0);
                }
            }
        }
        }
        LDS_BAR();
    }
    CK_WRITEOUT(NCH - 1);
#undef CK_ISSUE
#undef CK_COMMIT
#undef CK_WRITEOUT
#undef CK_P1A
#undef CK_P1B
}
__device__ __forceinline__ void gla_chunk_item(unsigned char* ldsg, kparams_t p, int chain, int tid) {
    LAS unsigned char* lds = (LAS unsigned char*)ldsg;
    constexpr int INB = 16 * 320, NCH = (SEQ + CTXL) / 16, IMGB = 6400;
    LAS unsigned char* IMG0 = lds + 3 * INB;
    LAS unsigned char* QKI = IMG0 + 2 * IMGB;
    LAS unsigned char* OBI = QKI + 512;
    const int b = chain >> 3, h = (chain >> 1) & 3, dir = chain & 1;
    const int lane = tid & 63, wave = __builtin_amdgcn_readfirstlane(tid >> 6), fr = lane & 15, quad = lane >> 4;
    const hf* PG = (const hf*)(p->ws + WS_PG); const bf16_t* P1 = (const bf16_t*)(p->ws + WS_P1); hf* OG = (hf*)(p->ws + WS_OG) + (size_t)dir * MT * 256;
    const int pp_ = tid < 320 ? tid : 0, st_ = pp_ / 20, q_ = pp_ % 20;
    const size_t crow_ = (size_t)(ML + b * 256 + (dir ? 255 - st_ : st_)), lrow_ = (size_t)(b * 4096 + (dir ? 4095 - st_ : st_));
    const int ar_ = q_ >> 2, sog_ = (ar_ == 0 ? h * 32 : ar_ == 1 ? 128 + h * 32 : 256 + dir * 128 + h * 32) + (q_ & 3) * 8;
    const unsigned char* cur_ = q_ < 12 ? (const unsigned char*)(PG + crow_ * PGC + sog_) : (const unsigned char*)(P1 + crow_ * P1C + 256 + h * 64 + (q_ - 12) * 8);
    const unsigned char* lat_ = q_ < 12 ? (const unsigned char*)(PG + lrow_ * PGC + sog_) : (const unsigned char*)(P1 + lrow_ * P1C + 256 + h * 64 + (q_ - 12) * 8);
    const ptrdiff_t stepB_ = (ptrdiff_t)(dir ? -16 : 16) * (q_ < 12 ? PGC * 2 : P1C * 2);
    const int lo_ = st_ * 320 + q_ * 16;
    int icc_ = 0, cbuf_ = 0, wcc_ = 0;
    const int wst_ = (tid & 127) >> 3, wpc_ = tid & 7;
    hf* wcur_ = OG + (size_t)(ML + b * 256 + (dir ? 255 - wst_ : wst_)) * 256 + h * 64 + wpc_ * 8;
    hf* wlat_ = OG + (size_t)(b * 4096 + (dir ? 4095 - wst_ : wst_)) * 256 + h * 64 + wpc_ * 8;
    const ptrdiff_t wstep_ = (ptrdiff_t)(dir ? -16 : 16) * 256;
    u32x4 pre;
#define GK_ISSUE() do { if (icc_ == 16) cur_ = lat_; pre = *(const u32x4*)cur_; cur_ += stepB_; ++icc_; } while (0)
#define GK_COMMIT() do { if (tid < 320) *(LAS u32x4*)(lds + cbuf_ + lo_) = pre; cbuf_ = (cbuf_ == 2 * INB) ? 0 : cbuf_ + INB; } while (0)
#define GK_WRITEOUT(cc) do { if (wcc_ == 16) wcur_ = wlat_; if (tid < 128) *(u32x4*)wcur_ = *(const LAS u32x4*)(OBI + ((cc) & 1) * 2048 + wst_ * 128 + wpc_ * 16); wcur_ += wstep_; ++wcc_; } while (0)
#define GK_P1(cc) do { const LAS unsigned char* in_ = lds + ((cc) % 3) * INB; LAS unsigned char* im_ = IMG0 + ((cc) & 1) * IMGB; \
        const int k_ = lane & 31, go_ = (wave - 4) * 2 + (lane >> 5), t0_ = go_ * 2; \
        float e_[16]; _Pragma("unroll") for (int i_ = 0; i_ < 16; ++i_) e_[i_] = (float)*(const LAS hf*)(in_ + i_ * 320 + 128 + k_ * 2); \
        float pfx_ = 1.f, sfx_ = 1.f; _Pragma("unroll") for (int g_ = 0; g_ < 8; ++g_) { const float H_ = e_[2 * g_] * e_[2 * g_ + 1]; pfx_ *= (g_ < go_) ? H_ : 1.f; sfx_ *= (g_ > go_) ? H_ : 1.f; } \
        const float ea_ = (float)*(const LAS hf*)(in_ + t0_ * 320 + 128 + k_ * 2), eb_ = (float)*(const LAS hf*)(in_ + (t0_ + 1) * 320 + 128 + k_ * 2); \
        const float ga_ = pfx_ * ea_, gb_ = ga_ * eb_, gC_ = gb_ * sfx_; \
        if (go_ == 0) *(LAS float*)(im_ + 3584 + k_ * 4) = gC_; \
        _Pragma("unroll") for (int e2_ = 0; e2_ < 2; ++e2_) { const int t_ = t0_ + e2_; const float gt_ = e2_ == 0 ? ga_ : gb_; const float inv_ = __builtin_amdgcn_rcpf(gt_); \
            const float qv_ = (float)*(const LAS hf*)(in_ + t_ * 320 + k_ * 2), kv_ = (float)*(const LAS hf*)(in_ + t_ * 320 + 64 + k_ * 2); \
            const unsigned pa_ = cvtpk(qv_ * gt_, kv_ * inv_), pb_ = cvtpk(kv_ * inv_ * gC_, 0.f); \
            *(LAS unsigned short*)(im_ + t_ * 80 + k_ * 2) = (unsigned short)(pa_ & 0xffffu); *(LAS unsigned short*)(im_ + 1280 + t_ * 80 + k_ * 2) = (unsigned short)(pa_ >> 16); \
            *(LAS unsigned short*)(im_ + 2560 + k_ * 32 + t_ * 2) = (unsigned short)(pb_ & 0xffffu); \
              \
            *(LAS unsigned short*)(im_ + 3712 + k_ * 32 + t_ * 2) = *(const LAS unsigned short*)(in_ + t_ * 320 + 192 + k_ * 2); \
            *(LAS unsigned short*)(im_ + 3712 + (k_ + 32) * 32 + t_ * 2) = *(const LAS unsigned short*)(in_ + t_ * 320 + 192 + (k_ + 32) * 2); } } while (0)
    f32x4 St[2];
    St[0] = (f32x4){0.f, 0.f, 0.f, 0.f}; St[1] = St[0];
    GK_ISSUE(); GK_COMMIT(); GK_ISSUE(); GK_COMMIT(); GK_ISSUE();
    __syncthreads();
    if (wave >= 4) GK_P1(0);
    LDS_BAR();
#pragma unroll 1
    for (int c = 0; c < NCH; ++c) {
        LAS unsigned char* im = IMG0 + (c & 1) * IMGB;
        const LAS unsigned char* QI = im; const LAS unsigned char* KI = im + 1280; const LAS unsigned char* AUPG = im + 2560; const LAS float* GC = (const LAS float*)(im + 3584); const LAS unsigned char* VTI = im + 3712;
        if (c + 2 < NCH) GK_COMMIT();
        if (c + 3 < NCH) GK_ISSUE();
        if (c > 0) GK_WRITEOUT(c - 1);
        if (wave >= 4) { if (c + 1 < NCH) GK_P1(c + 1); }
        if (wave == 0) {
            const bf16x8 a = *(const LAS bf16x8*)(QI + fr * 80 + quad * 16), bb = *(const LAS bf16x8*)(KI + fr * 80 + quad * 16);
            const f32x4 zf = {0.f, 0.f, 0.f, 0.f};
            const f32x4 acc = __builtin_amdgcn_mfma_f32_16x16x32_bf16(a, bb, zf, 0, 0, 0);
            const unsigned p01 = cvtpk((fr <= quad * 4 + 0) ? acc[0] : 0.f, (fr <= quad * 4 + 1) ? acc[1] : 0.f), p23 = cvtpk((fr <= quad * 4 + 2) ? acc[2] : 0.f, (fr <= quad * 4 + 3) ? acc[3] : 0.f);
            *(LAS unsigned short*)(QKI + ((quad * 4 + 0) * 16 + fr) * 2) = (unsigned short)(p01 & 0xffffu); *(LAS unsigned short*)(QKI + ((quad * 4 + 1) * 16 + fr) * 2) = (unsigned short)(p01 >> 16);
            *(LAS unsigned short*)(QKI + ((quad * 4 + 2) * 16 + fr) * 2) = (unsigned short)(p23 & 0xffffu); *(LAS unsigned short*)(QKI + ((quad * 4 + 3) * 16 + fr) * 2) = (unsigned short)(p23 >> 16);
        }
        LDS_BAR();
        if (wave < 4) {
            const int vrow = wave * 16 + fr;
            const bf16x8 Sb = mk_op(cvtpk(St[0][0], St[0][1]), cvtpk(St[0][2], St[0][3]), cvtpk(St[1][0], St[1][1]), cvtpk(St[1][2], St[1][3]));
            const u32x2 q0 = *(const LAS u32x2*)(QI + fr * 80 + (quad * 4) * 2), q1 = *(const LAS u32x2*)(QI + fr * 80 + (16 + quad * 4) * 2);
            const u32x2 vt = *(const LAS u32x2*)(VTI + vrow * 32 + quad * 8), qk = *(const LAS u32x2*)(QKI + fr * 32 + quad * 8);
            const bf16x8 Vb = mk_op(vt.x, vt.y, 0u, 0u);
            const f32x4 zf = {0.f, 0.f, 0.f, 0.f};
            f32x4 ot = __builtin_amdgcn_mfma_f32_16x16x32_bf16(mk_op(q0.x, q0.y, q1.x, q1.y), Sb, zf, 0, 0, 0);
            ot = __builtin_amdgcn_mfma_f32_16x16x32_bf16(mk_op(qk.x, qk.y, 0u, 0u), Vb, ot, 0, 0, 0);
#pragma unroll
            for (int j = 0; j < 4; ++j) *(LAS hf*)(OBI + (c & 1) * 2048 + ((quad * 4 + j) * 64 + vrow) * 2) = (hf)ot[j];
#pragma unroll
            for (int kt = 0; kt < 2; ++kt) { const f32x4 gc = *(const LAS f32x4*)(GC + kt * 16 + quad * 4); const u32x2 au = *(const LAS u32x2*)(AUPG + (kt * 16 + fr) * 32 + quad * 8);
                St[kt] = __builtin_amdgcn_mfma_f32_16x16x32_bf16(mk_op(au.x, au.y, 0u, 0u), Vb, St[kt] * gc, 0, 0, 0); }
        }
        LDS_BAR();
    }
    GK_WRITEOUT(NCH - 1);
#undef GK_ISSUE
#undef GK_COMMIT
#undef GK_WRITEOUT
#undef GK_P1
}
__device__ __forceinline__ void swa_item(unsigned char* ldsg, kparams_t p, int l, int item, int tid) {
    LAS unsigned char* lds = (LAS unsigned char*)ldsg;
    const int lane = tid & 63, wave = tid >> 6, fr = lane & 15, quad = lane >> 4;
    const bf16_t* P1 = (const bf16_t*)(p->ws + WS_P1); bf16_t* MIX = (bf16_t*)(p->ws + WS_XN);
    const bool lat = item < 512;
    int b, n, kvh;
    if (lat) { b = item >> 6; n = (item >> 1) & 31; kvh = item & 1; } else { const int r = item - 512; b = r >> 2; n = (r >> 1) & 1; kvh = r & 1; }
    const int qrow = (lat ? b * 4096 : ML + b * 256) + n * 128 + wave * 16 + fr;
    const int qpos = n * 128 + wave * 16 + fr;
#pragma unroll 1
    for (int hp = 0; hp < 2; ++hp) {
    const int hbase = kvh * 4 + hp * 2;
    bf16x8 qf[2][2];
#pragma unroll
    for (int g = 0; g < 2; ++g)
#pragma unroll
        for (int ks = 0; ks < 2; ++ks) qf[g][ks] = *(const bf16x8*)(P1 + (size_t)qrow * P1C + 800 + (hbase + g) * 64 + ks * 32 + quad * 8);
    f32x4 oacc[2][4]; float mrun[2], lrun[2];
#pragma unroll
    for (int g = 0; g < 2; ++g) { mrun[g] = -1e30f; lrun[g] = 0.f;
#pragma unroll
        for (int dt = 0; dt < 4; ++dt) oacc[g][dt] = (f32x4){0.f, 0.f, 0.f, 0.f}; }
    const int jlo = lat ? (n == 0 ? 2 : 0) : 0, jhi = lat ? (n == 31 ? 4 : 6) : 0, T = 4 + (jhi - jlo);
    const int key_ = tid >> 3, ch_ = tid & 7;
#define SWA_SRC(t) (P1 + (size_t)(((t) < 4 ? ML + b * 256 + (t) * 64 : b * 4096 + (n - 1) * 128 + (jlo + (t) - 4) * 64) + key_) * P1C + 1312 + kvh * 64 + ch_ * 8)
#define SWA_STORE(bf) do { LAS unsigned char* Ks_ = lds + (bf) * 18432; LAS unsigned char* Vt_ = Ks_ + 9216; *(LAS u32x4*)(Ks_ + key_ * 144 + ch_ * 16) = pk_; \
        _Pragma("unroll") for (int e = 0; e < 4; ++e) { *(LAS unsigned short*)(Vt_ + (ch_ * 8 + 2 * e) * 144 + key_ * 2) = (unsigned short)(pv_[e] & 0xffffu); *(LAS unsigned short*)(Vt_ + (ch_ * 8 + 2 * e + 1) * 144 + key_ * 2) = (unsigned short)(pv_[e] >> 16); } } while (0)
    u32x4 pk_, pv_;
    { const bf16_t* src = SWA_SRC(0); pk_ = *(const u32x4*)src; pv_ = *(const u32x4*)(src + 128); }
    SWA_STORE(0);
    __syncthreads();
    for (int tile = 0; tile < T; ++tile) {
        if (tile + 1 < T) { const bf16_t* src = SWA_SRC(tile + 1); pk_ = *(const u32x4*)src; pv_ = *(const u32x4*)(src + 128); }
        const bool local = tile >= 4; const int kpos0 = local ? (n - 1) * 128 + (jlo + tile - 4) * 64 : 0;
        const LAS unsigned char* Ks = lds + (tile & 1) * 18432; const LAS unsigned char* Vt = Ks + 9216;
#pragma unroll
        for (int g = 0; g < 2; ++g) {
            asm volatile("" ::: "memory");
            bf16x8 kf[4][2], vf[4][2];
#pragma unroll
        for (int st = 0; st < 4; ++st)
#pragma unroll
            for (int ks = 0; ks < 2; ++ks) kf[st][ks] = *(const LAS bf16x8*)(Ks + (st * 16 + fr) * 144 + ks * 64 + quad * 16);
#pragma unroll
        for (int dt = 0; dt < 4; ++dt)
#pragma unroll
            for (int kp = 0; kp < 2; ++kp) { const u32x2 lo = *(const LAS u32x2*)(Vt + (dt * 16 + fr) * 144 + ((2 * kp) * 16 + quad * 4) * 2), hi = *(const LAS u32x2*)(Vt + (dt * 16 + fr) * 144 + ((2 * kp + 1) * 16 + quad * 4) * 2);
                const u32x4 t = {lo.x, lo.y, hi.x, hi.y}; vf[dt][kp] = __builtin_bit_cast(bf16x8, t); }
            f32x4 s[4];
#pragma unroll
            for (int st = 0; st < 4; ++st) { f32x4 a = (f32x4){0.f, 0.f, 0.f, 0.f};
                a = __builtin_amdgcn_mfma_f32_16x16x32_bf16(kf[st][0], qf[g][0], a, 0, 0, 0); a = __builtin_amdgcn_mfma_f32_16x16x32_bf16(kf[st][1], qf[g][1], a, 0, 0, 0); s[st] = a * 0.125f; }
            if (local) {
#pragma unroll
                for (int st = 0; st < 4; ++st)
#pragma unroll
                    for (int j = 0; j < 4; ++j) { const int d = qpos - (kpos0 + st * 16 + quad * 4 + j); if (d > 128 || d < -128) s[st][j] = -1e30f; }
            }
            float mx = fmaxf(fmaxf(fmaxf(s[0][0], s[0][1]), fmaxf(s[0][2], s[0][3])), fmaxf(fmaxf(s[1][0], s[1][1]), fmaxf(s[1][2], s[1][3])));
            mx = fmaxf(mx, fmaxf(fmaxf(fmaxf(s[2][0], s[2][1]), fmaxf(s[2][2], s[2][3])), fmaxf(fmaxf(s[3][0], s[3][1]), fmaxf(s[3][2], s[3][3]))));
            mx = fmaxf(mx, __shfl_xor(mx, 16)); mx = fmaxf(mx, __shfl_xor(mx, 32));
            const float mn = fmaxf(mrun[g], mx), alpha = __expf(mrun[g] - mn); mrun[g] = mn;
            float ps = 0.f;
#pragma unroll
            for (int st = 0; st < 4; ++st)
#pragma unroll
                for (int j = 0; j < 4; ++j) { s[st][j] = __expf(s[st][j] - mn); ps += s[st][j]; }
            lrun[g] = lrun[g] * alpha + ps;
            bf16x8 pb[2];
#pragma unroll
            for (int kp = 0; kp < 2; ++kp) { const u32x4 t = {cvtpk(s[2 * kp][0], s[2 * kp][1]), cvtpk(s[2 * kp][2], s[2 * kp][3]), cvtpk(s[2 * kp + 1][0], s[2 * kp + 1][1]), cvtpk(s[2 * kp + 1][2], s[2 * kp + 1][3])}; pb[kp] = __builtin_bit_cast(bf16x8, t); }
#pragma unroll
            for (int dt = 0; dt < 4; ++dt) { f32x4 o = oacc[g][dt] * alpha;
                o = __builtin_amdgcn_mfma_f32_16x16x32_bf16(vf[dt][0], pb[0], o, 0, 0, 0); o = __builtin_amdgcn_mfma_f32_16x16x32_bf16(vf[dt][1], pb[1], o, 0, 0, 0); oacc[g][dt] = o; }
        }
        if (tile + 1 < T) SWA_STORE((tile + 1) & 1);
        __syncthreads();
    }
#undef SWA_SRC
#undef SWA_STORE
    const float* sink = p->in[13] + l * 8;
#pragma unroll
    for (int g = 0; g < 2; ++g) {
        float lsum = lrun[g]; lsum += __shfl_xor(lsum, 16); lsum += __shfl_xor(lsum, 32);
        lsum += __expf(sink[hbase + g] - mrun[g]);
        const float inv = 1.0f / lsum;
#pragma unroll
        for (int dt = 0; dt < 4; ++dt) { const f32x4 o = oacc[g][dt] * inv; u32x2 w; w.x = cvtpk(o[0], o[1]); w.y = cvtpk(o[2], o[3]);
            *(u32x2*)(MIX + (size_t)qrow * DM + 256 + (hbase + g) * 64 + dt * 16 + quad * 4) = w; }
    }
    }
}

__device__ __forceinline__ float group16_sum(float v) { return reduce16(v); }
__device__ __forceinline__ void phase_finalize(kparams_t p, int l, int nrows, int gw, int ngw, int lane) {
    const hf* OR = (const hf*)(p->ws + WS_OR); const hf* OG = (const hf*)(p->ws + WS_OG); const hf* PREP = (const hf*)(p->ws + WS_PREP); const hf* GG = (const hf*)(p->ws + WS_GG);
    const float* BONUS = (const float*)(p->ws + WS_BONUS); const bf16_t* P1 = (const bf16_t*)(p->ws + WS_P1); bf16_t* MIX = (bf16_t*)(p->ws + WS_XN);
    const float* ln_g = p->in[23] + l * 256; const float* ln_b = p->in[24] + l * 256; const float* gng = p->in[12] + l * 64;
    const int c = lane * 4, h = lane >> 4;
    const f32x4 lg4 = *(const f32x4*)(ln_g + c), lb4 = *(const f32x4*)(ln_b + c), gn4 = *(const f32x4*)(gng + (c & 63));
    h4 ra, rb, rv, rg, ga, gb; float rbon; u32x2 rgt;
#define FIN_LOAD(rw_) do { const size_t r_ = (size_t)(rw_); ra = *(const h4*)(OR + r_ * 256 + c); rb = *(const h4*)(OR + (size_t)MT * 256 + r_ * 256 + c); rbon = BONUS[r_ * 4 + h]; \
        rv = *(const h4*)(PREP + r_ * PRC + 512 + c); rg = *(const h4*)(GG + r_ * 256 + c); ga = *(const h4*)(OG + r_ * 256 + c); gb = *(const h4*)(OG + (size_t)MT * 256 + r_ * 256 + c); \
        rgt = *(const u32x2*)(P1 + r_ * P1C + 512 + c); } while (0)
    if (gw < nrows) FIN_LOAD(gw);
    for (int row = gw; row < nrows; row += ngw) {
        const h4 a = ra, bq = rb, v4 = rv, g4 = rg, a2 = ga, b2 = gb; const float bon = rbon; const u32x2 gt = rgt;
        if (row + ngw < nrows) FIN_LOAD(row + ngw);
        {
            float o[4]; float s = 0.f;
#pragma unroll
            for (int e = 0; e < 4; ++e) { o[e] = (float)a[e] + (float)bq[e]; s += o[e]; }
            const float mu = group16_sum(s) * (1.0f / 64.0f); float q = 0.f;
#pragma unroll
            for (int e = 0; e < 4; ++e) { o[e] -= mu; q += o[e] * o[e]; }
            const float rs = rsqrtf(group16_sum(q) * (1.0f / 64.0f) + 64e-5f);
            float y[4];
#pragma unroll
            for (int e = 0; e < 4; ++e) y[e] = (o[e] * rs * lg4[e] + lb4[e] + bon * (float)v4[e]) * (float)g4[e];
            u32x2 w; w.x = cvtpk(y[0], y[1]); w.y = cvtpk(y[2], y[3]);
            *(u32x2*)(MIX + (size_t)row * DM + 768 + c) = w;
        }
        {
            float o[4]; float q = 0.f;
#pragma unroll
            for (int e = 0; e < 4; ++e) { o[e] = (float)a2[e] + (float)b2[e]; q += o[e] * o[e]; }
            const float rs = rsqrtf(group16_sum(q) * (1.0f / 64.0f) + 1e-6f);
            const float gv[4] = {bflo(gt.x), bfhi(gt.x), bflo(gt.y), bfhi(gt.y)};
            float y[4];
#pragma unroll
            for (int e = 0; e < 4; ++e) y[e] = o[e] * rs * gn4[e] * gv[e] * sigmoidf_(gv[e]);
            u32x2 w; w.x = cvtpk(y[0], y[1]); w.y = cvtpk(y[2], y[3]);
            *(u32x2*)(MIX + (size_t)row * DM + c) = w;
        }
    }
#undef FIN_LOAD
}
__global__ void __launch_bounds__(NTHREADS, 2) hybrid_fwd(Params p_arg) {
    extern __shared__ __attribute__((aligned(16))) unsigned char lds[];
#ifndef EXP_REP
#define EXP_REP 1
#endif
#ifndef EXP_FLAG
#define EXP_FLAG(rep) 0
#endif
#ifndef MAXSTEP
#define MAXSTEP 1000
#endif
    constexpr int NSTEP = 1 + 9 * NLAYER + 1;
#ifdef PROBE
    unsigned long long tacc1 = 0, tacc2 = 0;
#endif
    { volatile LAS unsigned* st0 = (volatile LAS unsigned*)((LAS unsigned char*)lds + 147392); if (threadIdx.x < 2) st0[threadIdx.x] = 0u; __syncthreads();
      (void)xcd_barrier_post((unsigned*)(p_arg.ws + WS_CTL) + 1024, st0); }
    int rep = 0;
#pragma unroll 1
    for (int step = 0; step < NSTEP; ++step) {
#ifdef PROBE
        const unsigned long long t0_ = __builtin_amdgcn_s_memrealtime();
#endif
        kparams_t kp = (kparams_t)__builtin_amdgcn_kernarg_segment_ptr();
        asm volatile("" : "+s"(kp));
        kparams_t p = kp;
        int tid = threadIdx.x, bid = blockIdx.x, G = gridDim.x;
        asm volatile("" : "+v"(tid)); asm volatile("" : "+s"(bid)); asm volatile("" : "+s"(G));
        const int lane = tid & 63, wave = __builtin_amdgcn_readfirstlane(tid >> 6);
        const int gw = bid * NWAVES + wave, ngw = G * NWAVES;
        unsigned char* ws = p->ws;
        bf16_t* XN = (bf16_t*)(ws + WS_XN); float* XC = (float*)(ws + WS_XC); float* XL = p->out;
        if (step == 0) { phase_mod(lds, p, tid, bid, G); }
        else if (step == NSTEP - 1) { final_norm_rows(XL, p->in[28], gw, ngw, lane);
#ifdef PROBE
            cg::this_grid().sync();
            if (bid == 0) { const float v1 = (float)tacc1 * 0.01f; if (tid == 0) XL[0] = v1; }
            if (bid == PROBE_B2) { const float v2 = (float)tacc2 * 0.01f; for (int i = tid; i < (1 << 20); i += NTHREADS) XL[1024 + i] = v2; }
#endif
            break; }
        else {
            const int l = (step - 1) / 9, ph = (step - 1) % 9;

            const bool lastl = (l == NLAYER - 1);
            const int mrows = lastl ? ML : MT;
            const float* modl = (const float*)(ws + WS_MOD) + (size_t)l * 9 * 6144;
            const float* resL = l == 0 ? p->in[0] : XL; const float* resC = l == 0 ? p->in[2] : XC;
            if (ph == 0) {
                convert_weights(lds, p, l, gw, ngw, wave, lane);
                norm_mod_rows(resL, resC, p->in[6] + l * DM, modl, 0, 1024, XN, MT, gw, ngw, lane);
            } else if (ph == 1) {
                pg8::Gemm g{XN, (const bf16_t*)(ws + WS_WT + WT_IN), MT, INP, DM}; pg8::StaticOrder S; S.init(MT, INP, G, bid);
                pg8::EpiIn E{(bf16_t*)(ws + WS_P1), (bf16_t*)(ws + WS_RAW)};
                pg8::gemm_phase<pg8::EpiIn, pg8::StaticOrder, true, true>((PG8_LAS unsigned char*)lds, g, S, E, tid);
            } else if (ph == 5) {
                pg8::Gemm g{XN, (const bf16_t*)(ws + WS_WT + WT_OUT), mrows, DM, DM}; pg8::StaticOrder S; S.init(mrows, DM, G, bid);
                pg8::EpiRes E{resL, XL, resC, XC, modl + 2048};
                pg8::gemm_phase<pg8::EpiRes, pg8::StaticOrder, true, true>((PG8_LAS unsigned char*)lds, g, S, E, tid);
            } else if (ph == 7) {
                pg8::Gemm g{XN, (const bf16_t*)(ws + WS_WT + WT_GU), mrows, 2 * FF, DM}; pg8::StaticOrder S; S.init(mrows, 2 * FF, G, bid);
                pg8::EpiSwiglu E{(bf16_t*)(ws + WS_H)};
                pg8::gemm_phase<pg8::EpiSwiglu, pg8::StaticOrder, true, true>((PG8_LAS unsigned char*)lds, g, S, E, tid);
            } else if (ph == 8) {
                pg8::Gemm g{(const bf16_t*)(ws + WS_H), (const bf16_t*)(ws + WS_WT + WT_DN), mrows, DM, FF}; pg8::StaticOrder S; S.init(mrows, DM, G, bid);
                pg8::EpiRes E{XL, XL, XC, XC, modl + 5120};
                pg8::gemm_phase<pg8::EpiRes, pg8::StaticOrder, true, true>((PG8_LAS unsigned char*)lds, g, S, E, tid);
            } else if (ph == 2) {
                phase_prep(lds, p, l, tid, bid, G, rep == 0);
            } else if (ph == 3) {
#ifdef PROBE_SCAN
                const unsigned long long ts_ = __builtin_amdgcn_s_memrealtime();
#endif
#ifdef REP_NO_SCAN
                if (rep == 0)
#endif
#ifdef RWKV_SCAN
                for (int it = bid; it < 192; it += G) {
#ifdef REP_ONLY_RWKV
                    if (rep == EXP_REP && it >= 128) continue;
#endif
#ifdef REP_ONLY_GLA
                    if (rep == EXP_REP && it < 128) continue;
#endif
                    if (it < 128) rwkv_scan_item(lds, p, it, tid, EXP_FLAG(rep)); else gla_scan_item(lds, p, (it - 128) * 2, tid); __syncthreads(); }
#else
                for (int it = bid; it < 128; it += G) {
#ifdef REP_ONLY_RWKV
                    if (rep == EXP_REP && it >= 64) continue;
#endif
#ifdef REP_ONLY_GLA
                    if (rep == EXP_REP && it < 64) continue;
#endif
                    if (it < 64) rwkv_chunk_item(lds, p, it, tid, EXP_FLAG(rep)); else gla_chunk_item(lds, p, it - 64, tid); __syncthreads(); }
#endif
#ifdef PROBE_SCAN
                { const unsigned long long d_ = __builtin_amdgcn_s_memrealtime() - ts_; tacc1 += d_; tacc2 += d_; }
#endif
#ifdef REP_NO_SWA
                const int nswa = rep == EXP_REP ? 0 : (lastl ? 512 : 544);
#else
                const int nswa = lastl ? 512 : 544;
#endif
                unsigned* ctl = (unsigned*)(ws + WS_CTL);
                LAS int* qslot = (LAS int*)((LAS unsigned char*)lds + 147328);
                for (;;) {
                    __syncthreads();
                    if (tid == 0) *qslot = (int)atomicAdd(ctl + 64 * l + 32 * rep, 1u);
                    __syncthreads();
                    const int it = *qslot;
                    if (it >= nswa) break;
                    swa_item(lds, p, l, it, tid);
                }
            } else if (ph == 4) {
                phase_finalize(p, l, mrows, gw, ngw, lane);
            } else {
                norm_mod_rows(XL, XC, p->in[7] + l * DM, modl, 3072, 4096, XN, mrows, gw, ngw, lane);
            }
        }
        if (step == 0) cg::this_grid().sync();
        else { XcdBarrier xb_; xb_.bar = (unsigned*)(p->ws + WS_CTL) + 1024; xb_.x = xb_xcc_id(); xb_.st = (volatile LAS unsigned*)((LAS unsigned char*)lds + 147392); xcd_barrier(xb_); }
#ifdef PROBE
        { const unsigned long long dt_ = __builtin_amdgcn_s_memrealtime() - t0_; const int ph_ = step == 0 ? 9 : (step - 1) % 9;
          if (PROBE_C1(ph_)) tacc1 += dt_; if (PROBE_C2(ph_)) tacc2 += dt_; }
#endif
#ifdef DOUBLE_MASK
#ifdef DOUBLE_STEP0
        if (step == 0 && rep == 0) { rep = 1; --step; } else
#endif
#ifdef DOUBLE_D0
        if (step == 6 && rep == 0) { rep = 1; --step; } else
#endif
        if (step >= 1 && rep == 0 && ((DOUBLE_MASK >> ((step - 1) % 9)) & 1)) { rep = 1; --step; } else rep = 0;
#endif
        if (step + 1 >= MAXSTEP) break;
    }
}

extern "C" void kernel_launch(void* const* d_in, const int* in_sizes, int n_in, void* d_out, int out_size, void* d_ws, size_t ws_size, hipStream_t stream) {
    static int grid_blocks = 0;
    if (grid_blocks == 0) {
        if (n_in != 29 || out_size != ML * DM || ws_size < WS_END) { fprintf(stderr, "kernel_launch: unexpected shapes (n_in %d out %d ws %zu)\n", n_in, out_size, ws_size); grid_blocks = -1; return; }
        int dev = 0, cus = 0, per_cu = 0;
        (void)hipGetDevice(&dev);
        (void)hipDeviceGetAttribute(&cus, hipDeviceAttributeMultiprocessorCount, dev);
        (void)hipFuncSetAttribute((const void*)hybrid_fwd, hipFuncAttributeMaxDynamicSharedMemorySize, LDS_BYTES);
        (void)hipOccupancyMaxActiveBlocksPerMultiprocessor(&per_cu, (const void*)hybrid_fwd, NTHREADS, LDS_BYTES);
        if (per_cu < 1) per_cu = 1;
        grid_blocks = cus * per_cu;
        (void)hipGetLastError();
    }
    if (grid_blocks < 0) return;
    (void)hipMemsetAsync((char*)d_ws + WS_CTL, 0, 65536, stream);
    Params p{};
    for (int i = 0; i < 29; ++i) p.in[i] = (const float*)d_in[i];
    p.out = (float*)d_out; p.ws = (unsigned char*)d_ws;
    void* args[] = {&p};
    hipError_t e = hipLaunchCooperativeKernel((const void*)hybrid_fwd, dim3(grid_blocks), dim3(NTHREADS), args, LDS_BYTES, stream);
    if (e != hipSuccess) fprintf(stderr, "cooperative launch failed: %s (grid %d)\n", hipGetErrorString(e), grid_blocks);
}
```

```cpp
#include <hip/hip_runtime.h>
#include <hip/hip_cooperative_groups.h>
#include <cstdio>
#include <cstdint>
namespace cg = cooperative_groups;
namespace pg8 {
#define PG8_LAS __attribute__((address_space(3)))
typedef unsigned short bf16_t;
typedef short bf16x8 __attribute__((ext_vector_type(8)));
typedef float f32x4 __attribute__((ext_vector_type(4)));
typedef unsigned u32x4 __attribute__((ext_vector_type(4)));
constexpr int BM = 256, BK = 64, HALF = 128, HTB = HALF * BK * 2  , STAGE_BYTES = 8 * HTB, NXCD = 8, WGM = 8;

__host__ __device__ __forceinline__ int lds_byte(int r, int c) { const int st = (r >> 4) * 2 + (c >> 5), rr = r & 15, cc = c & 31, ob = rr * 64 + cc * 2; return st * 1024 + (ob ^ (((ob >> 9) & 1) << 5)); }
__host__ __device__ __forceinline__ void stage_rc(int b, int& R, int& C) { const int st = b / 1024, sb = b % 1024, swz = sb ^ (((sb >> 9) & 1) << 5); R = (st >> 1) * 16 + swz / 64; C = (st & 1) * 32 + (swz % 64) / 2; }
__host__ __device__ __forceinline__ int perm32(int rho) { const int n = rho >> 4, i = rho & 15; return 8 * (i >> 2) + 4 * n + (i & 3); }

struct Unit { int pm, pn; };
struct Gemm { const bf16_t* A; const bf16_t* Bt; int M, N, K; };

struct StaticOrder {
    int nM, nN, nwg, G, c;
    __host__ __device__ void init(int M, int N, int G_, int c_) { nM = M / BM; nN = N / BM; nwg = nM * nN; G = G_; c = c_; }
    __host__ __device__ bool next(int i, Unit& u) const {
        const long L = (long)i * G + c; if (L >= nwg) return false;
        int wgid = (int)L; { const int q = nwg / NXCD, r = nwg % NXCD, xcd = wgid % NXCD, off = wgid / NXCD; wgid = (xcd < r ? xcd * (q + 1) : r * (q + 1) + (xcd - r) * q) + off; }
        const int nig = WGM * nN, gid = wgid / nig, fm = gid * WGM, gsz = (nM - fm) < WGM ? (nM - fm) : WGM;
        u.pm = fm + ((wgid % nig) % gsz); u.pn = (wgid % nig) / gsz; return true;
    }
    __device__ __forceinline__ void a_ready(const Unit&) const {}
    __device__ __forceinline__ void done(const Unit&) const {}
};

__device__ __forceinline__ unsigned cvt_pk_bf16(float lo, float hi) { unsigned r; asm volatile("v_cvt_pk_bf16_f32 %0, %1, %2" : "=v"(r) : "v"(lo), "v"(hi)); return r; }
typedef float f32x2 __attribute__((ext_vector_type(2)));
constexpr int EP_ML = 32768;
struct EpiIn {
    static constexpr bool PERM = true, AFTER_DRAIN = false;
    bf16_t* O0; bf16_t* O1;
    __device__ __forceinline__ void operator()(const f32x4 (&acc)[2][2][4][2], const Unit& u, int wr, int wc, int fr, int fq) const {
        const int row0 = u.pm * BM + wr * 64 + fr;
#pragma unroll
        for (int bj = 0; bj < 2; ++bj) {
            const int c0 = u.pn * BM + bj * HALF + wc * 32 + 8 * fq;
            bf16_t* base; size_t ld; int cc; bool ok = true;
            if (c0 < 1568) { base = O0; ld = 1568; cc = c0; } else if (c0 < 2720) { base = O1; ld = 1152; cc = c0 - 1568; } else { base = O0; ld = 0; cc = 0; ok = false; }
            if (ok) {
#pragma unroll
            for (int ai = 0; ai < 2; ++ai)
#pragma unroll
                for (int m = 0; m < 4; ++m) {
                    const f32x4 v0 = acc[ai][bj][m][0], v1 = acc[ai][bj][m][1];
                    u32x4 w; w.x = cvt_pk_bf16(v0[0], v0[1]); w.y = cvt_pk_bf16(v0[2], v0[3]); w.z = cvt_pk_bf16(v1[0], v1[1]); w.w = cvt_pk_bf16(v1[2], v1[3]);
                    *(u32x4*)(base + (size_t)(row0 + ai * HALF + m * 16) * ld + cc) = w;
                }
            }
        }
    }
};
struct EpiRes {
    static constexpr bool PERM = true, AFTER_DRAIN = false;
    const float* srcL; float* dstL; const float* srcC; float* dstC; const float* gate;
    __device__ __forceinline__ void operator()(const f32x4 (&acc)[2][2][4][2], const Unit& u, int wr, int wc, int fr, int fq) const {
        const int rowt = u.pm * BM;
        const bool lat = rowt < EP_ML;
        const float* src = lat ? srcL : srcC; float* dst = lat ? dstL : dstC;
        const float* g = gate + (lat ? (rowt >> 12) : 8) * 6144; const int rb = lat ? rowt : rowt - EP_ML;
        const int col0 = u.pn * BM + wc * 32 + 8 * fq;
#pragma unroll
        for (int bj = 0; bj < 2; ++bj) {
            const f32x4 g0 = *(const f32x4*)(g + col0 + bj * HALF), g1 = *(const f32x4*)(g + col0 + bj * HALF + 4);
#pragma unroll
            for (int ai = 0; ai < 2; ++ai)
#pragma unroll
                for (int m = 0; m < 4; ++m) { const size_t off = (size_t)(rb + ai * HALF + wr * 64 + m * 16 + fr) * 1024 + col0 + bj * HALF;
                    const f32x4 s0 = *(const f32x4*)(src + off), s1 = *(const f32x4*)(src + off + 4);
                    *(f32x4*)(dst + off) = s0 + g0 * acc[ai][bj][m][0]; *(f32x4*)(dst + off + 4) = s1 + g1 * acc[ai][bj][m][1]; }
        }
    }
};
struct EpiSwiglu {
    static constexpr bool PERM = true, AFTER_DRAIN = false;
    bf16_t* O0;
    __device__ __forceinline__ void operator()(const f32x4 (&acc)[2][2][4][2], const Unit& u, int wr, int wc, int fr, int fq) const {
        const int row0 = u.pm * BM + wr * 64 + fr, col = u.pn * HALF + wc * 32 + 8 * fq;
#pragma unroll
        for (int ai = 0; ai < 2; ++ai)
#pragma unroll
            for (int m = 0; m < 4; ++m) {
                float h[8];
#pragma unroll
                for (int n = 0; n < 2; ++n)
#pragma unroll
                    for (int e = 0; e < 4; ++e) { const float gt = acc[ai][0][m][n][e], up = acc[ai][1][m][n][e]; h[n * 4 + e] = gt * up * __builtin_amdgcn_rcpf(1.0f + __expf(-gt)); }
                u32x4 w; w.x = cvt_pk_bf16(h[0], h[1]); w.y = cvt_pk_bf16(h[2], h[3]); w.z = cvt_pk_bf16(h[4], h[5]); w.w = cvt_pk_bf16(h[6], h[7]);
                *(u32x4*)(O0 + (size_t)(row0 + ai * HALF + m * 16) * 2816 + col) = w;
            }
    }
};
template <class Epi, class Sched, bool ALIGN_EPI = false, bool SP2 = false>
__device__ __forceinline__ void gemm_phase(PG8_LAS unsigned char* lds, const Gemm g, const Sched& S, const Epi& E, int tid_in) {
    const int tid = tid_in, wid = __builtin_amdgcn_readfirstlane(tid >> 6), lane = tid & 63, wr = wid >> 2, wc = wid & 3, fr = lane & 15, fq = lane >> 4;
    const int K = g.K, nt = K / BK;
    unsigned voffA[2], voffB[2];
#pragma unroll
    for (int i = 0; i < 2; ++i) { int R, C; stage_rc(tid * 16 + i * 8192, R, C); const int Rb = Epi::PERM ? ((R & ~31) + perm32(R & 31)) : R;
        voffA[i] = (unsigned)(R * K + C) * 2u; voffB[i] = (unsigned)(Rb * K + C) * 2u; }
    const size_t kstep = (size_t)(BK * 2);
    const size_t hstep = (size_t)HALF * K * 2;
    const size_t tstep = 2 * hstep;
    const unsigned ldsw = (unsigned)wid * 1024u;
    const int aoff = lds_byte(wr * 64 + fr, fq * 8), boff = lds_byte(wc * 32 + fr, fq * 8);
#define PG8_SA(b, h) (((b) * 2 + (h)) * HTB)
#define PG8_SB(b, h) ((4 + (b) * 2 + (h)) * HTB)
#define PG8_STAGE(bufoff, gbase, voff) do { _Pragma("unroll") for (int _i = 0; _i < 2; ++_i) \
        __builtin_amdgcn_global_load_lds((const unsigned*)((const char*)(gbase) + (voff)[_i]), (PG8_LAS unsigned*)(lds + (bufoff) + ldsw + _i * 8192), 16, 0, 0); } while (0)
#define PG8_LDA(dst, b, h) do { _Pragma("unroll") for (int m = 0; m < 4; ++m) _Pragma("unroll") for (int k = 0; k < 2; ++k) dst[m][k] = *(const PG8_LAS bf16x8*)(lds + PG8_SA(b, h) + aoff + m * 2048 + k * 1024); } while (0)
#define PG8_LDB(dst, b, h) do { _Pragma("unroll") for (int n = 0; n < 2; ++n) _Pragma("unroll") for (int k = 0; k < 2; ++k) dst[n][k] = *(const PG8_LAS bf16x8*)(lds + PG8_SB(b, h) + boff + n * 2048 + k * 1024); } while (0)
#define PG8_MMA(ai, bj, At, Bt) do { __builtin_amdgcn_s_setprio(1); _Pragma("unroll") for (int m = 0; m < 4; ++m) _Pragma("unroll") for (int n = 0; n < 2; ++n) _Pragma("unroll") for (int k = 0; k < 2; ++k) \
        acc[ai][bj][m][n] = __builtin_amdgcn_mfma_f32_16x16x32_bf16(Bt[n][k], At[m][k], acc[ai][bj][m][n], 0, 0, 0); __builtin_amdgcn_s_setprio(0); } while (0)
#define PG8_WAIT_V(n) asm volatile("s_waitcnt vmcnt(" #n ")" ::: "memory")
#define PG8_WAIT_L(n) asm volatile("s_waitcnt lgkmcnt(" #n ")" ::: "memory")
#define PG8_BAR __builtin_amdgcn_s_barrier()
#define PG8_SCHED __builtin_amdgcn_sched_barrier(0)
    Unit cur, nxt; int ui = 0;
    if (!S.next(0, cur)) return;
    f32x4 acc[2][2][4][2];
#pragma unroll
    for (int a = 0; a < 2; ++a)
#pragma unroll
        for (int b = 0; b < 2; ++b)
#pragma unroll
            for (int m = 0; m < 4; ++m)
#pragma unroll
                for (int n = 0; n < 2; ++n) acc[a][b][m][n] = (f32x4){0.f, 0.f, 0.f, 0.f};
    bf16x8 At[4][2], B0[2][2], B1[2][2];
    const char* cA = (const char*)g.A + (size_t)cur.pm * tstep; const char* cB = (const char*)g.Bt + (size_t)cur.pn * tstep;
    S.a_ready(cur);
    if constexpr (SP2) {
        PG8_STAGE(PG8_SB(0, 0), cB, voffB); PG8_STAGE(PG8_SB(0, 1), cB + hstep, voffB); PG8_STAGE(PG8_SA(0, 0), cA, voffA); PG8_STAGE(PG8_SA(0, 1), cA + hstep, voffA);
        if (wr == 1) PG8_BAR;
        PG8_WAIT_V(2); PG8_BAR;
        PG8_STAGE(PG8_SB(1, 0), cB + kstep, voffB); PG8_STAGE(PG8_SA(1, 0), cA + kstep, voffA); PG8_STAGE(PG8_SB(1, 1), cB + hstep + kstep, voffB);
        PG8_WAIT_V(6); PG8_BAR;
    } else {
        PG8_STAGE(PG8_SB(0, 0), cB, voffB); PG8_STAGE(PG8_SA(0, 0), cA, voffA); PG8_STAGE(PG8_SB(0, 1), cB + hstep, voffB); PG8_STAGE(PG8_SA(0, 1), cA + hstep, voffA);
        if (wr == 1) PG8_BAR;
        PG8_WAIT_V(4); PG8_BAR;
        PG8_STAGE(PG8_SB(1, 0), cB + kstep, voffB); PG8_STAGE(PG8_SA(1, 0), cA + kstep, voffA); PG8_STAGE(PG8_SB(1, 1), cB + hstep + kstep, voffB);
        PG8_WAIT_V(6); PG8_BAR;
    }
    for (;;) {
        const bool has_next = S.next(ui + 1, nxt);
        const char* nA = has_next ? (const char*)g.A + (size_t)nxt.pm * tstep : cA; const char* nB = has_next ? (const char*)g.Bt + (size_t)nxt.pn * tstep : cB;
        for (int t = 0; t < nt; t += 2) {
            const bool last = (t == nt - 2);
            const char* a1 = cA + (size_t)(t + 1) * kstep;
            const char* a2 = last ? nA : cA + (size_t)(t + 2) * kstep; const char* b2 = last ? nB : cB + (size_t)(t + 2) * kstep;
            const char* a3 = a2 + kstep; const char* b3 = b2 + kstep;
            if (last && has_next) S.a_ready(nxt);
            if constexpr (SP2) {
            PG8_LDB(B0, 0, 0); PG8_LDB(B1, 0, 1); PG8_SCHED; PG8_LDA(At, 0, 0); PG8_STAGE(PG8_SA(1, 1), a1 + hstep, voffA);
            PG8_WAIT_V(8); PG8_WAIT_L(0); PG8_BAR; PG8_MMA(0, 0, At, B0); PG8_MMA(0, 1, At, B1); PG8_BAR; PG8_SCHED;
            PG8_LDA(At, 0, 1); PG8_STAGE(PG8_SB(0, 0), b2, voffB); PG8_STAGE(PG8_SB(0, 1), b2 + hstep, voffB); PG8_STAGE(PG8_SA(0, 0), a2, voffA);
            PG8_WAIT_V(8); PG8_WAIT_L(0); PG8_BAR; PG8_MMA(1, 0, At, B0); PG8_MMA(1, 1, At, B1); PG8_BAR; PG8_SCHED;
            PG8_LDB(B0, 1, 0); PG8_LDB(B1, 1, 1); PG8_SCHED; PG8_LDA(At, 1, 0); PG8_STAGE(PG8_SA(0, 1), a2 + hstep, voffA);
            PG8_WAIT_V(8); PG8_WAIT_L(0); PG8_BAR; PG8_MMA(0, 0, At, B0); PG8_MMA(0, 1, At, B1); PG8_BAR; PG8_SCHED;
            PG8_LDA(At, 1, 1); PG8_STAGE(PG8_SB(1, 0), b3, voffB); PG8_STAGE(PG8_SB(1, 1), b3 + hstep, voffB); PG8_STAGE(PG8_SA(1, 0), a3, voffA);
            PG8_WAIT_V(8); PG8_WAIT_L(0); PG8_BAR; PG8_MMA(1, 0, At, B0); PG8_MMA(1, 1, At, B1); PG8_BAR; PG8_SCHED;
            } else {
            PG8_LDB(B0, 0, 0); PG8_SCHED; PG8_LDA(At, 0, 0); PG8_STAGE(PG8_SA(1, 1), a1 + hstep, voffA);
            PG8_WAIT_L(8); PG8_BAR; PG8_WAIT_L(0); PG8_MMA(0, 0, At, B0); PG8_BAR; PG8_SCHED;
            PG8_LDB(B1, 0, 1); PG8_STAGE(PG8_SB(0, 0), b2, voffB);
            PG8_BAR; PG8_WAIT_L(0); PG8_MMA(0, 1, At, B1); PG8_BAR;
            PG8_LDA(At, 0, 1); PG8_STAGE(PG8_SA(0, 0), a2, voffA);
            PG8_BAR; PG8_WAIT_L(0); PG8_MMA(1, 0, At, B0); PG8_BAR; PG8_SCHED;
            PG8_STAGE(PG8_SB(0, 1), b2 + hstep, voffB);
            PG8_WAIT_V(6); PG8_BAR; PG8_MMA(1, 1, At, B1); PG8_BAR;
            PG8_LDB(B0, 1, 0); PG8_SCHED; PG8_LDA(At, 1, 0); PG8_STAGE(PG8_SA(0, 1), a2 + hstep, voffA);
            PG8_WAIT_L(8); PG8_BAR; PG8_WAIT_L(0); PG8_MMA(0, 0, At, B0); PG8_BAR; PG8_SCHED;
            PG8_LDB(B1, 1, 1); PG8_STAGE(PG8_SB(1, 0), b3, voffB);
            PG8_BAR; PG8_WAIT_L(0); PG8_MMA(0, 1, At, B1); PG8_BAR;
            PG8_LDA(At, 1, 1); PG8_STAGE(PG8_SA(1, 0), a3, voffA);
            PG8_BAR; PG8_WAIT_L(0); PG8_MMA(1, 0, At, B0); PG8_BAR; PG8_SCHED;
            PG8_STAGE(PG8_SB(1, 1), b3 + hstep, voffB);
            PG8_WAIT_V(6); PG8_BAR; PG8_MMA(1, 1, At, B1); PG8_BAR;
            }
        }
        if constexpr (ALIGN_EPI) { if (wr == 0) PG8_BAR; }
        if constexpr (!Epi::AFTER_DRAIN) { E(acc, cur, wr, wc, fr, fq); S.done(cur); }
        if (!has_next) break;
#pragma unroll
        for (int a = 0; a < 2; ++a)
#pragma unroll
            for (int b = 0; b < 2; ++b)
#pragma unroll
                for (int m = 0; m < 4; ++m)
#pragma unroll
                    for (int n = 0; n < 2; ++n) acc[a][b][m][n] = (f32x4){0.f, 0.f, 0.f, 0.f};
        cur = nxt; cA = nA; cB = nB; ++ui;
        if constexpr (ALIGN_EPI) { if (wr == 1) PG8_BAR; }
    }
    PG8_WAIT_V(0);
    if constexpr (!ALIGN_EPI) { if (wr == 0) PG8_BAR; }
    PG8_BAR;
    if constexpr (Epi::AFTER_DRAIN) { E.fused(acc, cur, wr, wc, fr, fq, lds, wid, lane); S.done(cur); }
#undef PG8_SA
#undef PG8_SB
#undef PG8_STAGE
#undef PG8_LDA
#undef PG8_LDB
#undef PG8_MMA
#undef PG8_WAIT_V
#undef PG8_WAIT_L
#undef PG8_BAR
#undef PG8_SCHED
}
}
#define LAS __attribute__((address_space(3)))
typedef unsigned short bf16_t;
typedef _Float16 hf;
typedef _Float16 h8 __attribute__((ext_vector_type(8)));
typedef _Float16 h4 __attribute__((ext_vector_type(4)));
typedef unsigned u32x4 __attribute__((ext_vector_type(4)));
typedef unsigned u32x2 __attribute__((ext_vector_type(2)));
typedef float f32x4 __attribute__((ext_vector_type(4)));
typedef short bf16x8 __attribute__((ext_vector_type(8)));

constexpr int DM = 1024, NB = 8, SEQ = 4096, CTXL = 256, NLAYER = 4;
constexpr int ML = NB * SEQ, MC = NB * CTXL, MT = ML + MC;
constexpr int INC = 2720, INP = 2816, P1C = 1568, RAWC = 1152, FF = 2816;
constexpr int PRC = 2304, PGC = 512;
constexpr int NTHREADS = 512, NWAVES = 8;
constexpr int LDS_BYTES = 147456;
constexpr size_t MiB = 1u << 20;
constexpr size_t WS_CTL = 0, WS_MOD = 1 * MiB, WS_ROPE = 2 * MiB, WS_BONUS = 3 * MiB, WS_WT = 4 * MiB, WS_XC = 28 * MiB, WS_XN = 36 * MiB,
                 WS_P1 = 104 * MiB, WS_RAW = 209 * MiB, WS_PREP = 286 * MiB, WS_PG = 439 * MiB, WS_GG = 473 * MiB, WS_END = 490 * MiB;
constexpr size_t WS_H = 104 * MiB;
constexpr size_t WS_OR = 209 * MiB, WS_OG = 243 * MiB;
constexpr size_t WT_IN = 0, WT_OUT = (size_t)INP * DM * 2, WT_GU = WT_OUT + (size_t)DM * DM * 2, WT_DN = WT_GU + (size_t)2 * FF * DM * 2;
static_assert(WT_DN + (size_t)DM * FF * 2 == 24 * MiB, "wt");
static_assert(WS_P1 + (size_t)MT * P1C * 2 <= WS_RAW && WS_RAW + (size_t)MT * RAWC * 2 <= WS_PREP && WS_PREP + (size_t)MT * PRC * 2 <= WS_PG && WS_PG + (size_t)MT * PGC * 2 <= WS_GG && WS_GG + (size_t)MT * 256 * 2 <= WS_END, "ws map");
static_assert(WS_OG + (size_t)2 * MT * 256 * 2 <= WS_PREP && WS_H + (size_t)MT * FF * 2 <= WS_PG && WS_XN + (size_t)MT * DM * 2 <= WS_P1, "ws overlay");

struct Params { const float* in[29]; float* out; unsigned char* ws; };
typedef const __attribute__((address_space(4))) Params* kparams_t;

__device__ __forceinline__ float bf2f(unsigned b) { return __uint_as_float(b << 16); }
__device__ __forceinline__ unsigned f2bf(float f) { unsigned u = __float_as_uint(f); return (u + 0x7fffu + ((u >> 16) & 1u)) >> 16; }
__device__ __forceinline__ unsigned pk2(float lo, float hi) { return f2bf(lo) | (f2bf(hi) << 16); }
typedef float f32x2_t __attribute__((ext_vector_type(2))); typedef __bf16 bf16x2_t __attribute__((ext_vector_type(2)));
__device__ __forceinline__ unsigned cvtpk(float lo, float hi) { const f32x2_t v = {lo, hi}; const bf16x2_t b = __builtin_convertvector(v, bf16x2_t); return __builtin_bit_cast(unsigned, b); }
__device__ __forceinline__ float bflo(unsigned w) { return __uint_as_float(w << 16); }
__device__ __forceinline__ float bfhi(unsigned w) { return __uint_as_float(w & 0xffff0000u); }
__device__ __forceinline__ float sigmoidf_(float x) { return __builtin_amdgcn_rcpf(1.0f + __expf(-x)); }
__device__ __forceinline__ float softplusf_(float x) { return fmaxf(x, 0.f) + __logf(1.0f + __expf(-fabsf(x))); }
template <int CTRL> __device__ __forceinline__ float dpp_add(float x) {
    return x + __int_as_float(__builtin_amdgcn_update_dpp(0, __float_as_int(x), CTRL, 0xF, 0xF, true));
}
__device__ __forceinline__ float reduce4(float x) { x = dpp_add<0xB1>(x); x = dpp_add<0x4E>(x); return x; }
__device__ __forceinline__ float reduce16(float x) { x = dpp_add<0xB1>(x); x = dpp_add<0x4E>(x); x = dpp_add<0x141>(x); x = dpp_add<0x140>(x); return x; }
__device__ __forceinline__ float reduce8(float x) { x = dpp_add<0xB1>(x); x = dpp_add<0x4E>(x); x = dpp_add<0x141>(x); return x; }
__device__ __forceinline__ float wave_sum(float v) {
    v = reduce16(v);
    const int vi = __float_as_int(v);
    const float r0 = __int_as_float(__builtin_amdgcn_readlane(vi, 0)), r1 = __int_as_float(__builtin_amdgcn_readlane(vi, 16)), r2 = __int_as_float(__builtin_amdgcn_readlane(vi, 32)), r3 = __int_as_float(__builtin_amdgcn_readlane(vi, 48));
    return (r0 + r1) + (r2 + r3);
}

__device__ __forceinline__ void phase_mod(unsigned char* lds, kparams_t p, int tid, int bid, int G) {
    float* sc = (float*)lds;
    float* part = (float*)(lds + 36864);
    const float* c = p->in[1]; const float* cctx = p->in[3]; const float* ada_w = p->in[4]; const float* ada_b = p->in[5];
    float* MOD = (float*)(p->ws + WS_MOD);
    for (int i = tid; i < 9 * 1024; i += NTHREADS) { const float x = i < 8192 ? c[i] : cctx[i - 8192]; sc[i] = x * sigmoidf_(x); }
    __syncthreads();
    const int cl = tid & 31, kg = tid >> 5;
    for (int item = bid; item < NLAYER * 192; item += G) {
        const int l = item / 192, cgp = item % 192, col = cgp * 32 + cl;
        float acc[9];
#pragma unroll
        for (int s = 0; s < 9; ++s) acc[s] = 0.f;
        const float* w = ada_w + ((size_t)l * 1024 + kg * 64) * 6144 + col;
#pragma unroll 16
        for (int kk = 0; kk < 64; ++kk) { const float wv = w[(size_t)kk * 6144];
#pragma unroll
            for (int s = 0; s < 9; ++s) acc[s] = fmaf(sc[s * 1024 + kg * 64 + kk], wv, acc[s]); }
#pragma unroll
        for (int s = 0; s < 9; ++s) part[(kg * 9 + s) * 32 + cl] = acc[s];
        __syncthreads();
        if (tid < 288) { const int s = tid >> 5; float a = ada_b[l * 6144 + col];
#pragma unroll
            for (int k2 = 0; k2 < 16; ++k2) a += part[(k2 * 9 + s) * 32 + cl];
            MOD[((size_t)l * 9 + s) * 6144 + col] = a; }
        __syncthreads();
    }
    float* RC = (float*)(p->ws + WS_ROPE); float* RS = RC + 4096 * 32;
    for (int idx = bid * NTHREADS + tid; idx < 4096 * 32; idx += G * NTHREADS) {
        const int t = idx >> 5, j = idx & 31; const float pos = (float)(j < 16 ? (t >> 6) : (t & 63));
        const float inv = exp2f(-(float)(j & 15) * (13.287712379549449f / 16.0f));
        const float ang = pos * inv; const float rev = ang * 0.15915494309189535f; const float fr = rev - floorf(rev);
        const float a2 = fr * 6.283185307179586f;
        RC[idx] = __cosf(a2); RS[idx] = __sinf(a2);
    }
}

__device__ __forceinline__ void transpose_item(const float* W, int K, int N, bf16_t* WT, int k0, int n0, int drow0, LAS float* scr, int lane) {
#pragma unroll 16
    for (int i = 0; i < 32; ++i) { const int kk = 2 * i + (lane >> 5); scr[kk * 33 + (lane & 31)] = W[(size_t)(k0 + kk) * N + n0 + (lane & 31)]; }
    asm volatile("s_waitcnt lgkmcnt(0)" ::: "memory");
    const int c = lane & 7;
#pragma unroll
    for (int j = 0; j < 4; ++j) { const int n = (lane >> 3) + 8 * j; const LAS float* s = scr + (8 * c) * 33 + n;
        u32x4 o; o.x = pk2(s[0 * 33], s[1 * 33]); o.y = pk2(s[2 * 33], s[3 * 33]); o.z = pk2(s[4 * 33], s[5 * 33]); o.w = pk2(s[6 * 33], s[7 * 33]);
        *(u32x4*)(WT + (size_t)(drow0 + n) * K + k0 + 8 * c) = o; }
    asm volatile("s_waitcnt lgkmcnt(0)" ::: "memory");
}
__device__ __forceinline__ void convert_weights(unsigned char* lds, kparams_t p, int l, int gw, int ngw, int wave, int lane) {
    LAS float* scr = (LAS float*)((LAS unsigned char*)lds + wave * 16384);
    unsigned char* wt = p->ws + WS_WT;
    constexpr int I_IN = 16 * 85, I_OUT = 16 * 32, I_G = 16 * 88, I_D = 44 * 32;
    constexpr int NIT = I_IN + I_OUT + 2 * I_G + I_D;
    for (int it = gw; it < NIT; it += ngw) {
        int r = it;
        if (r < I_IN) { const int kb = r / 85, nb = r % 85; transpose_item(p->in[8] + (size_t)l * DM * INC, DM, INC, (bf16_t*)(wt + WT_IN), kb * 64, nb * 32, nb * 32, scr, lane); continue; } r -= I_IN;
        if (r < I_OUT) { const int kb = r / 32, nb = r % 32; transpose_item(p->in[9] + (size_t)l * DM * DM, DM, DM, (bf16_t*)(wt + WT_OUT), kb * 64, nb * 32, nb * 32, scr, lane); continue; } r -= I_OUT;
        if (r < I_G) { const int kb = r / 88, nb = r % 88, n0 = nb * 32; transpose_item(p->in[25] + (size_t)l * DM * FF, DM, FF, (bf16_t*)(wt + WT_GU), kb * 64, n0, (n0 >> 7) * 256 + (n0 & 127), scr, lane); continue; } r -= I_G;
        if (r < I_G) { const int kb = r / 88, nb = r % 88, n0 = nb * 32; transpose_item(p->in[26] + (size_t)l * DM * FF, DM, FF, (bf16_t*)(wt + WT_GU), kb * 64, n0, (n0 >> 7) * 256 + 128 + (n0 & 127), scr, lane); continue; } r -= I_G;
        { const int kb = r / 32, nb = r % 32; transpose_item(p->in[27] + (size_t)l * FF * DM, FF, DM, (bf16_t*)(wt + WT_DN), kb * 64, nb * 32, nb * 32, scr, lane); }
    }
}

__device__ __forceinline__ void norm_row_store(const f32x4 (&v)[4], int m, const float* gamma, const float* modl, int shoff, int scoff, bf16_t* XN, int lane) {
    const int s = m < ML ? (m >> 12) : 8; const float* md = modl + (size_t)s * 6144;
    float ss = 0.f;
#pragma unroll
    for (int j = 0; j < 4; ++j) ss += (v[j].x * v[j].x + v[j].y * v[j].y) + (v[j].z * v[j].z + v[j].w * v[j].w);
    const float rstd = rsqrtf(wave_sum(ss) * (1.0f / DM) + 1e-6f);
#pragma unroll
    for (int j = 0; j < 4; ++j) { const int c4 = lane + 64 * j; const f32x4 g = ((const f32x4*)gamma)[c4], sc = ((const f32x4*)(md + scoff))[c4], sh = ((const f32x4*)(md + shoff))[c4];
        const f32x4 y = (v[j] * rstd * g) * (sc + 1.0f) + sh; u32x2 o; o.x = cvtpk(y.x, y.y); o.y = cvtpk(y.z, y.w);
        ((u32x2*)(XN + (size_t)m * DM))[c4] = o; }
}
__device__ __forceinline__ void norm_mod_rows(const float* srcL, const float* srcC, const float* gamma, const float* modl, int shoff, int scoff, bf16_t* XN, int nrows, int gw, int ngw, int lane) {
    f32x4 va[4], vb[4];
#define NM_LOAD(dst, mm) do { if ((mm) < nrows) { const float* xr_ = (mm) < ML ? srcL + (size_t)(mm) * DM : srcC + (size_t)((mm) - ML) * DM; \
        _Pragma("unroll") for (int j = 0; j < 4; ++j) dst[j] = ((const f32x4*)xr_)[lane + 64 * j]; } } while (0)
    int m = gw;
    NM_LOAD(va, m); NM_LOAD(vb, m + ngw);
    while (m < nrows) {
        f32x4 na[4], nb[4];
        NM_LOAD(na, m + 2 * ngw); NM_LOAD(nb, m + 3 * ngw);
        norm_row_store(va, m, gamma, modl, shoff, scoff, XN, lane);
        if (m + ngw < nrows) norm_row_store(vb, m + ngw, gamma, modl, shoff, scoff, XN, lane);
#pragma unroll
        for (int j = 0; j < 4; ++j) { va[j] = na[j]; vb[j] = nb[j]; }
        m += 2 * ngw;
    }
#undef NM_LOAD
}
__device__ __forceinline__ void final_norm_rows(float* x, const float* gamma, int gw, int ngw, int lane) {
    for (int m = gw; m < ML; m += ngw) {
        float* xr = x + (size_t)m * DM; f32x4 v[4]; float ss = 0.f;
#pragma unroll
        for (int j = 0; j < 4; ++j) { v[j] = ((const f32x4*)xr)[lane + 64 * j]; ss += (v[j].x * v[j].x + v[j].y * v[j].y) + (v[j].z * v[j].z + v[j].w * v[j].w); }
        const float rstd = rsqrtf(wave_sum(ss) * (1.0f / DM) + 1e-6f);
#pragma unroll
        for (int j = 0; j < 4; ++j) { const int c4 = lane + 64 * j; ((f32x4*)xr)[c4] = v[j] * rstd * ((const f32x4*)gamma)[c4]; }
    }
}
#define XB_TMO      128
#define XB_XCNT(j)  (256  + 64 * (j))
#define XB_XSUB(j)  (1280 + 64 * (j))
#define XB_XGEN(j)  (2304 + 64 * (j))
#define XB_TOP      3328
#define XB_TOPGEN   3392
#define XCD_BAR_WORDS 3456
#define XB_SPIN_CAP (1u << 18)

__device__ __forceinline__ unsigned xb_ld(unsigned* p)              { return __hip_atomic_load(p, __ATOMIC_RELAXED, __HIP_MEMORY_SCOPE_AGENT); }
__device__ __forceinline__ unsigned xb_add(unsigned* p, unsigned v) { return __hip_atomic_fetch_add(p, v, __ATOMIC_RELAXED, __HIP_MEMORY_SCOPE_AGENT); }
__device__ __forceinline__ unsigned xb_xcc_id() { return (unsigned)__builtin_amdgcn_s_getreg((3 << 11) | 20) & 0xFu; }
#define XB_SPIN(cond, bar) do { unsigned _sp = 0; while (cond) { __builtin_amdgcn_s_sleep(1); \
    if ((++_sp & 255u) == 0u) { if (xb_ld(&(bar)[XB_TMO])) break; if (_sp > XB_SPIN_CAP) { atomicAdd(&(bar)[XB_TMO], 1u); break; } } } } while (0)

struct XcdBarrier {
    unsigned* bar; unsigned x;
    volatile LAS unsigned* st;
};

__device__ __forceinline__ XcdBarrier xcd_barrier_post(unsigned* bar, volatile LAS unsigned* st) {
    XcdBarrier b; b.bar = bar; b.x = xb_xcc_id(); b.st = st;
    if (threadIdx.x == 0) (void)xb_add(&bar[XB_XCNT(b.x)], 1u);
    return b;
}
__device__ __forceinline__ void xcd_barrier_complete(unsigned* bar, unsigned x, unsigned& nloc, unsigned& nx) {
    const unsigned G = gridDim.x * gridDim.y * gridDim.z;
    unsigned sum, cnt, mine, sp = 0u;
    for (;;) {
        sum = 0u; cnt = 0u; mine = 0u;
#pragma unroll
        for (unsigned j = 0; j < 16; ++j) { const unsigned c = xb_ld(&bar[XB_XCNT(j)]); sum += c; cnt += (c > 0u) ? 1u : 0u; mine = (j == x) ? c : mine; }
        if (sum == G) break;
        __builtin_amdgcn_s_sleep(1);
        if ((++sp & 255u) == 0u) { if (xb_ld(&bar[XB_TMO])) break; if (sp > XB_SPIN_CAP) { atomicAdd(&bar[XB_TMO], 1u); break; } }
    }
    nloc = mine > 0u ? mine : 1u; nx = cnt > 0u ? cnt : 1u;
}

__device__ __forceinline__ void xcd_barrier(const XcdBarrier& b) {
    asm volatile("s_waitcnt vmcnt(0)" ::: "memory");
    __syncthreads();
    if (threadIdx.x == 0) {
        unsigned* bar = b.bar;
        __builtin_amdgcn_s_waitcnt(0);
        unsigned nloc = b.st[0], nx = b.st[1];
        if (nloc == 0u) { xcd_barrier_complete(bar, b.x, nloc, nx); b.st[0] = nloc; b.st[1] = nx; }
        const unsigned old = xb_add(&bar[XB_XSUB(b.x)], 1u);
        const unsigned gen = old / nloc;
        if (old + 1u == (gen + 1u) * nloc) {
            __builtin_amdgcn_fence(__ATOMIC_RELEASE, "agent");
            asm volatile("s_waitcnt vmcnt(0)" ::: "memory");
            const unsigned og = xb_add(&bar[XB_TOP], 1u);
            const unsigned tg = og / nx;
            if (og + 1u == (tg + 1u) * nx) xb_add(&bar[XB_TOPGEN], 1u);
            else XB_SPIN(xb_ld(&bar[XB_TOPGEN]) == tg, bar);
            __builtin_amdgcn_fence(__ATOMIC_ACQUIRE, "agent");
            xb_add(&bar[XB_XGEN(b.x)], 1u);
            asm volatile("s_waitcnt vmcnt(0)" ::: "memory");
        } else {
            XB_SPIN(xb_ld(&bar[XB_XGEN(b.x)]) == gen, bar);
            __builtin_amdgcn_fence(__ATOMIC_ACQUIRE, "agent");
            asm volatile("s_waitcnt vmcnt(0)" ::: "memory");
        }
    }
    __syncthreads();
}
__device__ __forceinline__ bf16x8 load_wfrag(const float* W, int k0, int c) {
    u32x4 t; t.x = pk2(W[(k0 + 0) * 256 + c], W[(k0 + 1) * 256 + c]); t.y = pk2(W[(k0 + 2) * 256 + c], W[(k0 + 3) * 256 + c]);
    t.z = pk2(W[(k0 + 4) * 256 + c], W[(k0 + 5) * 256 + c]); t.w = pk2(W[(k0 + 6) * 256 + c], W[(k0 + 7) * 256 + c]);
    return __builtin_bit_cast(bf16x8, t);
}
__device__ __forceinline__ u32x2 pack_h4(float a, float b, float c, float d) {
    const h4 v = {(hf)a, (hf)b, (hf)c, (hf)d}; return __builtin_bit_cast(u32x2, v);
}
__device__ __forceinline__ void phase_prep(unsigned char* ldsg, kparams_t p, int l, int tid, int bid, int G, bool do_rope) {
    LAS unsigned char* lds = (LAS unsigned char*)ldsg;
    LAS float* SH = (LAS float*)lds;
    LAS unsigned char* ACT = lds + 73728;
    LAS float* KK = (LAS float*)(lds + 86272);
    LAS float* GL = (LAS float*)(lds + 102656);
    const int lane = tid & 63, wave = tid >> 6, fr = lane & 15, quad = lane >> 4;
    bf16_t* P1 = (bf16_t*)(p->ws + WS_P1); const bf16_t* RAW = (const bf16_t*)(p->ws + WS_RAW);
    hf* PREP = (hf*)(p->ws + WS_PREP); hf* PG = (hf*)(p->ws + WS_PG); hf* GG = (hf*)(p->ws + WS_GG); float* BONUS = (float*)(p->ws + WS_BONUS);
    const float* RC = (const float*)(p->ws + WS_ROPE); const float* RS = RC + 4096 * 32;
    const float* shw = p->in[14] + (size_t)l * 3 * RAWC;
    const float* w0 = p->in[15] + (size_t)l * 512; const float* w2 = p->in[16] + (size_t)l * 2 * 64 * 256;
    const float* a0 = p->in[17] + (size_t)l * 512; const float* a2 = p->in[18] + (size_t)l * 2 * 64 * 256;
    const float* g2 = p->in[19] + (size_t)l * 128 * 256;
    const float* k_k = p->in[20] + l * 256; const float* k_a = p->in[21] + l * 256; const float* r_k = p->in[22] + l * 256;
    const float* dw = p->in[10] + (size_t)l * 2 * 16 * 128; const float* db = p->in[11] + l * 256;
    bf16x8 Fw[2][2][2], Fa[2][2][2], Fg[2][4];
#pragma unroll
    for (int ct2 = 0; ct2 < 2; ++ct2) { const int c = (wave * 2 + ct2) * 16 + fr;
#pragma unroll
        for (int i = 0; i < 2; ++i)
#pragma unroll
            for (int ks = 0; ks < 2; ++ks) { Fw[i][ct2][ks] = load_wfrag(w2 + (size_t)i * 64 * 256, ks * 32 + quad * 8, c); Fa[i][ct2][ks] = load_wfrag(a2 + (size_t)i * 64 * 256, ks * 32 + quad * 8, c); }
#pragma unroll
        for (int ks = 0; ks < 4; ++ks) Fg[ct2][ks] = load_wfrag(g2, ks * 32 + quad * 8, c); }
    const int cgp = tid % 144, part = tid / 144, c8 = cgp * 8;
    const int tokb = part == 0 ? 0 : (part == 1 ? 6 : 11), toke = part == 0 ? 6 : (part == 1 ? 11 : 16);
    for (int tile = bid; tile < MT / 16; tile += G) {
        const int row0 = tile * 16; const bool lat = row0 < ML;
        const int t0 = lat ? (row0 & 4095) : ((row0 - ML) & 255); const int T = lat ? 4096 : 256;
        if (part < 3) {
            float sw0[8], sw1[8], sw2[8];
#pragma unroll
            for (int e = 0; e < 8; ++e) { sw0[e] = shw[c8 + e]; sw1[e] = shw[RAWC + c8 + e]; sw2[e] = shw[2 * RAWC + c8 + e]; }
            const u32x4 z4 = {0u, 0u, 0u, 0u};
            const bf16_t* rp = RAW + (size_t)(row0 + tokb) * RAWC + c8;
            const int ntok = toke - tokb;
            u32x4 rw[8];
#pragma unroll
            for (int j = 0; j < 8; ++j) { const int tt = t0 + tokb - 1 + j; rw[j] = (j < ntok + 2 && tt >= 0 && tt < T) ? *(const u32x4*)(rp + (ptrdiff_t)(j - 1) * RAWC) : z4; }
#pragma unroll
            for (int j = 0; j < 6; ++j) {
                if (j < ntok) {
                    const int tok = tokb + j; const u32x4 prv = rw[j], cur = rw[j + 1], nxt = rw[j + 2];
                    f32x4 o0, o1;
#pragma unroll
                    for (int e = 0; e < 4; ++e) {
                        const float x0 = sw0[2 * e] * bflo(prv[e]) + sw1[2 * e] * bflo(cur[e]) + sw2[2 * e] * bflo(nxt[e]);
                        const float x1 = sw0[2 * e + 1] * bfhi(prv[e]) + sw1[2 * e + 1] * bfhi(cur[e]) + sw2[2 * e + 1] * bfhi(nxt[e]);
                        if (e < 2) { o0[2 * e] = x0; o0[2 * e + 1] = x1; } else { o1[2 * e - 4] = x0; o1[2 * e - 3] = x1; }
                    }
                    *(LAS f32x4*)(SH + tok * RAWC + c8) = o0; *(LAS f32x4*)(SH + tok * RAWC + c8 + 4) = o1;
                }
            }
        }
        { const int tok = tid >> 5, j = tid & 31; GL[j * 16 + tok] = bf2f(P1[(size_t)(row0 + tok) * P1C + 768 + j]); }
        __syncthreads();
        for (int idx = tid; idx < 16 * 192; idx += NTHREADS) {
            const int tok = idx / 192, j2 = (idx % 192) * 2; const float xa = SH[tok * RAWC + 768 + j2], xb = SH[tok * RAWC + 768 + j2 + 1];
            float ya, yb;
            if (j2 < 128) { ya = 1.0f - 2.0f * __builtin_amdgcn_rcpf(__expf(2.0f * xa) + 1.0f); yb = 1.0f - 2.0f * __builtin_amdgcn_rcpf(__expf(2.0f * xb) + 1.0f); }
            else if (j2 < 256) { ya = xa; yb = xb; }
            else { ya = sigmoidf_(xa); yb = sigmoidf_(xb); }
            *(LAS unsigned*)(ACT + tok * 784 + j2 * 2) = cvtpk(ya, yb);
        }
#pragma unroll 1
        for (int i = 0; i < 8; ++i) {
            const int pair = wave * 8 + i, tok = pair >> 2, h = pair & 3, c = h * 64 + lane; const size_t row = row0 + tok;
            const float r = SH[tok * RAWC + c], k = SH[tok * RAWC + 256 + c], v = SH[tok * RAWC + 512 + c];
            const float val = k * k_k[c]; const float ss = wave_sum(val * val); const float kk = val * rsqrtf(ss + 1e-12f);
            KK[tok * 256 + c] = kk;
            const float bon = wave_sum(r * k * r_k[c]);
            if (lane == 0) BONUS[row * 4 + h] = bon;
            PREP[row * PRC + c] = (hf)r; PREP[row * PRC + 256 + c] = (hf)kk; PREP[row * PRC + 512 + c] = (hf)v;
        }
        __syncthreads();
        {
#define BFRAG(s2) (*(const LAS bf16x8*)(ACT + fr * 784 + ((s2) * 32 + quad * 8) * 2))
            const size_t row = row0 + fr;
#pragma unroll
            for (int ct2 = 0; ct2 < 2; ++ct2) {
                const int c0 = (wave * 2 + ct2) * 16 + quad * 4;
                const f32x4 zf = {0.f, 0.f, 0.f, 0.f};
                const f32x4 k4 = *(const LAS f32x4*)(SH + fr * RAWC + 256 + c0), kk4 = *(const LAS f32x4*)(KK + fr * 256 + c0), ka4 = *(const f32x4*)(k_a + c0);
#pragma unroll
                for (int i = 0; i < 2; ++i) {
                    f32x4 aw = __builtin_amdgcn_mfma_f32_16x16x32_bf16(Fw[i][ct2][0], BFRAG(i * 2), zf, 0, 0, 0); aw = __builtin_amdgcn_mfma_f32_16x16x32_bf16(Fw[i][ct2][1], BFRAG(i * 2 + 1), aw, 0, 0, 0);
                    f32x4 aa = __builtin_amdgcn_mfma_f32_16x16x32_bf16(Fa[i][ct2][0], BFRAG(4 + i * 2), zf, 0, 0, 0); aa = __builtin_amdgcn_mfma_f32_16x16x32_bf16(Fa[i][ct2][1], BFRAG(4 + i * 2 + 1), aa, 0, 0, 0);
                    const f32x4 z = aw + *(const f32x4*)(w0 + i * 256 + c0), az = aa + *(const f32x4*)(a0 + i * 256 + c0);
                    float dec[4], bb[4], kd[4];
#pragma unroll
                    for (int j = 0; j < 4; ++j) { dec[j] = __expf(-__expf(-softplusf_(-z[j]) - 0.5f)); const float a = sigmoidf_(az[j]); bb[j] = -(kk4[j] * a); kd[j] = k4[j] * (1.0f + (a - 1.0f) * ka4[j]); }
                    hf* dst = PREP + row * PRC + 768 + i * 768 + c0;
                    *(u32x2*)dst = pack_h4(dec[0], dec[1], dec[2], dec[3]); *(u32x2*)(dst + 256) = pack_h4(bb[0], bb[1], bb[2], bb[3]); *(u32x2*)(dst + 512) = pack_h4(kd[0], kd[1], kd[2], kd[3]);
                }
                f32x4 ag = __builtin_amdgcn_mfma_f32_16x16x32_bf16(Fg[ct2][0], BFRAG(8), zf, 0, 0, 0);
#pragma unroll
                for (int ks = 1; ks < 4; ++ks) ag = __builtin_amdgcn_mfma_f32_16x16x32_bf16(Fg[ct2][ks], BFRAG(8 + ks), ag, 0, 0, 0);
                *(u32x2*)(GG + row * 256 + c0) = pack_h4(ag[0], ag[1], ag[2], ag[3]);
            }
        }
        {
            const int c = tid & 127, i = (tid >> 7) & 1, th = tid >> 8;
            float acc[8]; const float bb = db[i * 128 + c];
#pragma unroll
            for (int q = 0; q < 8; ++q) acc[q] = bb;
            const float* W = dw + (size_t)i * 16 * 128 + c;
#pragma unroll
            for (int j = 0; j < 16; ++j) { const float wv = W[j * 128]; const f32x4 ta = *(const LAS f32x4*)(GL + (i * 16 + j) * 16 + th * 8), tb = *(const LAS f32x4*)(GL + (i * 16 + j) * 16 + th * 8 + 4);
                acc[0] = fmaf(ta.x, wv, acc[0]); acc[1] = fmaf(ta.y, wv, acc[1]); acc[2] = fmaf(ta.z, wv, acc[2]); acc[3] = fmaf(ta.w, wv, acc[3]);
                acc[4] = fmaf(tb.x, wv, acc[4]); acc[5] = fmaf(tb.y, wv, acc[5]); acc[6] = fmaf(tb.z, wv, acc[6]); acc[7] = fmaf(tb.w, wv, acc[7]); }
#pragma unroll
            for (int q = 0; q < 8; ++q) { const float glog = -softplusf_(-acc[q]) * (1.0f / 16.0f); PG[(size_t)(row0 + th * 8 + q) * PGC + 256 + i * 128 + c] = (hf)__expf(glog); }
            { const int tok = tid >> 5, c8q = (tid & 31) * 8; const u32x4 x = *(const u32x4*)(P1 + (size_t)(row0 + tok) * P1C + c8q); const float sc = c8q < 128 ? 0.17677669529663687f : 1.0f;
              u32x4 o;
#pragma unroll
              for (int e = 0; e < 4; ++e) { const h4 t = {(hf)(bflo(x[e]) * sc), (hf)(bfhi(x[e]) * sc), (hf)0.f, (hf)0.f}; o[e] = __builtin_bit_cast(u32x2, t).x; }
              *(u32x4*)(PG + (size_t)(row0 + tok) * PGC + c8q) = o; }
        }
        if (lat && do_rope) {
            for (int task = tid; task < 640; task += NTHREADS) {
                const int tok = task / 40, r = task % 40, hh = r >> 2, gi = r & 3; const int t = t0 + tok;
                bf16_t* ptr = P1 + (size_t)(row0 + tok) * P1C + 800 + hh * 64 + gi * 8;
                const u32x4 x1 = *(const u32x4*)ptr, x2 = *(const u32x4*)(ptr + 32);
                const f32x4 ca = *(const f32x4*)(RC + t * 32 + gi * 8), cb = *(const f32x4*)(RC + t * 32 + gi * 8 + 4), sa = *(const f32x4*)(RS + t * 32 + gi * 8), sb = *(const f32x4*)(RS + t * 32 + gi * 8 + 4);
                const float cs[8] = {ca.x, ca.y, ca.z, ca.w, cb.x, cb.y, cb.z, cb.w}, sn[8] = {sa.x, sa.y, sa.z, sa.w, sb.x, sb.y, sb.z, sb.w};
                u32x4 o1, o2;
#pragma unroll
                for (int e = 0; e < 4; ++e) {
                    const float a0_ = bflo(x1[e]), a1_ = bfhi(x1[e]), b0_ = bflo(x2[e]), b1_ = bfhi(x2[e]);
                    const float c0_ = cs[2 * e], c1_ = cs[2 * e + 1], s0_ = sn[2 * e], s1_ = sn[2 * e + 1];
                    o1[e] = cvtpk(a0_ * c0_ - b0_ * s0_, a1_ * c1_ - b1_ * s1_); o2[e] = cvtpk(a0_ * s0_ + b0_ * c0_, a1_ * s1_ + b1_ * c1_);
                }
                *(u32x4*)ptr = o1; *(u32x4*)(ptr + 32) = o2;
            }
        }
        __syncthreads();
    }
}
#ifndef NO_MIX
#define MIXLO(d, a, h, c) asm("v_fma_mix_f32 %0, %1, %2, %3 op_sel:[0,0,0] op_sel_hi:[0,1,0]" : "=v"(d) : "v"(a), "v"(h), "v"(c))
#define MIXHI(d, a, h, c) asm("v_fma_mix_f32 %0, %1, %2, %3 op_sel:[0,1,0] op_sel_hi:[0,1,0]" : "=v"(d) : "v"(a), "v"(h), "v"(c))
#else
#define MIXLO(d, a, h, c) d = fmaf(a, (float)__builtin_bit_cast(hf, (unsigned short)((h) & 0xffffu)), c)
#define MIXHI(d, a, h, c) d = fmaf(a, (float)__builtin_bit_cast(hf, (unsigned short)((h) >> 16)), c)
#endif
#define DSR128(dst, addr, OFF) asm volatile("ds_read_b128 %0, %1 offset:" #OFF : "=v"(dst) : "v"(addr))
#define DSR64(dst, addr, OFF) asm volatile("ds_read_b64 %0, %1 offset:" #OFF : "=v"(dst) : "v"(addr))
#define DSR16(dst, addr, OFF) asm volatile("ds_read_u16 %0, %1 offset:" #OFF : "=v"(dst) : "v"(addr))
#define LDS_BAR() do { asm volatile("s_waitcnt lgkmcnt(0)" ::: "memory"); __builtin_amdgcn_s_barrier(); asm volatile("" ::: "memory"); } while (0)
#define REP32(M) M(0) M(1) M(2) M(3) M(4) M(5) M(6) M(7) M(8) M(9) M(10) M(11) M(12) M(13) M(14) M(15) M(16) M(17) M(18) M(19) M(20) M(21) M(22) M(23) M(24) M(25) M(26) M(27) M(28) M(29) M(30) M(31)
__device__ __forceinline__ unsigned lds_addr(LAS unsigned char* p) { return (unsigned)(uintptr_t)p; }

__device__ __forceinline__ int chain_row(int b, int dir, int s) {
    if (s < 256) return ML + b * 256 + (dir ? 255 - s : s);
    const int t = s - 256; return b * 4096 + (dir ? 4095 - t : t);
}
constexpr int NCHUNK = (SEQ + CTXL) / 32;
__device__ __forceinline__ void rwkv_scan_item(unsigned char* ldsg, kparams_t p, int item, int tid, int expflag) {
    LAS unsigned char* lds = (LAS unsigned char*)ldsg;
    constexpr int STEPB = 704, BUFB = 32 * STEPB, NPIECE = 32 * 44;
    LAS unsigned char* obuf = lds + 2 * BUFB;
    const int chain = item >> 1, half_ = item & 1, b = chain >> 3, h = (chain >> 1) & 3, dir = chain & 1;
    const int lane = tid & 63, wave = tid >> 6, kq = lane & 15, rloc = wave * 4 + (lane >> 4);
    const hf* PREP = (const hf*)(p->ws + WS_PREP); hf* OR = (hf*)(p->ws + WS_OR) + (size_t)dir * MT * 256;
    int srcoff[6]; srcoff[0] = h * 64; srcoff[1] = 256 + h * 64; srcoff[2] = 768 + dir * 768 + h * 64; srcoff[3] = srcoff[2] + 256; srcoff[4] = srcoff[2] + 512; srcoff[5] = 512 + h * 64 + half_ * 32;
    float S[4];
#pragma unroll
    for (int i = 0; i < 4; ++i) S[i] = 0.f;
    u32x4 pre[3];
#define RW_ISSUE(cc) do { const bool isctx_ = (cc) < 8; _Pragma("unroll") for (int i_ = 0; i_ < 3; ++i_) { int pp = tid + i_ * NTHREADS; pp = pp < NPIECE ? pp : pp - NTHREADS; const int st = pp / 44, q = pp % 44; \
        const int s_ = (cc) * 32 + st, t_ = s_ - 256; const int row = isctx_ ? (ML + b * 256 + (dir ? 255 - s_ : s_)) : (b * 4096 + (dir ? 4095 - t_ : t_)); \
        const int arr = q >> 3; const int so = arr == 0 ? srcoff[0] : arr == 1 ? srcoff[1] : arr == 2 ? srcoff[2] : arr == 3 ? srcoff[3] : arr == 4 ? srcoff[4] : srcoff[5]; \
        pre[i_] = *(const u32x4*)(PREP + (size_t)row * PRC + so + (q & 7) * 8); } } while (0)
#define RW_COMMIT(cc) do { _Pragma("unroll") for (int i_ = 0; i_ < 3; ++i_) { const int pp = tid + i_ * NTHREADS; if (pp < NPIECE) { const int st = pp / 44, q = pp % 44; \
        *(LAS u32x4*)(lds + ((cc) & 1) * BUFB + st * STEPB + q * 16) = pre[i_]; } } } while (0)
    RW_ISSUE(0); RW_COMMIT(0); RW_ISSUE(1);
    __syncthreads();
    for (int c = 0; c < NCHUNK; ++c) {
        if (expflag != 2) { if (c + 1 < NCHUNK) RW_COMMIT(c + 1);
        if (c + 2 < NCHUNK) RW_ISSUE(c + 2); }
        if (c > 0 && tid < 128) { const int cc = c - 1; const int st = tid >> 2, pc = tid & 3; const int row = chain_row(b, dir, cc * 32 + st);
            *(u32x4*)(OR + (size_t)row * 256 + h * 64 + half_ * 32 + pc * 8) = *(const LAS u32x4*)(obuf + (cc & 1) * 2048 + st * 64 + pc * 16); }
        if (expflag != 1) {
            const unsigned abase = lds_addr(lds + (c & 1) * BUFB) + kq * 8, vbase = lds_addr(lds + (c & 1) * BUFB) + 640 + rloc * 2;
            LAS hf* op = (LAS hf*)(obuf + (c & 1) * 2048 + rloc * 2);
            u32x2 LR[2], LK[2], LW[2], LB[2], LD[2]; unsigned LV[2]; const float zero = 0.f;
#define RW_LOAD(slot, o0, o1, o2, o3, o4) do { DSR64(LR[slot], abase, o0); DSR64(LK[slot], abase, o1); DSR64(LW[slot], abase, o2); DSR64(LB[slot], abase, o3); DSR64(LD[slot], abase, o4); } while (0)
#define RW_COMPUTE(cur, st) do { \
                const float vv = (float)__builtin_bit_cast(hf, (unsigned short)LV[cur]); \
                float sa0 = 0.f, sa1 = 0.f; \
                _Pragma("unroll") for (int i = 0; i < 2; ++i) { MIXLO(sa0, S[2 * i], LK[cur][i], sa0); MIXHI(sa1, S[2 * i + 1], LK[cur][i], sa1); } \
                const float nsa = reduce16(sa0 + sa1); \
                float o0 = 0.f, o1 = 0.f; \
                _Pragma("unroll") for (int i = 0; i < 2; ++i) { float u0, u1; \
                    MIXLO(u0, vv, LD[cur][i], zero); MIXHI(u1, vv, LD[cur][i], zero); \
                    MIXLO(u0, nsa, LB[cur][i], u0); MIXHI(u1, nsa, LB[cur][i], u1); \
                    MIXLO(S[2 * i], S[2 * i], LW[cur][i], u0); MIXHI(S[2 * i + 1], S[2 * i + 1], LW[cur][i], u1); \
                    MIXLO(o0, S[2 * i], LR[cur][i], o0); MIXHI(o1, S[2 * i + 1], LR[cur][i], o1); } \
                const float o = reduce16(o0 + o1); \
                op[(st) * 32] = (hf)o; } while (0)
#define RW_PIN(n, cur) asm volatile("s_waitcnt lgkmcnt(" #n ")" : "+v"(LR[cur]), "+v"(LK[cur]), "+v"(LW[cur]), "+v"(LB[cur]), "+v"(LD[cur]), "+v"(LV[cur]))
            RW_LOAD(0, 0, 128, 256, 384, 512); DSR16(LV[0], vbase, 0);
            RW_LOAD(1, 704, 832, 960, 1088, 1216); DSR16(LV[1], vbase, 704); RW_PIN(6, 0); RW_COMPUTE(0, 0);
            RW_LOAD(0, 1408, 1536, 1664, 1792, 1920); DSR16(LV[0], vbase, 1408); RW_PIN(6, 1); RW_COMPUTE(1, 1);
            RW_LOAD(1, 2112, 2240, 2368, 2496, 2624); DSR16(LV[1], vbase, 2112); RW_PIN(6, 0); RW_COMPUTE(0, 2);
            RW_LOAD(0, 2816, 2944, 3072, 3200, 3328); DSR16(LV[0], vbase, 2816); RW_PIN(6, 1); RW_COMPUTE(1, 3);
            RW_LOAD(1, 3520, 3648, 3776, 3904, 4032); DSR16(LV[1], vbase, 3520); RW_PIN(6, 0); RW_COMPUTE(0, 4);
            RW_LOAD(0, 4224, 4352, 4480, 4608, 4736); DSR16(LV[0], vbase, 4224); RW_PIN(6, 1); RW_COMPUTE(1, 5);
            RW_LOAD(1, 4928, 5056, 5184, 5312, 5440); DSR16(LV[1], vbase, 4928); RW_PIN(6, 0); RW_COMPUTE(0, 6);
            RW_LOAD(0, 5632, 5760, 5888, 6016, 6144); DSR16(LV[0], vbase, 5632); RW_PIN(6, 1); RW_COMPUTE(1, 7);
            RW_LOAD(1, 6336, 6464, 6592, 6720, 6848); DSR16(LV[1], vbase, 6336); RW_PIN(6, 0); RW_COMPUTE(0, 8);
            RW_LOAD(0, 7040, 7168, 7296, 7424, 7552); DSR16(LV[0], vbase, 7040); RW_PIN(6, 1); RW_COMPUTE(1, 9);
            RW_LOAD(1, 7744, 7872, 8000, 8128, 8256); DSR16(LV[1], vbase, 7744); RW_PIN(6, 0); RW_COMPUTE(0, 10);
            RW_LOAD(0, 8448, 8576, 8704, 8832, 8960); DSR16(LV[0], vbase, 8448); RW_PIN(6, 1); RW_COMPUTE(1, 11);
            RW_LOAD(1, 9152, 9280, 9408, 9536, 9664); DSR16(LV[1], vbase, 9152); RW_PIN(6, 0); RW_COMPUTE(0, 12);
            RW_LOAD(0, 9856, 9984, 10112, 10240, 10368); DSR16(LV[0], vbase, 9856); RW_PIN(6, 1); RW_COMPUTE(1, 13);
            RW_LOAD(1, 10560, 10688, 10816, 10944, 11072); DSR16(LV[1], vbase, 10560); RW_PIN(6, 0); RW_COMPUTE(0, 14);
            RW_LOAD(0, 11264, 11392, 11520, 11648, 11776); DSR16(LV[0], vbase, 11264); RW_PIN(6, 1); RW_COMPUTE(1, 15);
            RW_LOAD(1, 11968, 12096, 12224, 12352, 12480); DSR16(LV[1], vbase, 11968); RW_PIN(6, 0); RW_COMPUTE(0, 16);
            RW_LOAD(0, 12672, 12800, 12928, 13056, 13184); DSR16(LV[0], vbase, 12672); RW_PIN(6, 1); RW_COMPUTE(1, 17);
            RW_LOAD(1, 13376, 13504, 13632, 13760, 13888); DSR16(LV[1], vbase, 13376); RW_PIN(6, 0); RW_COMPUTE(0, 18);
            RW_LOAD(0, 14080, 14208, 14336, 14464, 14592); DSR16(LV[0], vbase, 14080); RW_PIN(6, 1); RW_COMPUTE(1, 19);
            RW_LOAD(1, 14784, 14912, 15040, 15168, 15296); DSR16(LV[1], vbase, 14784); RW_PIN(6, 0); RW_COMPUTE(0, 20);
            RW_LOAD(0, 15488, 15616, 15744, 15872, 16000); DSR16(LV[0], vbase, 15488); RW_PIN(6, 1); RW_COMPUTE(1, 21);
            RW_LOAD(1, 16192, 16320, 16448, 16576, 16704); DSR16(LV[1], vbase, 16192); RW_PIN(6, 0); RW_COMPUTE(0, 22);
            RW_LOAD(0, 16896, 17024, 17152, 17280, 17408); DSR16(LV[0], vbase, 16896); RW_PIN(6, 1); RW_COMPUTE(1, 23);
            RW_LOAD(1, 17600, 17728, 17856, 17984, 18112); DSR16(LV[1], vbase, 17600); RW_PIN(6, 0); RW_COMPUTE(0, 24);
            RW_LOAD(0, 18304, 18432, 18560, 18688, 18816); DSR16(LV[0], vbase, 18304); RW_PIN(6, 1); RW_COMPUTE(1, 25);
            RW_LOAD(1, 19008, 19136, 19264, 19392, 19520); DSR16(LV[1], vbase, 19008); RW_PIN(6, 0); RW_COMPUTE(0, 26);
            RW_LOAD(0, 19712, 19840, 19968, 20096, 20224); DSR16(LV[0], vbase, 19712); RW_PIN(6, 1); RW_COMPUTE(1, 27);
            RW_LOAD(1, 20416, 20544, 20672, 20800, 20928); DSR16(LV[1], vbase, 20416); RW_PIN(6, 0); RW_COMPUTE(0, 28);
            RW_LOAD(0, 21120, 21248, 21376, 21504, 21632); DSR16(LV[0], vbase, 21120); RW_PIN(6, 1); RW_COMPUTE(1, 29);
            RW_LOAD(1, 21824, 21952, 22080, 22208, 22336); DSR16(LV[1], vbase, 21824); RW_PIN(6, 0); RW_COMPUTE(0, 30);
            RW_PIN(0, 1); RW_COMPUTE(1, 31);
#undef RW_LOAD
#undef RW_COMPUTE
#undef RW_PIN
        }
        LDS_BAR();
    }
    { const int cc = NCHUNK - 1; if (tid < 128) { const int st = tid >> 2, pc = tid & 3; const int row = chain_row(b, dir, cc * 32 + st);
        *(u32x4*)(OR + (size_t)row * 256 + h * 64 + half_ * 32 + pc * 8) = *(const LAS u32x4*)(obuf + (cc & 1) * 2048 + st * 64 + pc * 16); } }
#undef RW_ISSUE
#undef RW_COMMIT
}
__device__ __forceinline__ void gla_scan_item(unsigned char* ldsg, kparams_t p, int item, int tid) {
    const int chain = item >> 1, half_ = item & 1;
    LAS unsigned char* lds = (LAS unsigned char*)ldsg;
    constexpr int STEPB = 320, BUFB = 32 * STEPB, NPIECE = 32 * 20;
    LAS unsigned char* obuf = lds + 2 * BUFB;
    const int b = chain >> 3, h = (chain >> 1) & 3, dir = chain & 1;
    const int lane = tid & 63, wave = tid >> 6, dq = lane & 7, col = half_ * 32 + (wave & 3) * 8 + (lane >> 3);
    const hf* PG = (const hf*)(p->ws + WS_PG); const bf16_t* P1 = (const bf16_t*)(p->ws + WS_P1); hf* OG = (hf*)(p->ws + WS_OG) + (size_t)dir * MT * 256;
    float S[4];
#pragma unroll
    for (int i = 0; i < 4; ++i) S[i] = 0.f;
    u32x4 pre[3]; const int t4 = tid - 256;
#define GL_ISSUE(cc) do { const bool isctx_ = (cc) < 8; _Pragma("unroll") for (int i_ = 0; i_ < 3; ++i_) { int pp = t4 + i_ * 256; pp = pp < NPIECE ? pp : pp - 256; const int st = pp / 20, q = pp % 20; \
        const int s_ = (cc) * 32 + st, t_ = s_ - 256; const int row = isctx_ ? (ML + b * 256 + (dir ? 255 - s_ : s_)) : (b * 4096 + (dir ? 4095 - t_ : t_)); \
        const int arr = q >> 2; const int so = arr == 0 ? h * 32 : arr == 1 ? 128 + h * 32 : 256 + dir * 128 + h * 32; \
        const unsigned char* sp = q < 12 ? (const unsigned char*)(PG + (size_t)row * PGC + so + (q & 3) * 8) : (const unsigned char*)(P1 + (size_t)row * P1C + 256 + h * 64 + (q - 12) * 8); \
        pre[i_] = *(const u32x4*)sp; } } while (0)
#define GL_COMMIT(cc) do { _Pragma("unroll") for (int i_ = 0; i_ < 3; ++i_) { const int pp = t4 + i_ * 256; if (pp < NPIECE) { const int st = pp / 20, q = pp % 20; \
        *(LAS u32x4*)(lds + ((cc) & 1) * BUFB + st * STEPB + q * 16) = pre[i_]; } } } while (0)
    if (wave >= 4) { GL_ISSUE(0); GL_COMMIT(0); GL_ISSUE(1); }
    __syncthreads();
    for (int c = 0; c < NCHUNK; ++c) {
        if (wave >= 4) {
            if (c + 1 < NCHUNK) GL_COMMIT(c + 1);
            if (c + 2 < NCHUNK) GL_ISSUE(c + 2);
            if (c > 0 && t4 < 128) { const int cc = c - 1; const int st = t4 >> 2, pc = t4 & 3; const int row = chain_row(b, dir, cc * 32 + st);
                *(u32x4*)(OG + (size_t)row * 256 + h * 64 + half_ * 32 + pc * 8) = *(const LAS u32x4*)(obuf + (cc & 1) * 4096 + st * 128 + half_ * 64 + pc * 16); }
        }
        if (wave < 4) {
            const unsigned abase = lds_addr(lds + (c & 1) * BUFB) + dq * 8, vbase = lds_addr(lds + (c & 1) * BUFB) + 192 + col * 2;
            LAS hf* op = (LAS hf*)(obuf + (c & 1) * 4096 + col * 2);
            u32x2 LQ[2], LK[2], LE[2]; unsigned LV[2]; const float zero = 0.f;
#define GL_LOAD(slot, o0, o1, o2) do { DSR64(LQ[slot], abase, o0); DSR64(LK[slot], abase, o1); DSR64(LE[slot], abase, o2); } while (0)
#define GL_COMPUTE(cur, st) do { \
                const float vv = __uint_as_float(LV[cur] << 16); \
                float o0 = 0.f, o1 = 0.f; \
                _Pragma("unroll") for (int i = 0; i < 2; ++i) { float u0, u1; \
                    MIXLO(u0, vv, LK[cur][i], zero); MIXHI(u1, vv, LK[cur][i], zero); \
                    MIXLO(S[2 * i], S[2 * i], LE[cur][i], u0); MIXHI(S[2 * i + 1], S[2 * i + 1], LE[cur][i], u1); \
                    MIXLO(o0, S[2 * i], LQ[cur][i], o0); MIXHI(o1, S[2 * i + 1], LQ[cur][i], o1); } \
                const float o = reduce8(o0 + o1); \
                op[(st) * 64] = (hf)o; } while (0)
#define GL_PIN(n, cur) asm volatile("s_waitcnt lgkmcnt(" #n ")" : "+v"(LQ[cur]), "+v"(LK[cur]), "+v"(LE[cur]), "+v"(LV[cur]))
            GL_LOAD(0, 0, 64, 128); DSR16(LV[0], vbase, 0);
            GL_LOAD(1, 320, 384, 448); DSR16(LV[1], vbase, 320); GL_PIN(4, 0); GL_COMPUTE(0, 0);
            GL_LOAD(0, 640, 704, 768); DSR16(LV[0], vbase, 640); GL_PIN(4, 1); GL_COMPUTE(1, 1);
            GL_LOAD(1, 960, 1024, 1088); DSR16(LV[1], vbase, 960); GL_PIN(4, 0); GL_COMPUTE(0, 2);
            GL_LOAD(0, 1280, 1344, 1408); DSR16(LV[0], vbase, 1280); GL_PIN(4, 1); GL_COMPUTE(1, 3);
            GL_LOAD(1, 1600, 1664, 1728); DSR16(LV[1], vbase, 1600); GL_PIN(4, 0); GL_COMPUTE(0, 4);
            GL_LOAD(0, 1920, 1984, 2048); DSR16(LV[0], vbase, 1920); GL_PIN(4, 1); GL_COMPUTE(1, 5);
            GL_LOAD(1, 2240, 2304, 2368); DSR16(LV[1], vbase, 2240); GL_PIN(4, 0); GL_COMPUTE(0, 6);
            GL_LOAD(0, 2560, 2624, 2688); DSR16(LV[0], vbase, 2560); GL_PIN(4, 1); GL_COMPUTE(1, 7);
            GL_LOAD(1, 2880, 2944, 3008); DSR16(LV[1], vbase, 2880); GL_PIN(4, 0); GL_COMPUTE(0, 8);
            GL_LOAD(0, 3200, 3264, 3328); DSR16(LV[0], vbase, 3200); GL_PIN(4, 1); GL_COMPUTE(1, 9);
            GL_LOAD(1, 3520, 3584, 3648); DSR16(LV[1], vbase, 3520); GL_PIN(4, 0); GL_COMPUTE(0, 10);
            GL_LOAD(0, 3840, 3904, 3968); DSR16(LV[0], vbase, 3840); GL_PIN(4, 1); GL_COMPUTE(1, 11);
            GL_LOAD(1, 4160, 4224, 4288); DSR16(LV[1], vbase, 4160); GL_PIN(4, 0); GL_COMPUTE(0, 12);
            GL_LOAD(0, 4480, 4544, 4608); DSR16(LV[0], vbase, 4480); GL_PIN(4, 1); GL_COMPUTE(1, 13);
            GL_LOAD(1, 4800, 4864, 4928); DSR16(LV[1], vbase, 4800); GL_PIN(4, 0); GL_COMPUTE(0, 14);
            GL_LOAD(0, 5120, 5184, 5248); DSR16(LV[0], vbase, 5120); GL_PIN(4, 1); GL_COMPUTE(1, 15);
            GL_LOAD(1, 5440, 5504, 5568); DSR16(LV[1], vbase, 5440); GL_PIN(4, 0); GL_COMPUTE(0, 16);
            GL_LOAD(0, 5760, 5824, 5888); DSR16(LV[0], vbase, 5760); GL_PIN(4, 1); GL_COMPUTE(1, 17);
            GL_LOAD(1, 6080, 6144, 6208); DSR16(LV[1], vbase, 6080); GL_PIN(4, 0); GL_COMPUTE(0, 18);
            GL_LOAD(0, 6400, 6464, 6528); DSR16(LV[0], vbase, 6400); GL_PIN(4, 1); GL_COMPUTE(1, 19);
            GL_LOAD(1, 6720, 6784, 6848); DSR16(LV[1], vbase, 6720); GL_PIN(4, 0); GL_COMPUTE(0, 20);
            GL_LOAD(0, 7040, 7104, 7168); DSR16(LV[0], vbase, 7040); GL_PIN(4, 1); GL_COMPUTE(1, 21);
            GL_LOAD(1, 7360, 7424, 7488); DSR16(LV[1], vbase, 7360); GL_PIN(4, 0); GL_COMPUTE(0, 22);
            GL_LOAD(0, 7680, 7744, 7808); DSR16(LV[0], vbase, 7680); GL_PIN(4, 1); GL_COMPUTE(1, 23);
            GL_LOAD(1, 8000, 8064, 8128); DSR16(LV[1], vbase, 8000); GL_PIN(4, 0); GL_COMPUTE(0, 24);
            GL_LOAD(0, 8320, 8384, 8448); DSR16(LV[0], vbase, 8320); GL_PIN(4, 1); GL_COMPUTE(1, 25);
            GL_LOAD(1, 8640, 8704, 8768); DSR16(LV[1], vbase, 8640); GL_PIN(4, 0); GL_COMPUTE(0, 26);
            GL_LOAD(0, 8960, 9024, 9088); DSR16(LV[0], vbase, 8960); GL_PIN(4, 1); GL_COMPUTE(1, 27);
            GL_LOAD(1, 9280, 9344, 9408); DSR16(LV[1], vbase, 9280); GL_PIN(4, 0); GL_COMPUTE(0, 28);
            GL_LOAD(0, 9600, 9664, 9728); DSR16(LV[0], vbase, 9600); GL_PIN(4, 1); GL_COMPUTE(1, 29);
            GL_LOAD(1, 9920, 9984, 10048); DSR16(LV[1], vbase, 9920); GL_PIN(4, 0); GL_COMPUTE(0, 30);
            GL_PIN(0, 1); GL_COMPUTE(1, 31);
#undef GL_LOAD
#undef GL_COMPUTE
#undef GL_PIN
        }
        LDS_BAR();
    }
    if (t4 >= 0 && t4 < 128) { const int cc = NCHUNK - 1; const int st = t4 >> 2, pc = t4 & 3; const int row = chain_row(b, dir, cc * 32 + st);
        *(u32x4*)(OG + (size_t)row * 256 + h * 64 + half_ * 32 + pc * 8) = *(const LAS u32x4*)(obuf + (cc & 1) * 4096 + st * 128 + half_ * 64 + pc * 16); }
#undef GL_ISSUE
#undef GL_COMMIT
}
__device__ __forceinline__ bf16x8 mk_op(unsigned a, unsigned b, unsigned c, unsigned d) { const u32x4 t = {a, b, c, d}; return __builtin_bit_cast(bf16x8, t); }
__device__ __forceinline__ void ck_p1_step(const LAS unsigned char* in, LAS unsigned char* KKI, LAS unsigned char* BTI, LAS unsigned char* KDI, LAS unsigned char* RTI, LAS unsigned char* AUP, LAS unsigned char* VTI,
                                           int k, int t, float gprev, float gt, float gC) {
    const float inv = __builtin_amdgcn_rcpf(gt);
    const LAS unsigned char* sp = in + t * 768 + k * 2;
    const float r = (float)*(const LAS hf*)sp, kk = (float)*(const LAS hf*)(sp + 128), nb = (float)*(const LAS hf*)(sp + 384), kd = (float)*(const LAS hf*)(sp + 512), vv = (float)*(const LAS hf*)(sp + 640);
    const float nbi = nb * inv, kdi = kd * inv;
    const unsigned pa = cvtpk(kk * gprev, nbi), pb = cvtpk(kdi, r * gt), pc = cvtpk(nbi * gC, kdi * gC), pd = cvtpk(vv, vv);
    *(LAS unsigned short*)(KKI + t * 144 + k * 2) = (unsigned short)(pa & 0xffffu); *(LAS unsigned short*)(BTI + t * 144 + k * 2) = (unsigned short)(pa >> 16);
    *(LAS unsigned short*)(KDI + t * 144 + k * 2) = (unsigned short)(pb & 0xffffu); *(LAS unsigned short*)(RTI + t * 144 + k * 2) = (unsigned short)(pb >> 16);
    const int slot = (t >> 2) * 8 + (t & 3);
    *(LAS unsigned short*)(AUP + k * 80 + slot * 2) = (unsigned short)(pc & 0xffffu); *(LAS unsigned short*)(AUP + k * 80 + (slot + 4) * 2) = (unsigned short)(pc >> 16);
    *(LAS unsigned short*)(VTI + k * 32 + t * 2) = (unsigned short)(pd & 0xffffu);
}
__device__ __forceinline__ void rwkv_chunk_item(unsigned char* ldsg, kparams_t p, int chain, int tid, int expflag) {
    (void)expflag;
    LAS unsigned char* lds = (LAS unsigned char*)ldsg;
    constexpr int INB = 16 * 768, NPIECE = 16 * 48, NCH = (SEQ + CTXL) / 16, IMGB = 16640;
    LAS unsigned char* IMG0 = lds + 3 * INB;
    LAS unsigned char* SM0 = IMG0 + 3 * IMGB;
    LAS unsigned char* NI = SM0;
    LAS unsigned char* MMI = NI + 4096;
    LAS unsigned char* AOI = MMI + 512;
    LAS unsigned char* OBI = SM0 + 2 * 5632;
    const int b = chain >> 3, h = (chain >> 1) & 3, dir = chain & 1;
    const int lane = tid & 63, wave = __builtin_amdgcn_readfirstlane(tid >> 6), fr = lane & 15, quad = lane >> 4;
    const hf* PREP = (const hf*)(p->ws + WS_PREP); hf* OR = (hf*)(p->ws + WS_OR) + (size_t)dir * MT * 256;
    const int so0 = h * 64, so1 = 256 + h * 64, so2 = 768 + dir * 768 + h * 64, so5 = 512 + h * 64;
    u32x4 pre[2];
    const int pp0_ = tid, pp1_ = tid < 256 ? tid + 512 : tid;
    const int st0_ = pp0_ / 48, q0_ = pp0_ % 48, st1_ = pp1_ / 48, q1_ = pp1_ % 48;
    const int ar0_ = q0_ >> 3, ar1_ = q1_ >> 3;
    const int sof0_ = (ar0_ == 0 ? so0 : ar0_ == 1 ? so1 : ar0_ == 2 ? so2 : ar0_ == 3 ? so2 + 256 : ar0_ == 4 ? so2 + 512 : so5) + (q0_ & 7) * 8;
    const int sof1_ = (ar1_ == 0 ? so0 : ar1_ == 1 ? so1 : ar1_ == 2 ? so2 : ar1_ == 3 ? so2 + 256 : ar1_ == 4 ? so2 + 512 : so5) + (q1_ & 7) * 8;
    const hf* pl0_ = PREP + (size_t)(b * 4096 + (dir ? 4095 - st0_ : st0_)) * PRC + sof0_;
    const hf* pl1_ = PREP + (size_t)(b * 4096 + (dir ? 4095 - st1_ : st1_)) * PRC + sof1_;
    const hf* cur0_ = PREP + (size_t)(ML + b * 256 + (dir ? 255 - st0_ : st0_)) * PRC + sof0_;
    const hf* cur1_ = PREP + (size_t)(ML + b * 256 + (dir ? 255 - st1_ : st1_)) * PRC + sof1_;
    const ptrdiff_t stepH_ = (ptrdiff_t)(dir ? -16 : 16) * PRC;
    const int lo0_ = st0_ * 768 + q0_ * 16, lo1_ = st1_ * 768 + q1_ * 16;
    int icc_ = 0, cbuf_ = 0, wcc_ = 0;
    const int wst_ = (tid & 127) >> 3, wpc_ = tid & 7;
    hf* wcur_ = OR + (size_t)(ML + b * 256 + (dir ? 255 - wst_ : wst_)) * 256 + h * 64 + wpc_ * 8;
    hf* wlat_ = OR + (size_t)(b * 4096 + (dir ? 4095 - wst_ : wst_)) * 256 + h * 64 + wpc_ * 8;
    const ptrdiff_t wstep_ = (ptrdiff_t)(dir ? -16 : 16) * 256;
#define CK_ISSUE(cc) do { if (icc_ == 16) { cur0_ = pl0_; cur1_ = pl1_; } pre[0] = *(const u32x4*)cur0_; pre[1] = *(const u32x4*)cur1_; cur0_ += stepH_; cur1_ += stepH_; ++icc_; } while (0)
#define CK_COMMIT(cc) do { *(LAS u32x4*)(lds + cbuf_ + lo0_) = pre[0]; if (tid < 256) *(LAS u32x4*)(lds + cbuf_ + lo1_) = pre[1]; cbuf_ = (cbuf_ == 2 * INB) ? 0 : cbuf_ + INB; } while (0)
#define CK_WRITEOUT(cc) do { if (wcc_ == 16) wcur_ = wlat_; if (tid < 128) *(u32x4*)wcur_ = *(const LAS u32x4*)(OBI + ((cc) & 1) * 2048 + wst_ * 128 + wpc_ * 16); wcur_ += wstep_; ++wcc_; } while (0)
    float gq0 = 1.f, gq1 = 1.f, gq2 = 1.f, gq3 = 1.f, gq4 = 1.f, gqC = 1.f;
#define CK_P1A(cc) do { const LAS unsigned char* in_ = lds + ((cc) % 3) * INB; LAS unsigned char* im_ = IMG0 + ((cc) % 3) * IMGB; const int wv_ = wave - 4, tb_ = wv_ * 4; \
        float w_[16]; _Pragma("unroll") for (int i_ = 0; i_ < 16; ++i_) w_[i_] = (float)*(const LAS hf*)(in_ + i_ * 768 + 256 + lane * 2); \
        const float G0_ = (w_[0] * w_[1]) * (w_[2] * w_[3]), G1_ = (w_[4] * w_[5]) * (w_[6] * w_[7]), G2_ = (w_[8] * w_[9]) * (w_[10] * w_[11]), G3_ = (w_[12] * w_[13]) * (w_[14] * w_[15]); \
        const float pfx_ = (wv_ > 0 ? G0_ : 1.f) * ((wv_ > 1 ? G1_ : 1.f) * (wv_ > 2 ? G2_ : 1.f)); \
        const float sfx_ = (wv_ < 3 ? G3_ : 1.f) * ((wv_ < 2 ? G2_ : 1.f) * (wv_ < 1 ? G1_ : 1.f)); \
        const LAS unsigned char* ow_ = in_ + tb_ * 768 + 256 + lane * 2; \
        const float o0_ = (float)*(const LAS hf*)ow_, o1_ = (float)*(const LAS hf*)(ow_ + 768), o2_ = (float)*(const LAS hf*)(ow_ + 1536), o3_ = (float)*(const LAS hf*)(ow_ + 2304); \
        gq0 = pfx_; gq1 = gq0 * o0_; gq2 = gq1 * o1_; gq3 = gq2 * o2_; gq4 = gq3 * o3_; gqC = gq4 * sfx_; \
        if (wave == 4) *(LAS float*)(im_ + 14336 + lane * 4) = gqC; \
        ck_p1_step(in_, im_, im_ + 2304, im_ + 4608, im_ + 6912, im_ + 9216, im_ + 14592, lane, tb_, gq0, gq1, gqC); \
        ck_p1_step(in_, im_, im_ + 2304, im_ + 4608, im_ + 6912, im_ + 9216, im_ + 14592, lane, tb_ + 1, gq1, gq2, gqC);  } while (0)
#define CK_P1B(cc) do { const LAS unsigned char* in_ = lds + ((cc) % 3) * INB; LAS unsigned char* im_ = IMG0 + ((cc) % 3) * IMGB; const int tb_ = (wave - 4) * 4; \
        ck_p1_step(in_, im_, im_ + 2304, im_ + 4608, im_ + 6912, im_ + 9216, im_ + 14592, lane, tb_ + 2, gq2, gq3, gqC); \
        ck_p1_step(in_, im_, im_ + 2304, im_ + 4608, im_ + 6912, im_ + 9216, im_ + 14592, lane, tb_ + 3, gq3, gq4, gqC); } while (0)
    f32x4 St[4];
#pragma unroll
    for (int i = 0; i < 4; ++i) St[i] = (f32x4){0.f, 0.f, 0.f, 0.f};
    CK_ISSUE(0); CK_COMMIT(0); CK_ISSUE(1); CK_COMMIT(1); CK_ISSUE(2); CK_COMMIT(2); CK_ISSUE(3);
    __syncthreads();
    if (wave >= 4) { CK_P1A(0); CK_P1B(0); CK_P1A(1); CK_P1B(1); }
    LDS_BAR();
    {   const int c = -1;
        LAS unsigned char* im = IMG0 + ((c + 1) % 3) * IMGB;
        LAS unsigned char* KKI = im; LAS unsigned char* BTI = im + 2304; LAS unsigned char* KDI = im + 4608; LAS unsigned char* RTI = im + 6912;
        LAS unsigned char* NI = SM0 + ((c + 1) & 1) * 5632; LAS unsigned char* MMI = NI + 4096; LAS unsigned char* AOI = MMI + 512;
        (void)NI; (void)MMI; (void)AOI;
        f32x4 accN = (f32x4){0.f, 0.f, 0.f, 0.f}, accNT = (f32x4){0.f, 0.f, 0.f, 0.f};
        if (wave < 4) {
            const LAS unsigned char* X = (wave < 2) ? KKI : RTI; const LAS unsigned char* Y = (wave & 1) ? KDI : BTI;
            f32x4 acc = (f32x4){0.f, 0.f, 0.f, 0.f};
#pragma unroll
            for (int ks = 0; ks < 2; ++ks) { const bf16x8 a = *(const LAS bf16x8*)(X + fr * 144 + (ks * 32 + quad * 8) * 2), bb = *(const LAS bf16x8*)(Y + fr * 144 + (ks * 32 + quad * 8) * 2);
                acc = __builtin_amdgcn_mfma_f32_16x16x32_bf16(a, bb, acc, 0, 0, 0);
                if (wave == 0) accNT = __builtin_amdgcn_mfma_f32_16x16x32_bf16(bb, a, accNT, 0, 0, 0); }
            accN = acc;
#pragma unroll
            for (int j = 0; j < 4; ++j) { const int t = quad * 4 + j, i = fr;
                if (wave == 0) { }
                else if (wave == 1) *(LAS unsigned short*)(MMI + (t * 16 + i) * 2) = (unsigned short)f2bf((i < t) ? acc[j] : 0.f);
                else { const int slot = (i >> 2) * 8 + (i & 3) + (wave == 3 ? 4 : 0); *(LAS unsigned short*)(AOI + (t * 32 + slot) * 2) = (unsigned short)f2bf((i <= t) ? acc[j] : 0.f); } }
        }
        if (wave == 0) {
            f32x4 nv, nT;
#pragma unroll
            for (int j = 0; j < 4; ++j) { nv[j] = (fr < quad * 4 + j) ? accN[j] : 0.f;
                                          nT[j] = (quad * 4 + j < fr) ? accNT[j] : 0.f; }
#pragma unroll
            for (int lv = 0; lv < 4; ++lv) {
                const unsigned n01 = cvtpk(nv[0], nv[1]), n23 = cvtpk(nv[2], nv[3]), t01 = cvtpk(nT[0], nT[1]), t23 = cvtpk(nT[2], nT[3]);
                const u32x2 rowv = {t01, t23};
                *(LAS u32x2*)(NI + lv * 1024 + (fr * 16 + quad * 4) * 2) = rowv;
                if (lv < 3) {
                    const f32x4 zf = {0.f, 0.f, 0.f, 0.f};
                    const bf16x8 opN = mk_op(n01, n23, 0u, 0u), opT = mk_op(t01, t23, 0u, 0u);
                    nv = __builtin_amdgcn_mfma_f32_16x16x32_bf16(opT, opN, zf, 0, 0, 0);
                    nT = __builtin_amdgcn_mfma_f32_16x16x32_bf16(opN, opT, zf, 0, 0, 0);
                }
            }
        }
    }
    LDS_BAR();
#pragma unroll 1
    for (int c = 0; c < NCH; ++c) {
        if (c + 3 < NCH) CK_COMMIT(c + 3);
        if (c + 4 < NCH) CK_ISSUE(c + 4);
        if (c > 0) CK_WRITEOUT(c - 1);
        if (wave >= 4) { if (c + 2 < NCH) { CK_P1A(c + 2); CK_P1B(c + 2); } }
        {
            LAS unsigned char* im = IMG0 + (c % 3) * IMGB;
            LAS unsigned char* KKI = im; LAS unsigned char* RTI = im + 6912; LAS unsigned char* AUP = im + 9216;
            LAS float* GC = (LAS float*)(im + 14336); LAS unsigned char* VTI = im + 14592;
            LAS unsigned char* NI = SM0 + (c & 1) * 5632; LAS unsigned char* MMI = NI + 4096; LAS unsigned char* AOI = MMI + 512;
        if (wave < 4) {
            const int vrow = wave * 16 + fr;
            bf16x8 Sb[2], KKa[2], RTa[2];
#pragma unroll
            for (int p2 = 0; p2 < 2; ++p2) {
                Sb[p2] = mk_op(cvtpk(St[2 * p2][0], St[2 * p2][1]), cvtpk(St[2 * p2][2], St[2 * p2][3]), cvtpk(St[2 * p2 + 1][0], St[2 * p2 + 1][1]), cvtpk(St[2 * p2 + 1][2], St[2 * p2 + 1][3]));
                const u32x2 a0 = *(const LAS u32x2*)(KKI + fr * 144 + ((2 * p2) * 16 + quad * 4) * 2), a1 = *(const LAS u32x2*)(KKI + fr * 144 + ((2 * p2 + 1) * 16 + quad * 4) * 2);
                KKa[p2] = mk_op(a0.x, a0.y, a1.x, a1.y);
                const u32x2 r0 = *(const LAS u32x2*)(RTI + fr * 144 + ((2 * p2) * 16 + quad * 4) * 2), r1 = *(const LAS u32x2*)(RTI + fr * 144 + ((2 * p2 + 1) * 16 + quad * 4) * 2);
                RTa[p2] = mk_op(r0.x, r0.y, r1.x, r1.y);
            }
            const f32x4 zf = {0.f, 0.f, 0.f, 0.f};
            f32x4 rhs = __builtin_amdgcn_mfma_f32_16x16x32_bf16(KKa[0], Sb[0], zf, 0, 0, 0); rhs = __builtin_amdgcn_mfma_f32_16x16x32_bf16(KKa[1], Sb[1], rhs, 0, 0, 0);
            const u32x2 vt = *(const LAS u32x2*)(VTI + vrow * 32 + quad * 8), mm = *(const LAS u32x2*)(MMI + fr * 32 + quad * 8);
            rhs = __builtin_amdgcn_mfma_f32_16x16x32_bf16(mk_op(mm.x, mm.y, 0u, 0u), mk_op(vt.x, vt.y, 0u, 0u), rhs, 0, 0, 0);
            f32x4 ut = rhs;
#pragma unroll
            for (int lv = 3; lv >= 0; --lv) { const u32x2 na = *(const LAS u32x2*)(NI + lv * 1024 + (fr * 16 + quad * 4) * 2);
                ut = __builtin_amdgcn_mfma_f32_16x16x32_bf16(mk_op(na.x, na.y, 0u, 0u), mk_op(cvtpk(ut[0], ut[1]), cvtpk(ut[2], ut[3]), 0u, 0u), ut, 0, 0, 0); }
            const bf16x8 UVb = mk_op(cvtpk(ut[0], ut[1]), cvtpk(ut[2], ut[3]), vt.x, vt.y);
            f32x4 ot = __builtin_amdgcn_mfma_f32_16x16x32_bf16(RTa[0], Sb[0], zf, 0, 0, 0); ot = __builtin_amdgcn_mfma_f32_16x16x32_bf16(RTa[1], Sb[1], ot, 0, 0, 0);
            ot = __builtin_amdgcn_mfma_f32_16x16x32_bf16(*(const LAS bf16x8*)(AOI + fr * 64 + quad * 16), UVb, ot, 0, 0, 0);
#pragma unroll
            for (int j = 0; j < 4; ++j) *(LAS hf*)(OBI + (c & 1) * 2048 + ((quad * 4 + j) * 64 + vrow) * 2) = (hf)ot[j];
#pragma unroll
            for (int kt = 0; kt < 4; ++kt) { const f32x4 gc = *(const LAS f32x4*)(GC + kt * 16 + quad * 4);
                St[kt] = __builtin_amdgcn_mfma_f32_16x16x32_bf16(*(const LAS bf16x8*)(AUP + (kt * 16 + fr) * 80 + quad * 16), UVb, St[kt] * gc, 0, 0, 0); }
        }
        }
        if (c + 1 < NCH) {
            LAS unsigned char* im = IMG0 + ((c + 1) % 3) * IMGB;
            LAS unsigned char* KKI = im; LAS unsigned char* BTI = im + 2304; LAS unsigned char* KDI = im + 4608; LAS unsigned char* RTI = im + 6912;
            LAS unsigned char* NI = SM0 + ((c + 1) & 1) * 5632; LAS unsigned char* MMI = NI + 4096; LAS unsigned char* AOI = MMI + 512;
            (void)NI; (void)MMI; (void)AOI;
        f32x4 accN = (f32x4){0.f, 0.f, 0.f, 0.f}, accNT = (f32x4){0.f, 0.f, 0.f, 0.f};
        if (wave < 4) {
            const LAS unsigned char* X = (wave < 2) ? KKI : RTI; const LAS unsigned char* Y = (wave & 1) ? KDI : BTI;
            f32x4 acc = (f32x4){0.f, 0.f, 0.f, 0.f};
#pragma unroll
            for (int ks = 0; ks < 2; ++ks) { const bf16x8 a = *(const LAS bf16x8*)(X + fr * 144 + (ks * 32 + quad * 8) * 2), bb = *(const LAS bf16x8*)(Y + fr * 144 + (ks * 32 + quad * 8) * 2);
                acc = __builtin_amdgcn_mfma_f32_16x16x32_bf16(a, bb, acc, 0, 0, 0);
                if (wave == 0) accNT = __builtin_amdgcn_mfma_f32_16x16x32_bf16(bb, a, accNT, 0, 0, 0); }
            accN = acc;
#pragma unroll
            for (int j = 0; j < 4; ++j) { const int t = quad * 4 + j, i = fr;
                if (wave == 0) { }
                else if (wave == 1) *(LAS unsigned short*)(MMI + (t * 16 + i) * 2) = (unsigned short)f2bf((i < t) ? acc[j] : 0.f);
                else { const int slot = (i >> 2) * 8 + (i & 3) + (wave == 3 ? 4 : 0); *(LAS unsigned short*)(AOI + (t * 32 + slot) * 2) = (unsigned short)f2bf((i <= t) ? acc[j] : 0.f); } }
        }
        if (wave == 0) {
            f32x4 nv, nT;
#pragma unroll
            for (int j = 0; j < 4; ++j) { nv[j] = (fr < quad * 4 + j) ? accN[j] : 0.f;
                                          nT[j] = (quad * 4 + j < fr) ? accNT[j] : 0.f; }
#pragma unroll
            for (int lv = 0; lv < 4; ++lv) {
                const unsigned n01 = cvtpk(nv[0], nv[1]), n23 = cvtpk(nv[2], nv[3]), t01 = cvtpk(nT[0], nT[1]), t23 = cvtpk(nT[2], nT[3]);
                const u32x2 rowv = {t01, t23};
                *(LAS u32x2*)(NI + lv * 1024 + (fr * 16 + quad * 4) * 2) = rowv;
                if (lv < 3) {
                    const f32x4 zf = {0.f, 0.f, 0.f, 0.f};
                    const bf16x8 opN = mk_op(n01, n23, 0u, 0u), opT = mk_op(t01, t23, 0u, 0u);
                    nv = __builtin_amdgcn_mfma_f32_16x16x32_bf16(opT, opN, zf, 0, 0, 0);
                    nT = __builtin_amdgcn_mfma_f32_16x16x32_bf16(opN, opT, zf, 0, 0, 0);
                }
            }
        }
        }
        LDS_BAR();
    }
    CK_WRITEOUT(NCH - 1);
#undef CK_ISSUE
#undef CK_COMMIT
#undef CK_WRITEOUT
#undef CK_P1A
#undef CK_P1B
}
__device__ __forceinline__ void gla_chunk_item(unsigned char* ldsg, kparams_t p, int chain, int tid) {
    LAS unsigned char* lds = (LAS unsigned char*)ldsg;
    constexpr int INB = 16 * 320, NCH = (SEQ + CTXL) / 16, IMGB = 6400;
    LAS unsigned char* IMG0 = lds + 3 * INB;
    LAS unsigned char* QKI = IMG0 + 2 * IMGB;
    LAS unsigned char* OBI = QKI + 512;
    const int b = chain >> 3, h = (chain >> 1) & 3, dir = chain & 1;
    const int lane = tid & 63, wave = __builtin_amdgcn_readfirstlane(tid >> 6), fr = lane & 15, quad = lane >> 4;
    const hf* PG = (const hf*)(p->ws + WS_PG); const bf16_t* P1 = (const bf16_t*)(p->ws + WS_P1); hf* OG = (hf*)(p->ws + WS_OG) + (size_t)dir * MT * 256;
    const int pp_ = tid < 320 ? tid : 0, st_ = pp_ / 20, q_ = pp_ % 20;
    const size_t crow_ = (size_t)(ML + b * 256 + (dir ? 255 - st_ : st_)), lrow_ = (size_t)(b * 4096 + (dir ? 4095 - st_ : st_));
    const int ar_ = q_ >> 2, sog_ = (ar_ == 0 ? h * 32 : ar_ == 1 ? 128 + h * 32 : 256 + dir * 128 + h * 32) + (q_ & 3) * 8;
    const unsigned char* cur_ = q_ < 12 ? (const unsigned char*)(PG + crow_ * PGC + sog_) : (const unsigned char*)(P1 + crow_ * P1C + 256 + h * 64 + (q_ - 12) * 8);
    const unsigned char* lat_ = q_ < 12 ? (const unsigned char*)(PG + lrow_ * PGC + sog_) : (const unsigned char*)(P1 + lrow_ * P1C + 256 + h * 64 + (q_ - 12) * 8);
    const ptrdiff_t stepB_ = (ptrdiff_t)(dir ? -16 : 16) * (q_ < 12 ? PGC * 2 : P1C * 2);
    const int lo_ = st_ * 320 + q_ * 16;
    int icc_ = 0, cbuf_ = 0, wcc_ = 0;
    const int wst_ = (tid & 127) >> 3, wpc_ = tid & 7;
    hf* wcur_ = OG + (size_t)(ML + b * 256 + (dir ? 255 - wst_ : wst_)) * 256 + h * 64 + wpc_ * 8;
    hf* wlat_ = OG + (size_t)(b * 4096 + (dir ? 4095 - wst_ : wst_)) * 256 + h * 64 + wpc_ * 8;
    const ptrdiff_t wstep_ = (ptrdiff_t)(dir ? -16 : 16) * 256;
    u32x4 pre;
#define GK_ISSUE() do { if (icc_ == 16) cur_ = lat_; pre = *(const u32x4*)cur_; cur_ += stepB_; ++icc_; } while (0)
#define GK_COMMIT() do { if (tid < 320) *(LAS u32x4*)(lds + cbuf_ + lo_) = pre; cbuf_ = (cbuf_ == 2 * INB) ? 0 : cbuf_ + INB; } while (0)
#define GK_WRITEOUT(cc) do { if (wcc_ == 16) wcur_ = wlat_; if (tid < 128) *(u32x4*)wcur_ = *(const LAS u32x4*)(OBI + ((cc) & 1) * 2048 + wst_ * 128 + wpc_ * 16); wcur_ += wstep_; ++wcc_; } while (0)
#define GK_P1(cc) do { const LAS unsigned char* in_ = lds + ((cc) % 3) * INB; LAS unsigned char* im_ = IMG0 + ((cc) & 1) * IMGB; \
        const int k_ = lane & 31, go_ = (wave - 4) * 2 + (lane >> 5), t0_ = go_ * 2; \
        float e_[16]; _Pragma("unroll") for (int i_ = 0; i_ < 16; ++i_) e_[i_] = (float)*(const LAS hf*)(in_ + i_ * 320 + 128 + k_ * 2); \
        float pfx_ = 1.f, sfx_ = 1.f; _Pragma("unroll") for (int g_ = 0; g_ < 8; ++g_) { const float H_ = e_[2 * g_] * e_[2 * g_ + 1]; pfx_ *= (g_ < go_) ? H_ : 1.f; sfx_ *= (g_ > go_) ? H_ : 1.f; } \
        const float ea_ = (float)*(const LAS hf*)(in_ + t0_ * 320 + 128 + k_ * 2), eb_ = (float)*(const LAS hf*)(in_ + (t0_ + 1) * 320 + 128 + k_ * 2); \
        const float ga_ = pfx_ * ea_, gb_ = ga_ * eb_, gC_ = gb_ * sfx_; \
        if (go_ == 0) *(LAS float*)(im_ + 3584 + k_ * 4) = gC_; \
        _Pragma("unroll") for (int e2_ = 0; e2_ < 2; ++e2_) { const int t_ = t0_ + e2_; const float gt_ = e2_ == 0 ? ga_ : gb_; const float inv_ = __builtin_amdgcn_rcpf(gt_); \
            const float qv_ = (float)*(const LAS hf*)(in_ + t_ * 320 + k_ * 2), kv_ = (float)*(const LAS hf*)(in_ + t_ * 320 + 64 + k_ * 2); \
            const unsigned pa_ = cvtpk(qv_ * gt_, kv_ * inv_), pb_ = cvtpk(kv_ * inv_ * gC_, 0.f); \
            *(LAS unsigned short*)(im_ + t_ * 80 + k_ * 2) = (unsigned short)(pa_ & 0xffffu); *(LAS unsigned short*)(im_ + 1280 + t_ * 80 + k_ * 2) = (unsigned short)(pa_ >> 16); \
            *(LAS unsigned short*)(im_ + 2560 + k_ * 32 + t_ * 2) = (unsigned short)(pb_ & 0xffffu); \
              \
            *(LAS unsigned short*)(im_ + 3712 + k_ * 32 + t_ * 2) = *(const LAS unsigned short*)(in_ + t_ * 320 + 192 + k_ * 2); \
            *(LAS unsigned short*)(im_ + 3712 + (k_ + 32) * 32 + t_ * 2) = *(const LAS unsigned short*)(in_ + t_ * 320 + 192 + (k_ + 32) * 2); } } while (0)
    f32x4 St[2];
    St[0] = (f32x4){0.f, 0.f, 0.f, 0.f}; St[1] = St[0];
    GK_ISSUE(); GK_COMMIT(); GK_ISSUE(); GK_COMMIT(); GK_ISSUE();
    __syncthreads();
    if (wave >= 4) GK_P1(0);
    LDS_BAR();
#pragma unroll 1
    for (int c = 0; c < NCH; ++c) {
        LAS unsigned char* im = IMG0 + (c & 1) * IMGB;
        const LAS unsigned char* QI = im; const LAS unsigned char* KI = im + 1280; const LAS unsigned char* AUPG = im + 2560; const LAS float* GC = (const LAS float*)(im + 3584); const LAS unsigned char* VTI = im + 3712;
        if (c + 2 < NCH) GK_COMMIT();
        if (c + 3 < NCH) GK_ISSUE();
        if (c > 0) GK_WRITEOUT(c - 1);
        if (wave >= 4) { if (c + 1 < NCH) GK_P1(c + 1); }
        if (wave == 0) {
            const bf16x8 a = *(const LAS bf16x8*)(QI + fr * 80 + quad * 16), bb = *(const LAS bf16x8*)(KI + fr * 80 + quad * 16);
            const f32x4 zf = {0.f, 0.f, 0.f, 0.f};
            const f32x4 acc = __builtin_amdgcn_mfma_f32_16x16x32_bf16(a, bb, zf, 0, 0, 0);
            const unsigned p01 = cvtpk((fr <= quad * 4 + 0) ? acc[0] : 0.f, (fr <= quad * 4 + 1) ? acc[1] : 0.f), p23 = cvtpk((fr <= quad * 4 + 2) ? acc[2] : 0.f, (fr <= quad * 4 + 3) ? acc[3] : 0.f);
            *(LAS unsigned short*)(QKI + ((quad * 4 + 0) * 16 + fr) * 2) = (unsigned short)(p01 & 0xffffu); *(LAS unsigned short*)(QKI + ((quad * 4 + 1) * 16 + fr) * 2) = (unsigned short)(p01 >> 16);
            *(LAS unsigned short*)(QKI + ((quad * 4 + 2) * 16 + fr) * 2) = (unsigned short)(p23 & 0xffffu); *(LAS unsigned short*)(QKI + ((quad * 4 + 3) * 16 + fr) * 2) = (unsigned short)(p23 >> 16);
        }
        LDS_BAR();
        if (wave < 4) {
            const int vrow = wave * 16 + fr;
            const bf16x8 Sb = mk_op(cvtpk(St[0][0], St[0][1]), cvtpk(St[0][2], St[0][3]), cvtpk(St[1][0], St[1][1]), cvtpk(St[1][2], St[1][3]));
            const u32x2 q0 = *(const LAS u32x2*)(QI + fr * 80 + (quad * 4) * 2), q1 = *(const LAS u32x2*)(QI + fr * 80 + (16 + quad * 4) * 2);
            const u32x2 vt = *(const LAS u32x2*)(VTI + vrow * 32 + quad * 8), qk = *(const LAS u32x2*)(QKI + fr * 32 + quad * 8);
            const bf16x8 Vb = mk_op(vt.x, vt.y, 0u, 0u);
            const f32x4 zf = {0.f, 0.f, 0.f, 0.f};
            f32x4 ot = __builtin_amdgcn_mfma_f32_16x16x32_bf16(mk_op(q0.x, q0.y, q1.x, q1.y), Sb, zf, 0, 0, 0);
            ot = __builtin_amdgcn_mfma_f32_16x16x32_bf16(mk_op(qk.x, qk.y, 0u, 0u), Vb, ot, 0, 0, 0);
#pragma unroll
            for (int j = 0; j < 4; ++j) *(LAS hf*)(OBI + (c & 1) * 2048 + ((quad * 4 + j) * 64 + vrow) * 2) = (hf)ot[j];
#pragma unroll
            for (int kt = 0; kt < 2; ++kt) { const f32x4 gc = *(const LAS f32x4*)(GC + kt * 16 + quad * 4); const u32x2 au = *(const LAS u32x2*)(AUPG + (kt * 16 + fr) * 32 + quad * 8);
                St[kt] = __builtin_amdgcn_mfma_f32_16x16x32_bf16(mk_op(au.x, au.y, 0u, 0u), Vb, St[kt] * gc, 0, 0, 0); }
        }
        LDS_BAR();
    }
    GK_WRITEOUT(NCH - 1);
#undef GK_ISSUE
#undef GK_COMMIT
#undef GK_WRITEOUT
#undef GK_P1
}
__device__ __forceinline__ void swa_item(unsigned char* ldsg, kparams_t p, int l, int item, int tid) {
    LAS unsigned char* lds = (LAS unsigned char*)ldsg;
    const int lane = tid & 63, wave = tid >> 6, fr = lane & 15, quad = lane >> 4;
    const bf16_t* P1 = (const bf16_t*)(p->ws + WS_P1); bf16_t* MIX = (bf16_t*)(p->ws + WS_XN);
    const bool lat = item < 512;
    int b, n, kvh;
    if (lat) { b = item >> 6; n = (item >> 1) & 31; kvh = item & 1; } else { const int r = item - 512; b = r >> 2; n = (r >> 1) & 1; kvh = r & 1; }
    const int qrow = (lat ? b * 4096 : ML + b * 256) + n * 128 + wave * 16 + fr;
    const int qpos = n * 128 + wave * 16 + fr;
#pragma unroll 1
    for (int hp = 0; hp < 2; ++hp) {
    const int hbase = kvh * 4 + hp * 2;
    bf16x8 qf[2][2];
#pragma unroll
    for (int g = 0; g < 2; ++g)
#pragma unroll
        for (int ks = 0; ks < 2; ++ks) qf[g][ks] = *(const bf16x8*)(P1 + (size_t)qrow * P1C + 800 + (hbase + g) * 64 + ks * 32 + quad * 8);
    f32x4 oacc[2][4]; float mrun[2], lrun[2];
#pragma unroll
    for (int g = 0; g < 2; ++g) { mrun[g] = -1e30f; lrun[g] = 0.f;
#pragma unroll
        for (int dt = 0; dt < 4; ++dt) oacc[g][dt] = (f32x4){0.f, 0.f, 0.f, 0.f}; }
    const int jlo = lat ? (n == 0 ? 2 : 0) : 0, jhi = lat ? (n == 31 ? 4 : 6) : 0, T = 4 + (jhi - jlo);
    const int key_ = tid >> 3, ch_ = tid & 7;
#define SWA_SRC(t) (P1 + (size_t)(((t) < 4 ? ML + b * 256 + (t) * 64 : b * 4096 + (n - 1) * 128 + (jlo + (t) - 4) * 64) + key_) * P1C + 1312 + kvh * 64 + ch_ * 8)
#define SWA_STORE(bf) do { LAS unsigned char* Ks_ = lds + (bf) * 18432; LAS unsigned char* Vt_ = Ks_ + 9216; *(LAS u32x4*)(Ks_ + key_ * 144 + ch_ * 16) = pk_; \
        _Pragma("unroll") for (int e = 0; e < 4; ++e) { *(LAS unsigned short*)(Vt_ + (ch_ * 8 + 2 * e) * 144 + key_ * 2) = (unsigned short)(pv_[e] & 0xffffu); *(LAS unsigned short*)(Vt_ + (ch_ * 8 + 2 * e + 1) * 144 + key_ * 2) = (unsigned short)(pv_[e] >> 16); } } while (0)
    u32x4 pk_, pv_;
    { const bf16_t* src = SWA_SRC(0); pk_ = *(const u32x4*)src; pv_ = *(const u32x4*)(src + 128); }
    SWA_STORE(0);
    __syncthreads();
    for (int tile = 0; tile < T; ++tile) {
        if (tile + 1 < T) { const bf16_t* src = SWA_SRC(tile + 1); pk_ = *(const u32x4*)src; pv_ = *(const u32x4*)(src + 128); }
        const bool local = tile >= 4; const int kpos0 = local ? (n - 1) * 128 + (jlo + tile - 4) * 64 : 0;
        const LAS unsigned char* Ks = lds + (tile & 1) * 18432; const LAS unsigned char* Vt = Ks + 9216;
#pragma unroll
        for (int g = 0; g < 2; ++g) {
            asm volatile("" ::: "memory");
            bf16x8 kf[4][2], vf[4][2];
#pragma unroll
        for (int st = 0; st < 4; ++st)
#pragma unroll
            for (int ks = 0; ks < 2; ++ks) kf[st][ks] = *(const LAS bf16x8*)(Ks + (st * 16 + fr) * 144 + ks * 64 + quad * 16);
#pragma unroll
        for (int dt = 0; dt < 4; ++dt)
#pragma unroll
            for (int kp = 0; kp < 2; ++kp) { const u32x2 lo = *(const LAS u32x2*)(Vt + (dt * 16 + fr) * 144 + ((2 * kp) * 16 + quad * 4) * 2), hi = *(const LAS u32x2*)(Vt + (dt * 16 + fr) * 144 + ((2 * kp + 1) * 16 + quad * 4) * 2);
                const u32x4 t = {lo.x, lo.y, hi.x, hi.y}; vf[dt][kp] = __builtin_bit_cast(bf16x8, t); }
            f32x4 s[4];
#pragma unroll
            for (int st = 0; st < 4; ++st) { f32x4 a = (f32x4){0.f, 0.f, 0.f, 0.f};
                a = __builtin_amdgcn_mfma_f32_16x16x32_bf16(kf[st][0], qf[g][0], a, 0, 0, 0); a = __builtin_amdgcn_mfma_f32_16x16x32_bf16(kf[st][1], qf[g][1], a, 0, 0, 0); s[st] = a * 0.125f; }
            if (local) {
#pragma unroll
                for (int st = 0; st < 4; ++st)
#pragma unroll
                    for (int j = 0; j < 4; ++j) { const int d = qpos - (kpos0 + st * 16 + quad * 4 + j); if (d > 128 || d < -128) s[st][j] = -1e30f; }
            }
            float mx = fmaxf(fmaxf(fmaxf(s[0][0], s[0][1]), fmaxf(s[0][2], s[0][3])), fmaxf(fmaxf(s[1][0], s[1][1]), fmaxf(s[1][2], s[1][3])));
            mx = fmaxf(mx, fmaxf(fmaxf(fmaxf(s[2][0], s[2][1]), fmaxf(s[2][2], s[2][3])), fmaxf(fmaxf(s[3][0], s[3][1]), fmaxf(s[3][2], s[3][3]))));
            mx = fmaxf(mx, __shfl_xor(mx, 16)); mx = fmaxf(mx, __shfl_xor(mx, 32));
            const float mn = fmaxf(mrun[g], mx), alpha = __expf(mrun[g] - mn); mrun[g] = mn;
            float ps = 0.f;
#pragma unroll
            for (int st = 0; st < 4; ++st)
#pragma unroll
                for (int j = 0; j < 4; ++j) { s[st][j] = __expf(s[st][j] - mn); ps += s[st][j]; }
            lrun[g] = lrun[g] * alpha + ps;
            bf16x8 pb[2];
#pragma unroll
            for (int kp = 0; kp < 2; ++kp) { const u32x4 t = {cvtpk(s[2 * kp][0], s[2 * kp][1]), cvtpk(s[2 * kp][2], s[2 * kp][3]), cvtpk(s[2 * kp + 1][0], s[2 * kp + 1][1]), cvtpk(s[2 * kp + 1][2], s[2 * kp + 1][3])}; pb[kp] = __builtin_bit_cast(bf16x8, t); }
#pragma unroll
            for (int dt = 0; dt < 4; ++dt) { f32x4 o = oacc[g][dt] * alpha;
                o = __builtin_amdgcn_mfma_f32_16x16x32_bf16(vf[dt][0], pb[0], o, 0, 0, 0); o = __builtin_amdgcn_mfma_f32_16x16x32_bf16(vf[dt][1], pb[1], o, 0, 0, 0); oacc[g][dt] = o; }
        }
        if (tile + 1 < T) SWA_STORE((tile + 1) & 1);
        __syncthreads();
    }
#undef SWA_SRC
#undef SWA_STORE
    const float* sink = p->in[13] + l * 8;
#pragma unroll
    for (int g = 0; g < 2; ++g) {
        float lsum = lrun[g]; lsum += __shfl_xor(lsum, 16); lsum += __shfl_xor(lsum, 32);
        lsum += __expf(sink[hbase + g] - mrun[g]);
        const float inv = 1.0f / lsum;
#pragma unroll
        for (int dt = 0; dt < 4; ++dt) { const f32x4 o = oacc[g][dt] * inv; u32x2 w; w.x = cvtpk(o[0], o[1]); w.y = cvtpk(o[2], o[3]);
            *(u32x2*)(MIX + (size_t)qrow * DM + 256 + (hbase + g) * 64 + dt * 16 + quad * 4) = w; }
    }
    }
}

__device__ __forceinline__ float group16_sum(float v) { return reduce16(v); }
__device__ __forceinline__ void phase_finalize(kparams_t p, int l, int nrows, int gw, int ngw, int lane) {
    const hf* OR = (const hf*)(p->ws + WS_OR); const hf* OG = (const hf*)(p->ws + WS_OG); const hf* PREP = (const hf*)(p->ws + WS_PREP); const hf* GG = (const hf*)(p->ws + WS_GG);
    const float* BONUS = (const float*)(p->ws + WS_BONUS); const bf16_t* P1 = (const bf16_t*)(p->ws + WS_P1); bf16_t* MIX = (bf16_t*)(p->ws + WS_XN);
    const float* ln_g = p->in[23] + l * 256; const float* ln_b = p->in[24] + l * 256; const float* gng = p->in[12] + l * 64;
    const int c = lane * 4, h = lane >> 4;
    const f32x4 lg4 = *(const f32x4*)(ln_g + c), lb4 = *(const f32x4*)(ln_b + c), gn4 = *(const f32x4*)(gng + (c & 63));
    h4 ra, rb, rv, rg, ga, gb; float rbon; u32x2 rgt;
#define FIN_LOAD(rw_) do { const size_t r_ = (size_t)(rw_); ra = *(const h4*)(OR + r_ * 256 + c); rb = *(const h4*)(OR + (size_t)MT * 256 + r_ * 256 + c); rbon = BONUS[r_ * 4 + h]; \
        rv = *(const h4*)(PREP + r_ * PRC + 512 + c); rg = *(const h4*)(GG + r_ * 256 + c); ga = *(const h4*)(OG + r_ * 256 + c); gb = *(const h4*)(OG + (size_t)MT * 256 + r_ * 256 + c); \
        rgt = *(const u32x2*)(P1 + r_ * P1C + 512 + c); } while (0)
    if (gw < nrows) FIN_LOAD(gw);
    for (int row = gw; row < nrows; row += ngw) {
        const h4 a = ra, bq = rb, v4 = rv, g4 = rg, a2 = ga, b2 = gb; const float bon = rbon; const u32x2 gt = rgt;
        if (row + ngw < nrows) FIN_LOAD(row + ngw);
        {
            float o[4]; float s = 0.f;
#pragma unroll
            for (int e = 0; e < 4; ++e) { o[e] = (float)a[e] + (float)bq[e]; s += o[e]; }
            const float mu = group16_sum(s) * (1.0f / 64.0f); float q = 0.f;
#pragma unroll
            for (int e = 0; e < 4; ++e) { o[e] -= mu; q += o[e] * o[e]; }
            const float rs = rsqrtf(group16_sum(q) * (1.0f / 64.0f) + 64e-5f);
            float y[4];
#pragma unroll
            for (int e = 0; e < 4; ++e) y[e] = (o[e] * rs * lg4[e] + lb4[e] + bon * (float)v4[e]) * (float)g4[e];
            u32x2 w; w.x = cvtpk(y[0], y[1]); w.y = cvtpk(y[2], y[3]);
            *(u32x2*)(MIX + (size_t)row * DM + 768 + c) = w;
        }
        {
            float o[4]; float q = 0.f;
#pragma unroll
            for (int e = 0; e < 4; ++e) { o[e] = (float)a2[e] + (float)b2[e]; q += o[e] * o[e]; }
            const float rs = rsqrtf(group16_sum(q) * (1.0f / 64.0f) + 1e-6f);
            const float gv[4] = {bflo(gt.x), bfhi(gt.x), bflo(gt.y), bfhi(gt.y)};
            float y[4];
#pragma unroll
            for (int e = 0; e < 4; ++e) y[e] = o[e] * rs * gn4[e] * gv[e] * sigmoidf_(gv[e]);
            u32x2 w; w.x = cvtpk(y[0], y[1]); w.y = cvtpk(y[2], y[3]);
            *(u32x2*)(MIX + (size_t)row * DM + c) = w;
        }
    }
#undef FIN_LOAD
}
__global__ void __launch_bounds__(NTHREADS, 2) hybrid_fwd(Params p_arg) {
    extern __shared__ __attribute__((aligned(16))) unsigned char lds[];
#ifndef EXP_REP
#define EXP_REP 1
#endif
#ifndef EXP_FLAG
#define EXP_FLAG(rep) 0
#endif
#ifndef MAXSTEP
#define MAXSTEP 1000
#endif
    constexpr int NSTEP = 1 + 9 * NLAYER + 1;
#ifdef PROBE
    unsigned long long tacc1 = 0, tacc2 = 0;
#endif
    { volatile LAS unsigned* st0 = (volatile LAS unsigned*)((LAS unsigned char*)lds + 147392); if (threadIdx.x < 2) st0[threadIdx.x] = 0u; __syncthreads();
      (void)xcd_barrier_post((unsigned*)(p_arg.ws + WS_CTL) + 1024, st0); }
    int rep = 0;
#pragma unroll 1
    for (int step = 0; step < NSTEP; ++step) {
#ifdef PROBE
        const unsigned long long t0_ = __builtin_amdgcn_s_memrealtime();
#endif
        kparams_t kp = (kparams_t)__builtin_amdgcn_kernarg_segment_ptr();
        asm volatile("" : "+s"(kp));
        kparams_t p = kp;
        int tid = threadIdx.x, bid = blockIdx.x, G = gridDim.x;
        asm volatile("" : "+v"(tid)); asm volatile("" : "+s"(bid)); asm volatile("" : "+s"(G));
        const int lane = tid & 63, wave = __builtin_amdgcn_readfirstlane(tid >> 6);
        const int gw = bid * NWAVES + wave, ngw = G * NWAVES;
        unsigned char* ws = p->ws;
        bf16_t* XN = (bf16_t*)(ws + WS_XN); float* XC = (float*)(ws + WS_XC); float* XL = p->out;
        if (step == 0) { phase_mod(lds, p, tid, bid, G); }
        else if (step == NSTEP - 1) { final_norm_rows(XL, p->in[28], gw, ngw, lane);
#ifdef PROBE
            cg::this_grid().sync();
            if (bid == 0) { const float v1 = (float)tacc1 * 0.01f; if (tid == 0) XL[0] = v1; }
            if (bid == PROBE_B2) { const float v2 = (float)tacc2 * 0.01f; for (int i = tid; i < (1 << 20); i += NTHREADS) XL[1024 + i] = v2; }
#endif
            break; }
        else {
            const int l = (step - 1) / 9, ph = (step - 1) % 9;

            const bool lastl = (l == NLAYER - 1);
            const int mrows = lastl ? ML : MT;
            const float* modl = (const float*)(ws + WS_MOD) + (size_t)l * 9 * 6144;
            const float* resL = l == 0 ? p->in[0] : XL; const float* resC = l == 0 ? p->in[2] : XC;
            if (ph == 0) {
                convert_weights(lds, p, l, gw, ngw, wave, lane);
                norm_mod_rows(resL, resC, p->in[6] + l * DM, modl, 0, 1024, XN, MT, gw, ngw, lane);
            } else if (ph == 1) {
                pg8::Gemm g{XN, (const bf16_t*)(ws + WS_WT + WT_IN), MT, INP, DM}; pg8::StaticOrder S; S.init(MT, INP, G, bid);
                pg8::EpiIn E{(bf16_t*)(ws + WS_P1), (bf16_t*)(ws + WS_RAW)};
                pg8::gemm_phase<pg8::EpiIn, pg8::StaticOrder, true, true>((PG8_LAS unsigned char*)lds, g, S, E, tid);
            } else if (ph == 5) {
                pg8::Gemm g{XN, (const bf16_t*)(ws + WS_WT + WT_OUT), mrows, DM, DM}; pg8::StaticOrder S; S.init(mrows, DM, G, bid);
                pg8::EpiRes E{resL, XL, resC, XC, modl + 2048};
                pg8::gemm_phase<pg8::EpiRes, pg8::StaticOrder, true, true>((PG8_LAS unsigned char*)lds, g, S, E, tid);
            } else if (ph == 7) {
                pg8::Gemm g{XN, (const bf16_t*)(ws + WS_WT + WT_GU), mrows, 2 * FF, DM}; pg8::StaticOrder S; S.init(mrows, 2 * FF, G, bid);
                pg8::EpiSwiglu E{(bf16_t*)(ws + WS_H)};
                pg8::gemm_phase<pg8::EpiSwiglu, pg8::StaticOrder, true, true>((PG8_LAS unsigned char*)lds, g, S, E, tid);
            } else if (ph == 8) {
                pg8::Gemm g{(const bf16_t*)(ws + WS_H), (const bf16_t*)(ws + WS_WT + WT_DN), mrows, DM, FF}; pg8::StaticOrder S; S.init(mrows, DM, G, bid);
                pg8::EpiRes E{XL, XL, XC, XC, modl + 5120};
                pg8::gemm_phase<pg8::EpiRes, pg8::StaticOrder, true, true>((PG8_LAS unsigned char*)lds, g, S, E, tid);
            } else if (ph == 2) {
                phase_prep(lds, p, l, tid, bid, G, rep == 0);
            } else if (ph == 3) {
#ifdef PROBE_SCAN
                const unsigned long long ts_ = __builtin_amdgcn_s_memrealtime();
#endif
#ifdef REP_NO_SCAN
                if (rep == 0)
#endif
#ifdef RWKV_SCAN
                for (int it = bid; it < 192; it += G) {
#ifdef REP_ONLY_RWKV
                    if (rep == EXP_REP && it >= 128) continue;
#endif
#ifdef REP_ONLY_GLA
                    if (rep == EXP_REP && it < 128) continue;
#endif
                    if (it < 128) rwkv_scan_item(lds, p, it, tid, EXP_FLAG(rep)); else gla_scan_item(lds, p, (it - 128) * 2, tid); __syncthreads(); }
#else
                for (int it = bid; it < 128; it += G) {
#ifdef REP_ONLY_RWKV
                    if (rep == EXP_REP && it >= 64) continue;
#endif
#ifdef REP_ONLY_GLA
                    if (rep == EXP_REP && it < 64) continue;
#endif
                    if (it < 64) rwkv_chunk_item(lds, p, it, tid, EXP_FLAG(rep)); else gla_chunk_item(lds, p, it - 64, tid); __syncthreads(); }
#endif
#ifdef PROBE_SCAN
                { const unsigned long long d_ = __builtin_amdgcn_s_memrealtime() - ts_; tacc1 += d_; tacc2 += d_; }
#endif
#ifdef REP_NO_SWA
                const int nswa = rep == EXP_REP ? 0 : (lastl ? 512 : 544);
#else
                const int nswa = lastl ? 512 : 544;
#endif
                unsigned* ctl = (unsigned*)(ws + WS_CTL);
                LAS int* qslot = (LAS int*)((LAS unsigned char*)lds + 147328);
                for (;;) {
                    __syncthreads();
                    if (tid == 0) *qslot = (int)atomicAdd(ctl + 64 * l + 32 * rep, 1u);
                    __syncthreads();
                    const int it = *qslot;
                    if (it >= nswa) break;
                    swa_item(lds, p, l, it, tid);
                }
            } else if (ph == 4) {
                phase_finalize(p, l, mrows, gw, ngw, lane);
            } else {
                norm_mod_rows(XL, XC, p->in[7] + l * DM, modl, 3072, 4096, XN, mrows, gw, ngw, lane);
            }
        }
        if (step == 0) cg::this_grid().sync();
        else { XcdBarrier xb_; xb_.bar = (unsigned*)(p->ws + WS_CTL) + 1024; xb_.x = xb_xcc_id(); xb_.st = (volatile LAS unsigned*)((LAS unsigned char*)lds + 147392); xcd_barrier(xb_); }
#ifdef PROBE
        { const unsigned long long dt_ = __builtin_amdgcn_s_memrealtime() - t0_; const int ph_ = step == 0 ? 9 : (step - 1) % 9;
          if (PROBE_C1(ph_)) tacc1 += dt_; if (PROBE_C2(ph_)) tacc2 += dt_; }
#endif
#ifdef DOUBLE_MASK
#ifdef DOUBLE_STEP0
        if (step == 0 && rep == 0) { rep = 1; --step; } else
#endif
#ifdef DOUBLE_D0
        if (step == 6 && rep == 0) { rep = 1; --step; } else
#endif
        if (step >= 1 && rep == 0 && ((DOUBLE_MASK >> ((step - 1) % 9)) & 1)) { rep = 1; --step; } else rep = 0;
#endif
        if (step + 1 >= MAXSTEP) break;
    }
}

extern "C" void kernel_launch(void* const* d_in, const int* in_sizes, int n_in, void* d_out, int out_size, void* d_ws, size_t ws_size, hipStream_t stream) {
    static int grid_blocks = 0;
    if (grid_blocks == 0) {
        if (n_in != 29 || out_size != ML * DM || ws_size < WS_END) { fprintf(stderr, "kernel_launch: unexpected shapes (n_in %d out %d ws %zu)\n", n_in, out_size, ws_size); grid_blocks = -1; return; }
        int dev = 0, cus = 0, per_cu = 0;
        (void)hipGetDevice(&dev);
        (void)hipDeviceGetAttribute(&cus, hipDeviceAttributeMultiprocessorCount, dev);
        (void)hipFuncSetAttribute((const void*)hybrid_fwd, hipFuncAttributeMaxDynamicSharedMemorySize, LDS_BYTES);
        (void)hipOccupancyMaxActiveBlocksPerMultiprocessor(&per_cu, (const void*)hybrid_fwd, NTHREADS, LDS_BYTES);
        if (per_cu < 1) per_cu = 1;
        grid_blocks = cus * per_cu;
        (void)hipGetLastError();
    }
    if (grid_blocks < 0) return;
    (void)hipMemsetAsync((char*)d_ws + WS_CTL, 0, 65536, stream);
    Params p{};
    for (int i = 0; i < 29; ++i) p.in[i] = (const float*)d_in[i];
    p.out = (float*)d_out; p.ws = (unsigned char*)d_ws;
    void* args[] = {&p};
    hipError_t e = hipLaunchCooperativeKernel((const void*)hybrid_fwd, dim3(grid_blocks), dim3(NTHREADS), args, LDS_BYTES, stream);
    if (e != hipSuccess) fprintf(stderr, "cooperative launch failed: %s (grid %d)\n", hipGetErrorString(e), grid_blocks);
}
```
